# Optimizing an MI355X kernel written in HIP

```python
import math
import jax, jax.numpy as jnp
from jax import lax
import numpy as np

D_MODEL = 2048
BATCH = 2
SEQ = 4096
DEPTH = 1
DEC_BATCH = 8
DEC_SEQ = 4
PAST_LEN = 16384
PAGE_SIZE = 128

HEAD_DIM = 128
MIX_WIDTH = D_MODEL
CONV_CH = D_MODEL // 4
ATTN_WIDTH = MIX_WIDTH - CONV_CH
N_ATTN_HEADS = ATTN_WIDTH // HEAD_DIM
DILATION_GROUPS = ((128, 1), (512, 4), (2048, 16))
HEADS_PER_GROUP = N_ATTN_HEADS // len(DILATION_GROUPS)
CONV_K = 31
FFN_HIDDEN = ((8 * D_MODEL + 2) // 3 + 255) // 256 * 256
ROPE_THETA = 10000.0
DEEPNORM_ALPHA = (2.0 * DEPTH) ** 0.25
DEEPNORM_BETA = (8.0 * DEPTH) ** -0.25
LN_EPS = 1e-5
Q_BLOCK = 128
ATTN_SCALE = HEAD_DIM ** -0.5
W_IN_COLS = 3 * ATTN_WIDTH + 2 * CONV_CH
SPLITS = (ATTN_WIDTH, 2 * ATTN_WIDTH, 3 * ATTN_WIDTH, 3 * ATTN_WIDTH + CONV_CH)

kernel_name = 'hymba_dilated_conformer_deepnorm_step'


def _layer_norm(x, g, b):
    xf = x.astype(jnp.float32)
    mu = jnp.mean(xf, axis=-1, keepdims=True)
    var = jnp.mean(jnp.square(xf - mu), axis=-1, keepdims=True)
    return ((xf - mu) * lax.rsqrt(var + LN_EPS) * g.astype(jnp.float32) + b.astype(jnp.float32)).astype(x.dtype)


def _rope(x, pos):
    half = HEAD_DIM // 2
    inv = ROPE_THETA ** (-jnp.arange(half, dtype=jnp.float32) / half)
    ang = pos.astype(jnp.float32)[:, None] * inv[None, :]
    cos = jnp.cos(ang)[:, None, :]
    sin = jnp.sin(ang)[:, None, :]
    x1 = x[..., :half].astype(jnp.float32)
    x2 = x[..., half:].astype(jnp.float32)
    return jnp.concatenate([x1 * cos - x2 * sin, x2 * cos + x1 * sin], axis=-1).astype(x.dtype)


def _attend(s, v, spec):
    m = jnp.max(s, axis=-1, keepdims=True)
    e = jnp.exp(s - m)
    den = jnp.sum(e, axis=-1, keepdims=True)
    out = jnp.einsum(spec, (e / den).astype(v.dtype), v)
    lse = (m + jnp.log(den))[..., 0]
    return out, lse


def _dilated_prompt(q, k, v, window, dilation):
    B, S, H, Dh = q.shape
    L = S // dilation
    nk = window // dilation
    n_blk = -(-L // Q_BLOCK)
    Lp = n_blk * Q_BLOCK

    def to_classes(t):
        return t.reshape(B, L, dilation, H, Dh).transpose(0, 2, 1, 3, 4)

    qb = jnp.pad(to_classes(q), ((0, 0), (0, 0), (0, Lp - L), (0, 0), (0, 0)))
    qb = qb.reshape(B, dilation, n_blk, Q_BLOCK, H, Dh)
    kpad = ((0, 0), (0, 0), (nk, Lp - L), (0, 0), (0, 0))
    kc = jnp.pad(to_classes(k), kpad)
    vc = jnp.pad(to_classes(v), kpad)
    blk = jnp.arange(n_blk)[:, None]
    idx = blk * Q_BLOCK + jnp.arange(Q_BLOCK + nk)[None, :]
    kb = kc[:, :, idx]
    vb = vc[:, :, idx]
    s = jnp.einsum('brnqhe,brnkhe->brnhqk', qb, kb).astype(jnp.float32) * ATTN_SCALE
    qq = jnp.arange(Q_BLOCK)[:, None]
    kk = jnp.arange(Q_BLOCK + nk)[None, :]
    dist = qq - kk + nk
    kidx = blk[:, :, None] * Q_BLOCK + kk[None] - nk
    valid = (dist >= 0)[None] & (dist <= nk)[None] & (kidx >= 0)
    s = jnp.where(valid[None, None, :, None], s, -jnp.inf)
    out, lse = _attend(s, vb, 'brnhqk,brnkhe->brnqhe')
    out = out.reshape(B, dilation, Lp, H, Dh)[:, :, :L].transpose(0, 2, 1, 3, 4).reshape(B, S, H, Dh)
    lse = lse.transpose(0, 1, 2, 4, 3).reshape(B, dilation, Lp, H)[:, :, :L]
    lse = lse.transpose(0, 2, 1, 3).reshape(B, S, H)
    return out, lse


def _dilated_sample(q, k_hist, v_hist, window, dilation):
    B, T, H, Dh = q.shape
    buf = k_hist.shape[1] - T
    nk = window // dilation
    idx = buf + jnp.arange(T)[:, None] - dilation * jnp.arange(nk + 1)[None, :]
    valid = idx >= 0
    idx = jnp.maximum(idx, 0)
    kg = k_hist[:, idx]
    vg = v_hist[:, idx]
    s = jnp.einsum('bthe,btjhe->bhtj', q, kg).astype(jnp.float32) * ATTN_SCALE
    s = jnp.where(valid[None, None], s, -jnp.inf)
    out, lse = _attend(s, vg, 'bhtj,btjhe->bthe')
    return out, lse.transpose(0, 2, 1)


def _layer(x, pos, kv_bufs, conv_buf, w_in, w_out, conv_w, conv_b, conv_ln_g, conv_ln_b,
           ln1_g, ln1_b, w_gate, w_up, w_down, ln2_g, ln2_b):
    B, T, _ = x.shape
    h = jnp.einsum('btd,de->bte', x, w_in)
    q, k, v, a, g = jnp.split(h, SPLITS, axis=-1)
    q = _rope(q.reshape(B, T, N_ATTN_HEADS, HEAD_DIM), pos)
    k = _rope(k.reshape(B, T, N_ATTN_HEADS, HEAD_DIM), pos)
    v = v.reshape(B, T, N_ATTN_HEADS, HEAD_DIM)

    outs, lses, new_kv = [], [], []
    for gi, (window, dilation) in enumerate(DILATION_GROUPS):
        hs = slice(gi * HEADS_PER_GROUP, (gi + 1) * HEADS_PER_GROUP)
        qg, kg, vg = q[:, :, hs], k[:, :, hs], v[:, :, hs]
        kv_new = jnp.stack([kg, vg], axis=2)
        if kv_bufs is None:
            o, l = _dilated_prompt(qg, kg, vg, window, dilation)
            keep = min(window, T)
            new_kv.append(kv_new[:, T - keep:])
        else:
            kv_hist = jnp.concatenate([kv_bufs[gi], kv_new], axis=1)
            o, l = _dilated_sample(qg, kv_hist[:, :, 0], kv_hist[:, :, 1], window, dilation)
            new_kv.append(kv_hist[:, T:])
        outs.append(o)
        lses.append(l)
    alpha = jax.nn.softmax(jnp.stack(lses, axis=0), axis=0)
    attn = jnp.concatenate([o * alpha[i][..., None].astype(o.dtype) for i, o in enumerate(outs)], axis=2)
    attn = attn.reshape(B, T, ATTN_WIDTH)

    u = a * jax.nn.sigmoid(g)
    if conv_buf is None:
        conv_buf = jnp.zeros((B, CONV_K - 1, CONV_CH), u.dtype)
    u_hist = jnp.concatenate([conv_buf, u], axis=1)
    c = lax.conv_general_dilated(u_hist, conv_w[:, None, :].astype(u.dtype), (1,), 'VALID',
                                 dimension_numbers=('NWC', 'WIO', 'NWC'),
                                 feature_group_count=CONV_CH) + conv_b
    c = jax.nn.silu(_layer_norm(c, conv_ln_g, conv_ln_b))
    new_conv = u_hist[:, -(CONV_K - 1):]

    mix = jnp.einsum('bte,ed->btd', jnp.concatenate([attn, c], axis=-1), w_out)
    x1 = _layer_norm(DEEPNORM_ALPHA * x + mix, ln1_g, ln1_b)
    f = jax.nn.silu(jnp.einsum('btd,df->btf', x1, w_gate)) * jnp.einsum('btd,df->btf', x1, w_up)
    f = jnp.einsum('btf,fd->btd', f, w_down)
    x2 = _layer_norm(DEEPNORM_ALPHA * x1 + f, ln2_g, ln2_b)
    return x2, new_kv, new_conv


def setup_inputs(seed: int = 0) -> dict:
    key = jax.random.key(seed)
    ks = jax.random.split(key, 20)
    f32 = jnp.float32
    nrm = lambda k, shape: jax.random.normal(k, shape, f32)
    bufs = [min(w, PAST_LEN) for (w, _) in DILATION_GROUPS]
    kv_shape = lambda n: (DEPTH, DEC_BATCH, n, 2, HEADS_PER_GROUP, HEAD_DIM)
    col_scale = jnp.concatenate([jnp.ones((2 * ATTN_WIDTH,), f32),
                                 jnp.full((ATTN_WIDTH + CONV_CH,), DEEPNORM_BETA, f32),
                                 jnp.ones((CONV_CH,), f32)])
    return {
        'x_prompt': nrm(ks[0], (BATCH, SEQ, D_MODEL)),
        'x_sample': nrm(ks[1], (DEC_BATCH, DEC_SEQ, D_MODEL)),
        'cache_kv_w128': nrm(ks[2], kv_shape(bufs[0])),
        'cache_kv_w512': nrm(ks[3], kv_shape(bufs[1])),
        'cache_kv_w2048': nrm(ks[4], kv_shape(bufs[2])),
        'state_conv': 0.5 * nrm(ks[5], (DEPTH, DEC_BATCH, CONV_K - 1, CONV_CH)),
        'w_in': nrm(ks[6], (DEPTH, D_MODEL, W_IN_COLS)) * D_MODEL ** -0.5 * col_scale,
        'w_out': nrm(ks[7], (DEPTH, MIX_WIDTH, D_MODEL)) * MIX_WIDTH ** -0.5 * DEEPNORM_BETA,
        'conv_w': nrm(ks[8], (DEPTH, CONV_K, CONV_CH)) * CONV_K ** -0.5,
        'conv_b': 0.01 * nrm(ks[9], (DEPTH, CONV_CH)),
        'conv_ln_g': 1.0 + 0.01 * nrm(ks[10], (DEPTH, CONV_CH)),
        'conv_ln_b': 0.01 * nrm(ks[11], (DEPTH, CONV_CH)),
        'ln1_g': 1.0 + 0.01 * nrm(ks[12], (DEPTH, D_MODEL)),
        'ln1_b': 0.01 * nrm(ks[13], (DEPTH, D_MODEL)),
        'w_gate': nrm(ks[14], (DEPTH, D_MODEL, FFN_HIDDEN)) * D_MODEL ** -0.5 * DEEPNORM_BETA,
        'w_up': nrm(ks[15], (DEPTH, D_MODEL, FFN_HIDDEN)) * D_MODEL ** -0.5 * DEEPNORM_BETA,
        'w_down': nrm(ks[16], (DEPTH, FFN_HIDDEN, D_MODEL)) * FFN_HIDDEN ** -0.5 * DEEPNORM_BETA,
        'ln2_g': 1.0 + 0.01 * nrm(ks[17], (DEPTH, D_MODEL)),
        'ln2_b': 0.01 * nrm(ks[18], (DEPTH, D_MODEL)),
    }


def reference(x_prompt, x_sample, cache_kv_w128, cache_kv_w512, cache_kv_w2048, state_conv,
              w_in, w_out, conv_w, conv_b, conv_ln_g, conv_ln_b, ln1_g, ln1_b,
              w_gate, w_up, w_down, ln2_g, ln2_b):
    pos_p = jnp.arange(x_prompt.shape[1], dtype=jnp.int32)
    pos_s = PAST_LEN + jnp.arange(x_sample.shape[1], dtype=jnp.int32)
    xp, xs = x_prompt, x_sample
    kvp = [[], [], []]
    kvs = [[], [], []]
    convp, convs = [], []
    for l in range(DEPTH):
        params = (w_in[l], w_out[l], conv_w[l], conv_b[l], conv_ln_g[l], conv_ln_b[l],
                  ln1_g[l], ln1_b[l], w_gate[l], w_up[l], w_down[l], ln2_g[l], ln2_b[l])
        xp, nkv_p, nconv_p = _layer(xp, pos_p, None, None, *params)
        bufs = (cache_kv_w128[l], cache_kv_w512[l], cache_kv_w2048[l])
        xs, nkv_s, nconv_s = _layer(xs, pos_s, bufs, state_conv[l], *params)
        for gi in range(len(DILATION_GROUPS)):
            kvp[gi].append(nkv_p[gi])
            kvs[gi].append(nkv_s[gi])
        convp.append(nconv_p)
        convs.append(nconv_s)
    y_prompt, y_sample = xp, xs
    new_kv_w128_prompt = jnp.stack(kvp[0], axis=0)
    new_kv_w512_prompt = jnp.stack(kvp[1], axis=0)
    new_kv_w2048_prompt = jnp.stack(kvp[2], axis=0)
    new_conv_prompt = jnp.stack(convp, axis=0)
    new_kv_w128_sample = jnp.stack(kvs[0], axis=0)
    new_kv_w512_sample = jnp.stack(kvs[1], axis=0)
    new_kv_w2048_sample = jnp.stack(kvs[2], axis=0)
    new_conv_sample = jnp.stack(convs, axis=0)
    return (y_prompt, y_sample, new_kv_w128_prompt, new_kv_w512_prompt, new_kv_w2048_prompt, new_conv_prompt,
            new_kv_w128_sample, new_kv_w512_sample, new_kv_w2048_sample, new_conv_sample)
```

```cpp
#include <hip/hip_runtime.h>
#include <hip/hip_cooperative_groups.h>
#include <cstdio>
namespace cg = cooperative_groups;

#define LAS __attribute__((address_space(3)))
typedef unsigned short bf16_t;
typedef short bf16x8 __attribute__((ext_vector_type(8)));
typedef short bf16x4 __attribute__((ext_vector_type(4)));
typedef float f32x4 __attribute__((ext_vector_type(4)));
typedef unsigned u32x4 __attribute__((ext_vector_type(4)));
typedef unsigned u32x2 __attribute__((ext_vector_type(2)));

constexpr int DM = 2048, SEQ = 4096, MP = 8192, MS = 32, MT = MP + MS, MPAD = 8448;
constexpr int AW = 1536, CCH = 512, NIN = 5632, FH = 5632;
constexpr float ALPHA = 1.189207115002721f;
constexpr float LN_EPS = 1e-5f;
constexpr float QSCALE = 0.08838834764831845f * 1.4426950408889634f;

constexpr size_t O_KVP0 = (size_t)MT * DM;
constexpr size_t O_KVP1 = O_KVP0 + 2 * 128 * 1024;
constexpr size_t O_KVP2 = O_KVP1 + 2 * 512 * 1024;
constexpr size_t O_CONVP = O_KVP2 + 2 * 2048 * 1024;
constexpr size_t O_KVS0 = O_CONVP + 2 * 30 * 512;
constexpr size_t O_KVS1 = O_KVS0 + 8 * 128 * 1024;
constexpr size_t O_KVS2 = O_KVS1 + 8 * 512 * 1024;
constexpr size_t O_CONVS = O_KVS2 + (size_t)8 * 2048 * 1024;
constexpr size_t O_END = O_CONVS + 8 * 30 * 512;

constexpr size_t WS_WIN = 0;
constexpr size_t WS_WOUT = WS_WIN + (size_t)NIN * DM * 2;
constexpr size_t WS_WGU = WS_WOUT + (size_t)DM * DM * 2;
constexpr size_t WS_WD = WS_WGU + (size_t)2 * FH * DM * 2;
constexpr size_t WS_ROPE = WS_WD + (size_t)DM * FH * 2;
constexpr size_t WS_LSE = WS_ROPE + (size_t)4100 * 64 * 8;
constexpr size_t WS_R1 = WS_LSE + (size_t)MPAD * 12 * 4;
constexpr size_t WS_XB = WS_R1;
constexpr size_t WS_Q = WS_XB + (size_t)MPAD * DM * 2;
constexpr size_t WS_K = WS_Q + (size_t)MPAD * AW * 2;
constexpr size_t WS_V = WS_K + (size_t)MPAD * AW * 2;
constexpr size_t WS_U = WS_V + (size_t)MPAD * AW * 2;
constexpr size_t WS_R1END = WS_U + (size_t)MPAD * CCH * 4;
constexpr size_t WS_H = WS_R1;
constexpr size_t WS_AO = WS_R1END;
constexpr size_t WS_Z1 = WS_AO + (size_t)MPAD * DM * 2;
constexpr size_t WS_END = WS_Z1 + (size_t)MPAD * DM * 4;
static_assert((size_t)MPAD * FH * 2 <= WS_R1END - WS_R1, "H alias");

struct Params {
    const float *xp, *xs, *c0, *c1, *c2, *sconv, *w_in, *w_out, *conv_w, *conv_b, *cln_g, *cln_b, *ln1_g, *ln1_b, *w_gate, *w_up, *w_down, *ln2_g, *ln2_b;
    float* out; unsigned char* ws;
};

__device__ __forceinline__ unsigned cvt_pk_bf16(float lo, float hi) { unsigned r; asm volatile("v_cvt_pk_bf16_f32 %0, %1, %2" : "=v"(r) : "v"(lo), "v"(hi)); return r; }
__device__ __forceinline__ float bf2f(unsigned short b) { return __uint_as_float(((unsigned)b) << 16); }
__device__ __forceinline__ u32x2 pack4(f32x4 v) { u32x2 r; r.x = cvt_pk_bf16(v[0], v[1]); r.y = cvt_pk_bf16(v[2], v[3]); return r; }
__device__ __forceinline__ u32x4 pack8(f32x4 a, f32x4 b) { u32x4 r; r.x = cvt_pk_bf16(a[0], a[1]); r.y = cvt_pk_bf16(a[2], a[3]); r.z = cvt_pk_bf16(b[0], b[1]); r.w = cvt_pk_bf16(b[2], b[3]); return r; }
__device__ __forceinline__ float wave_sum(float v) {
#pragma unroll
    for (int o = 1; o < 64; o <<= 1) v += __shfl_xor(v, o);
    return v;
}
__device__ __forceinline__ float wave_max(float v) {
#pragma unroll
    for (int o = 1; o < 64; o <<= 1) v = fmaxf(v, __shfl_xor(v, o));
    return v;
}
__device__ __forceinline__ float fast_sigmoid(float g) { return 1.0f / (1.0f + __expf(-g)); }

constexpr int BM = 256, BK = 64, HALF = 128, HTB = HALF * BK * 2, STAGE_BYTES = 8 * HTB, NXCD = 8, WGM = 8;
__device__ __forceinline__ int lds_byte(int r, int c) { const int st = (r >> 4) * 2 + (c >> 5), rr = r & 15, cc = c & 31, ob = rr * 64 + cc * 2; return st * 1024 + (ob ^ (((ob >> 9) & 1) << 5)); }
__device__ __forceinline__ void stage_rc(int b, int& R, int& C) { const int st = b / 1024, sb = b % 1024, swz = sb ^ (((sb >> 9) & 1) << 5); R = (st >> 1) * 16 + swz / 64; C = (st & 1) * 32 + (swz % 64) / 2; }
struct Unit { int pm, pn; };
struct Gemm { const bf16_t* A; const bf16_t* Bt; int M, N, K; };
struct StaticOrder {
    int nM, nN, nwg, G, c;
    __device__ void init(int M, int N, int G_, int c_) { nM = M / BM; nN = N / BM; nwg = nM * nN; G = G_; c = c_; }
    __device__ bool next(int i, Unit& u) const {
        const long L = (long)i * G + c; if (L >= nwg) return false;
        int wgid = (int)L; { const int q = nwg / NXCD, r = nwg % NXCD, xcd = wgid % NXCD, off = wgid / NXCD; wgid = (xcd < r ? xcd * (q + 1) : r * (q + 1) + (xcd - r) * q) + off; }
        const int nig = WGM * nN, gid = wgid / nig, fm = gid * WGM, gsz = (nM - fm) < WGM ? (nM - fm) : WGM;
        u.pm = fm + ((wgid % nig) % gsz); u.pn = (wgid % nig) / gsz; return true;
    }
};

template <class Epi>
__device__ __forceinline__ void gemm_phase(LAS unsigned char* lds, const Gemm g, const StaticOrder& S, const Epi& E) {
    const int tid = threadIdx.x, wid = __builtin_amdgcn_readfirstlane(tid >> 6), lane = tid & 63, wr = wid >> 2, wc = wid & 3, fr = lane & 15, fq = lane >> 4;
    const int K = g.K, nt = K / BK;
    unsigned voffA[2];
#pragma unroll
    for (int i = 0; i < 2; ++i) { int R, C; stage_rc(tid * 16 + i * 8192, R, C); voffA[i] = (unsigned)(R * K + C) * 2u; }
    const size_t kstep = (size_t)(BK * 2);
    const size_t hstep = (size_t)HALF * K * 2;
    const size_t tstep = 2 * hstep;
    const unsigned ldsw = (unsigned)wid * 1024u;
    const int aoff = lds_byte(wr * 64 + fr, fq * 8), boff = lds_byte(wc * 32 + fr, fq * 8);
#define PG8_SA(b, h) (((b) * 2 + (h)) * HTB)
#define PG8_SB(b, h) ((4 + (b) * 2 + (h)) * HTB)
#define PG8_STAGE(bufoff, gbase, voff) do { _Pragma("unroll") for (int _i = 0; _i < 2; ++_i) \
        __builtin_amdgcn_global_load_lds((const unsigned*)((const char*)(gbase) + (voff)[_i]), (LAS unsigned*)(lds + (bufoff) + ldsw + _i * 8192), 16, 0, 0); } while (0)
#define PG8_LDA(dst, b, h) do { _Pragma("unroll") for (int m = 0; m < 4; ++m) _Pragma("unroll") for (int k = 0; k < 2; ++k) dst[m][k] = *(const LAS bf16x8*)(lds + PG8_SA(b, h) + aoff + m * 2048 + k * 1024); } while (0)
#define PG8_LDB(dst, b, h) do { _Pragma("unroll") for (int n = 0; n < 2; ++n) _Pragma("unroll") for (int k = 0; k < 2; ++k) dst[n][k] = *(const LAS bf16x8*)(lds + PG8_SB(b, h) + boff + n * 2048 + k * 1024); } while (0)
#define PG8_MMA(ai, bj, At, Bt) do { __builtin_amdgcn_s_setprio(1); _Pragma("unroll") for (int m = 0; m < 4; ++m) _Pragma("unroll") for (int n = 0; n < 2; ++n) _Pragma("unroll") for (int k = 0; k < 2; ++k) \
        acc[ai][bj][m][n] = __builtin_amdgcn_mfma_f32_16x16x32_bf16(Bt[n][k], At[m][k], acc[ai][bj][m][n], 0, 0, 0); __builtin_amdgcn_s_setprio(0); } while (0)
#define PG8_WAIT_V(n) asm volatile("s_waitcnt vmcnt(" #n ")" ::: "memory")
#define PG8_WAIT_L(n) asm volatile("s_waitcnt lgkmcnt(" #n ")" ::: "memory")
#define PG8_BAR __builtin_amdgcn_s_barrier()
#define PG8_SCHED __builtin_amdgcn_sched_barrier(0)
    Unit cur, nxt; int ui = 0;
    if (!S.next(0, cur)) return;
    f32x4 acc[2][2][4][2];
#pragma unroll
    for (int a = 0; a < 2; ++a)
#pragma unroll
        for (int b = 0; b < 2; ++b)
#pragma unroll
            for (int m = 0; m < 4; ++m)
#pragma unroll
                for (int n = 0; n < 2; ++n) acc[a][b][m][n] = (f32x4){0.f, 0.f, 0.f, 0.f};
    bf16x8 At[4][2], B0[2][2], B1[2][2];
    const char* cA = (const char*)g.A + (size_t)cur.pm * tstep; const char* cB = (const char*)g.Bt + (size_t)cur.pn * tstep;
    PG8_STAGE(PG8_SB(0, 0), cB, voffA); PG8_STAGE(PG8_SA(0, 0), cA, voffA); PG8_STAGE(PG8_SB(0, 1), cB + hstep, voffA); PG8_STAGE(PG8_SA(0, 1), cA + hstep, voffA);
    if (wr == 1) PG8_BAR;
    PG8_WAIT_V(4); PG8_BAR;
    PG8_STAGE(PG8_SB(1, 0), cB + kstep, voffA); PG8_STAGE(PG8_SA(1, 0), cA + kstep, voffA); PG8_STAGE(PG8_SB(1, 1), cB + hstep + kstep, voffA);
    PG8_WAIT_V(6); PG8_BAR;
    for (;;) {
        const bool has_next = S.next(ui + 1, nxt);
        const char* nA = has_next ? (const char*)g.A + (size_t)nxt.pm * tstep : cA; const char* nB = has_next ? (const char*)g.Bt + (size_t)nxt.pn * tstep : cB;
        for (int t = 0; t < nt; t += 2) {
            const bool last = (t == nt - 2);
            const char* a1 = cA + (size_t)(t + 1) * kstep;
            const char* a2 = last ? nA : cA + (size_t)(t + 2) * kstep; const char* b2 = last ? nB : cB + (size_t)(t + 2) * kstep;
            const char* a3 = a2 + kstep; const char* b3 = b2 + kstep;
            PG8_LDB(B0, 0, 0); PG8_SCHED; PG8_LDA(At, 0, 0); PG8_STAGE(PG8_SA(1, 1), a1 + hstep, voffA);
            PG8_WAIT_L(8); PG8_BAR; PG8_WAIT_L(0); PG8_MMA(0, 0, At, B0); PG8_BAR; PG8_SCHED;
            PG8_LDB(B1, 0, 1); PG8_STAGE(PG8_SB(0, 0), b2, voffA);
            PG8_BAR; PG8_WAIT_L(0); PG8_MMA(0, 1, At, B1); PG8_BAR;
            PG8_LDA(At, 0, 1); PG8_STAGE(PG8_SA(0, 0), a2, voffA);
            PG8_BAR; PG8_WAIT_L(0); PG8_MMA(1, 0, At, B0); PG8_BAR; PG8_SCHED;
            PG8_STAGE(PG8_SB(0, 1), b2 + hstep, voffA);
            PG8_WAIT_V(6); PG8_BAR; PG8_MMA(1, 1, At, B1); PG8_BAR;
            PG8_LDB(B0, 1, 0); PG8_SCHED; PG8_LDA(At, 1, 0); PG8_STAGE(PG8_SA(0, 1), a2 + hstep, voffA);
            PG8_WAIT_L(8); PG8_BAR; PG8_WAIT_L(0); PG8_MMA(0, 0, At, B0); PG8_BAR; PG8_SCHED;
            PG8_LDB(B1, 1, 1); PG8_STAGE(PG8_SB(1, 0), b3, voffA);
            PG8_BAR; PG8_WAIT_L(0); PG8_MMA(0, 1, At, B1); PG8_BAR;
            PG8_LDA(At, 1, 1); PG8_STAGE(PG8_SA(1, 0), a3, voffA);
            PG8_BAR; PG8_WAIT_L(0); PG8_MMA(1, 0, At, B0); PG8_BAR; PG8_SCHED;
            PG8_STAGE(PG8_SB(1, 1), b3 + hstep, voffA);
            PG8_WAIT_V(6); PG8_BAR; PG8_MMA(1, 1, At, B1); PG8_BAR;
        }
        E(acc, cur, wr, wc, fr, fq);
        if (!has_next) break;
#pragma unroll
        for (int a = 0; a < 2; ++a)
#pragma unroll
            for (int b = 0; b < 2; ++b)
#pragma unroll
                for (int m = 0; m < 4; ++m)
#pragma unroll
                    for (int n = 0; n < 2; ++n) acc[a][b][m][n] = (f32x4){0.f, 0.f, 0.f, 0.f};
        cur = nxt; cA = nA; cB = nB; ++ui;
    }
    PG8_WAIT_V(0);
    if (wr == 0) PG8_BAR;
    PG8_BAR;
#undef PG8_SA
#undef PG8_SB
#undef PG8_STAGE
#undef PG8_LDA
#undef PG8_LDB
#undef PG8_MMA
#undef PG8_WAIT_V
#undef PG8_WAIT_L
#undef PG8_BAR
#undef PG8_SCHED
}

__device__ __forceinline__ float* kv_out_ptr(float* out, int r, int gi, bool& ok) {
    const int keep = 128 << (2 * gi);
    ok = false;
    if (r < MP) {
        const int b = r >> 12, t = r & 4095;
        if (t < SEQ - keep) return out;
        ok = true;
        const size_t base = gi == 0 ? O_KVP0 : (gi == 1 ? O_KVP1 : O_KVP2);
        return out + base + ((size_t)(b * keep + t - (SEQ - keep))) * 1024;
    }
    if (r < MT) {
        const int b = (r - MP) >> 2, t = (r - MP) & 3;
        ok = true;
        const size_t base = gi == 0 ? O_KVS0 : (gi == 1 ? O_KVS1 : O_KVS2);
        return out + base + ((size_t)(b * keep + keep - 4 + t)) * 1024;
    }
    return out;
}

struct EpiIn {
    bf16_t *Qb, *Kb, *Vb; float* U; const float* rope; float* out;
    __device__ __forceinline__ void operator()(const f32x4 (&acc)[2][2][4][2], const Unit& u, int wr, int wc, int fr, int fq) const {
        const int pn = u.pn;
#pragma unroll
        for (int ai = 0; ai < 2; ++ai)
#pragma unroll
            for (int m = 0; m < 4; ++m) {
                const int r = u.pm * 256 + ai * 128 + wr * 64 + m * 16 + fr;
                if (pn < 12) {
                    const int pidx = r < MP ? (r & 4095) : (r < MT ? 4096 + ((r - MP) & 3) : 0);
                    const f32x4* rp = (const f32x4*)(rope + ((size_t)pidx * 64 + 16 * wc + 4 * fq) * 2);
                    const f32x4 cs0 = rp[0], cs1 = rp[1];
                    const f32x4 c = {cs0[0], cs0[2], cs1[0], cs1[2]}, s = {cs0[1], cs0[3], cs1[1], cs1[3]};
                    const int col = 16 * wc + 4 * fq;
#pragma unroll
                    for (int bj = 0; bj < 2; ++bj) {
                        const f32x4 x1 = acc[ai][bj][m][0], x2 = acc[ai][bj][m][1];
                        f32x4 o1 = x1 * c - x2 * s, o2 = x2 * c + x1 * s;
                        const int hq = 2 * pn + bj;
                        if (pn < 6) {
                            o1 = o1 * QSCALE; o2 = o2 * QSCALE;
                            bf16_t* dst = Qb + (size_t)r * AW + hq * 128 + col;
                            *(u32x2*)dst = pack4(o1); *(u32x2*)(dst + 64) = pack4(o2);
                        } else {
                            const int hk = hq - 12;
                            bf16_t* dst = Kb + (size_t)r * AW + hk * 128 + col;
                            *(u32x2*)dst = pack4(o1); *(u32x2*)(dst + 64) = pack4(o2);
                            bool ok; float* o = kv_out_ptr(out, r, hk >> 2, ok);
                            if (ok) { o += (hk & 3) * 128 + col; *(f32x4*)o = o1; *(f32x4*)(o + 64) = o2; }
                        }
                    }
                } else if (pn < 18) {
                    const int col = 32 * wc + 8 * fq;
#pragma unroll
                    for (int bj = 0; bj < 2; ++bj) {
                        const int hv = 2 * (pn - 12) + bj;
                        const f32x4 v0 = acc[ai][bj][m][0], v1 = acc[ai][bj][m][1];
                        *(u32x4*)(Vb + (size_t)r * AW + hv * 128 + col) = pack8(v0, v1);
                        bool ok; float* o = kv_out_ptr(out, r, hv >> 2, ok);
                        if (ok) { o += 512 + (hv & 3) * 128 + col; *(f32x4*)o = v0; *(f32x4*)(o + 4) = v1; }
                    }
                } else {
                    const int ch = 128 * (pn - 18) + 32 * wc + 8 * fq;
                    f32x4 u0, u1;
#pragma unroll
                    for (int e = 0; e < 4; ++e) { u0[e] = acc[ai][0][m][0][e] * fast_sigmoid(acc[ai][1][m][0][e]); u1[e] = acc[ai][0][m][1][e] * fast_sigmoid(acc[ai][1][m][1][e]); }
                    float* up = U + (size_t)r * CCH + ch;
                    *(f32x4*)up = u0; *(f32x4*)(up + 4) = u1;
                    float* o = nullptr;
                    if (r < MP) { const int b = r >> 12, t = r & 4095; if (t >= SEQ - 30) o = out + O_CONVP + ((size_t)(b * 30 + t - (SEQ - 30))) * CCH + ch; }
                    else if (r < MT) { const int b = (r - MP) >> 2, t = (r - MP) & 3; o = out + O_CONVS + ((size_t)(b * 30 + 26 + t)) * CCH + ch; }
                    if (o) { *(f32x4*)o = u0; *(f32x4*)(o + 4) = u1; }
                }
            }
    }
};
struct EpiOut {
    const float *xp, *xs; float* Z;
    __device__ __forceinline__ void operator()(const f32x4 (&acc)[2][2][4][2], const Unit& u, int wr, int wc, int fr, int fq) const {
#pragma unroll
        for (int ai = 0; ai < 2; ++ai)
#pragma unroll
            for (int m = 0; m < 4; ++m) {
                const int r = u.pm * 256 + ai * 128 + wr * 64 + m * 16 + fr;
                const float* xrow = r < MP ? xp + (size_t)r * DM : (r < MT ? xs + (size_t)(r - MP) * DM : nullptr);
#pragma unroll
                for (int bj = 0; bj < 2; ++bj)
#pragma unroll
                    for (int n = 0; n < 2; ++n) {
                        const int col = u.pn * 256 + bj * 128 + wc * 32 + n * 16 + 4 * fq;
                        f32x4 xv = {0.f, 0.f, 0.f, 0.f}; if (xrow) xv = *(const f32x4*)(xrow + col);
                        *(f32x4*)(Z + (size_t)r * DM + col) = xv * ALPHA + acc[ai][bj][m][n];
                    }
            }
    }
};
struct EpiGU {
    bf16_t* H;
    __device__ __forceinline__ void operator()(const f32x4 (&acc)[2][2][4][2], const Unit& u, int wr, int wc, int fr, int fq) const {
#pragma unroll
        for (int ai = 0; ai < 2; ++ai)
#pragma unroll
            for (int m = 0; m < 4; ++m) {
                const int r = u.pm * 256 + ai * 128 + wr * 64 + m * 16 + fr;
                const int col = 128 * u.pn + 32 * wc + 8 * fq;
                f32x4 h0, h1;
#pragma unroll
                for (int e = 0; e < 4; ++e) {
                    const float g0 = acc[ai][0][m][0][e], g1 = acc[ai][0][m][1][e];
                    h0[e] = g0 * fast_sigmoid(g0) * acc[ai][1][m][0][e]; h1[e] = g1 * fast_sigmoid(g1) * acc[ai][1][m][1][e];
                }
                *(u32x4*)(H + (size_t)r * FH + col) = pack8(h0, h1);
            }
    }
};
struct EpiDown {
    const float* X1; float* Y;
    __device__ __forceinline__ void operator()(const f32x4 (&acc)[2][2][4][2], const Unit& u, int wr, int wc, int fr, int fq) const {
#pragma unroll
        for (int ai = 0; ai < 2; ++ai)
#pragma unroll
            for (int m = 0; m < 4; ++m) {
                const int r = u.pm * 256 + ai * 128 + wr * 64 + m * 16 + fr;
                if (r < MT) {
#pragma unroll
                    for (int bj = 0; bj < 2; ++bj)
#pragma unroll
                        for (int n = 0; n < 2; ++n) {
                            const int col = u.pn * 256 + bj * 128 + wc * 32 + n * 16 + 4 * fq;
                            const f32x4 xv = *(const f32x4*)(X1 + (size_t)r * DM + col);
                            *(f32x4*)(Y + (size_t)r * DM + col) = xv * ALPHA + acc[ai][bj][m][n];
                        }
                }
            }
    }
};

__device__ __forceinline__ int perm8(int s) { return 8 * ((s >> 2) & 3) + 4 * ((s >> 4) & 1) + (s & 3); }
__device__ __forceinline__ int src_col_in(int np) {
    const int pn = np >> 8, bj = (np >> 7) & 1, s = np & 127;
    if (pn < 12) { const int wc = s >> 5, n = (s >> 4) & 1, q4 = s & 15; return (2 * pn + bj) * 128 + 64 * n + 16 * wc + q4; }
    if (pn < 18) return (2 * pn + bj) * 128 + (s & ~31) + perm8(s & 31);
    return (bj ? 5120 : 4608) + 128 * (pn - 18) + (s & ~31) + perm8(s & 31);
}
__device__ __forceinline__ void cvt_tile(const float* W, int ldw, int K, int srccol, bf16_t* Bt, int n0, int k0, LAS unsigned* scr) {
    const int tid = threadIdx.x, lane = tid & 63, w = tid >> 6;
    float v[8];
#pragma unroll
    for (int j = 0; j < 4; ++j) { const int kp = w + 8 * j; v[2 * j] = W[(size_t)(k0 + 2 * kp) * ldw + srccol]; v[2 * j + 1] = W[(size_t)(k0 + 2 * kp + 1) * ldw + srccol]; }
#pragma unroll
    for (int j = 0; j < 4; ++j) scr[lane * 33 + w + 8 * j] = cvt_pk_bf16(v[2 * j], v[2 * j + 1]);
    __syncthreads();
    { const int i = tid >> 3, c = tid & 7; const LAS unsigned* s = scr + i * 33 + 4 * c; u32x4 o; o.x = s[0]; o.y = s[1]; o.z = s[2]; o.w = s[3];
      *(u32x4*)(Bt + (size_t)(n0 + i) * K + k0 + 8 * c) = o; }
    __syncthreads();
}
__device__ __forceinline__ void phase_convert(const Params& p, LAS unsigned char* lds) {
    const int tid = threadIdx.x, G = gridDim.x, bid = blockIdx.x;
    unsigned char* ws = p.ws;
    { bf16_t* Xb = (bf16_t*)(ws + WS_XB);
      for (size_t i = (size_t)bid * 512 + tid; i < (size_t)MT * DM / 8; i += (size_t)G * 512) {
          const size_t e = i * 8; const float* src = e < (size_t)MP * DM ? p.xp + e : p.xs + (e - (size_t)MP * DM);
          const f32x4 a = *(const f32x4*)src, b = *(const f32x4*)(src + 4);
          *(u32x4*)(Xb + e) = pack8(a, b); } }
    { float* rope = (float*)(ws + WS_ROPE);
      for (int i = bid * 512 + tid; i < 4100 * 64; i += G * 512) {
          const int pr = i >> 6, k = i & 63; const double pos = pr < 4096 ? (double)pr : (double)(16384 + pr - 4096);
          const double inv = exp2(-(double)k * (13.287712379549449 / 64.0));
          double sn, cs; sincos(pos * inv, &sn, &cs);
          rope[2 * i] = (float)cs; rope[2 * i + 1] = (float)sn; } }
    { LAS unsigned* scr = (LAS unsigned*)lds;
      constexpr int T_IN = (NIN / 64) * (DM / 64), T_OUT = (DM / 64) * (DM / 64), T_GU = (2 * FH / 64) * (DM / 64), T_D = (DM / 64) * (FH / 64);
      const int lane = tid & 63;
      for (int it = bid; it < T_IN + T_OUT + T_GU + T_D; it += G) {
          int r = it;
          if (r < T_IN) { const int nb = r / (DM / 64), kb = r % (DM / 64); cvt_tile(p.w_in, NIN, DM, src_col_in(nb * 64 + lane), (bf16_t*)(ws + WS_WIN), nb * 64, kb * 64, scr); continue; }
          r -= T_IN;
          if (r < T_OUT) { const int nb = r / (DM / 64), kb = r % (DM / 64); cvt_tile(p.w_out, DM, DM, nb * 64 + lane, (bf16_t*)(ws + WS_WOUT), nb * 64, kb * 64, scr); continue; }
          r -= T_OUT;
          if (r < T_GU) { const int nb = r / (DM / 64), kb = r % (DM / 64); const int np = nb * 64 + lane, pn = np >> 8, bj = (np >> 7) & 1, s = np & 127;
              cvt_tile(bj ? p.w_up : p.w_gate, FH, DM, 128 * pn + (s & ~31) + perm8(s & 31), (bf16_t*)(ws + WS_WGU), nb * 64, kb * 64, scr); continue; }
          r -= T_GU;
          { const int nb = r / (FH / 64), kb = r % (FH / 64); cvt_tile(p.w_down, DM, FH, nb * 64 + lane, (bf16_t*)(ws + WS_WD), nb * 64, kb * 64, scr); }
      } }
    { const size_t gt = (size_t)bid * 512 + tid, gs = (size_t)G * 512;
      for (int gi = 0; gi < 3; ++gi) {
          const int buf = 128 << (2 * gi); const float* src = gi == 0 ? p.c0 : (gi == 1 ? p.c1 : p.c2);
          float* dst = p.out + (gi == 0 ? O_KVS0 : (gi == 1 ? O_KVS1 : O_KVS2));
          const size_t per_b = (size_t)(buf - 4) * 256;
          for (size_t i = gt; i < 8 * per_b; i += gs) { const size_t b = i / per_b, o = i % per_b;
              ((f32x4*)dst)[b * buf * 256 + o] = ((const f32x4*)src)[b * buf * 256 + 4 * 256 + o]; } }
      const size_t per_b = 26 * 128;
      for (size_t i = gt; i < 8 * per_b; i += gs) { const size_t b = i / per_b, o = i % per_b;
          ((f32x4*)(p.out + O_CONVS))[b * 30 * 128 + o] = ((const f32x4*)p.sconv)[b * 30 * 128 + 4 * 128 + o]; } }
}

__device__ __forceinline__ unsigned off_b(unsigned row, unsigned ch) { return 256u * row + 16u * (ch ^ (((row & 3) << 2) | ((row >> 2) & 3))); }

__device__ __forceinline__ void attn_prompt_item(const Params& p, LAS unsigned char* lds, int item) {
    const int tid = threadIdx.x, w = tid >> 6, lane = tid & 63, fr = lane & 15, fq = lane >> 4;
    const int blk = item & 31, hs = (item >> 5) & 3, g = (item >> 7) % 3, b = item / 384;
    const int dsh = 2 * g, d = 1 << dsh, rcls = blk & (d - 1), n = blk >> dsh, head = g * 4 + hs;
    const bf16_t* Qb = (const bf16_t*)(p.ws + WS_Q); const bf16_t* Kb = (const bf16_t*)(p.ws + WS_K); const bf16_t* Vb = (const bf16_t*)(p.ws + WS_V);
    bf16_t* AO = (bf16_t*)(p.ws + WS_AO); float* LSE = (float*)(p.ws + WS_LSE);
    {
        const int ch = tid & 15, r0 = tid >> 4;
        u32x4 kv[8], vv[8];
#pragma unroll
        for (int i = 0; i < 8; ++i) {
            const int row = r0 + 32 * i, j = 128 * (n - 1) + row;
            kv[i] = (u32x4){0u, 0u, 0u, 0u}; vv[i] = kv[i];
            if (j >= 0) { const size_t gi = ((size_t)(b * SEQ + j * d + rcls)) * AW + head * 128 + ch * 8; kv[i] = *(const u32x4*)(Kb + gi); vv[i] = *(const u32x4*)(Vb + gi); }
        }
#pragma unroll
        for (int i = 0; i < 8; ++i) { const int row = r0 + 32 * i; *(LAS u32x4*)(lds + off_b(row, ch)) = kv[i]; *(LAS u32x4*)(lds + 65536 + off_b(row, ch)) = vv[i]; }
    }
    const int qi = 16 * w + fr;
    const size_t qrow = (size_t)(b * SEQ + (128 * n + qi) * d + rcls);
    bf16x8 qf[4];
#pragma unroll
    for (int ks = 0; ks < 4; ++ks) qf[ks] = *(const bf16x8*)(Qb + qrow * AW + head * 128 + 32 * ks + 8 * fq);
    __syncthreads();
    f32x4 s[9];
#pragma unroll
    for (int tt = 0; tt < 9; ++tt) {
        const int T = w + tt; s[tt] = (f32x4){0.f, 0.f, 0.f, 0.f};
#pragma unroll
        for (int ks = 0; ks < 4; ++ks) { const bf16x8 kf = *(const LAS bf16x8*)(lds + off_b(16 * T + fr, 4 * ks + fq)); s[tt] = __builtin_amdgcn_mfma_f32_16x16x32_bf16(kf, qf[ks], s[tt], 0, 0, 0); }
    }
    const int kmin = n == 0 ? 128 : 0;
    float mx = -3.0e38f;
#pragma unroll
    for (int tt = 0; tt < 9; ++tt)
#pragma unroll
        for (int e = 0; e < 4; ++e) { const int kk = 16 * (w + tt) + 4 * fq + e; const bool ok = kk >= qi && kk <= qi + 128 && kk >= kmin; s[tt][e] = ok ? s[tt][e] : -3.0e38f; mx = fmaxf(mx, s[tt][e]); }
    mx = fmaxf(mx, __shfl_xor(mx, 16)); mx = fmaxf(mx, __shfl_xor(mx, 32));
    float den = 0.f;
#pragma unroll
    for (int tt = 0; tt < 9; ++tt)
#pragma unroll
        for (int e = 0; e < 4; ++e) { const float pv = __builtin_amdgcn_exp2f(s[tt][e] - mx); s[tt][e] = pv; den += pv; }
    den += __shfl_xor(den, 16); den += __shfl_xor(den, 32);
    f32x4 o[8];
#pragma unroll
    for (int dt = 0; dt < 8; ++dt) o[dt] = (f32x4){0.f, 0.f, 0.f, 0.f};
    const int q4 = (lane & 15) >> 2, p4 = lane & 3;
#pragma unroll
    for (int ku = 0; ku < 5; ++ku) {
        const int T0 = w + 2 * ku, T1 = ku < 4 ? T0 + 1 : T0;
        union { bf16x8 v; unsigned u[4]; } pf;
        pf.u[0] = cvt_pk_bf16(s[2 * ku][0], s[2 * ku][1]); pf.u[1] = cvt_pk_bf16(s[2 * ku][2], s[2 * ku][3]);
        if (ku < 4) { pf.u[2] = cvt_pk_bf16(s[2 * ku + 1][0], s[2 * ku + 1][1]); pf.u[3] = cvt_pk_bf16(s[2 * ku + 1][2], s[2 * ku + 1][3]); } else { pf.u[2] = 0u; pf.u[3] = 0u; }
#pragma unroll
        for (int dt = 0; dt < 8; ++dt) {
            union { bf16x8 v; bf16x4 h[2]; } vf;
            vf.h[0] = __builtin_amdgcn_ds_read_tr16_b64_v4i16((LAS bf16x4*)(lds + 65536 + off_b(16 * T0 + 4 * fq + q4, 2 * dt + (p4 >> 1)) + 8 * (p4 & 1)));
            vf.h[1] = __builtin_amdgcn_ds_read_tr16_b64_v4i16((LAS bf16x4*)(lds + 65536 + off_b(16 * T1 + 4 * fq + q4, 2 * dt + (p4 >> 1)) + 8 * (p4 & 1)));
            o[dt] = __builtin_amdgcn_mfma_f32_16x16x32_bf16(vf.v, pf.v, o[dt], 0, 0, 0);
        }
    }
    const float rden = 1.0f / den;
    bf16_t* orow = AO + qrow * DM + head * 128 + 4 * fq;
#pragma unroll
    for (int dt = 0; dt < 8; ++dt) *(u32x2*)(orow + 16 * dt) = pack4(o[dt] * rden);
    if (fq == 0) LSE[qrow * 12 + head] = mx + __builtin_amdgcn_logf(den);
    __syncthreads();
}

__device__ __forceinline__ void attn_sample_item(const Params& p, LAS unsigned char* lds, int item) {
    const int tid = threadIdx.x;
    const int hs = item & 3, g = (item >> 2) % 3, b = item / 12, d = 1 << (2 * g), buf = 128 * d, head = g * 4 + hs;
    const float* cache = g == 0 ? p.c0 : (g == 1 ? p.c1 : p.c2);
    const float* okv = p.out + (g == 0 ? O_KVS0 : (g == 1 ? O_KVS1 : O_KVS2));
    LAS float* qs = (LAS float*)lds;
    LAS float* sc = qs + 512;
    LAS float* st = sc + 4 * 132;
    const bf16_t* Qb = (const bf16_t*)(p.ws + WS_Q);
    const int t = tid >> 7, j = tid & 127;
    const size_t row = (size_t)MP + b * 4 + t;
    qs[tid] = bf2f(Qb[row * AW + head * 128 + j]);
    __syncthreads();
    for (int jj = j; jj <= 128; jj += 128) {
        const int idx = buf + t - d * jj;
        const float* kr = (idx < buf ? cache + ((size_t)(b * buf + idx)) * 1024 : okv + ((size_t)(b * buf + idx - 4)) * 1024) + hs * 128;
        float dot = 0.f;
#pragma unroll 8
        for (int c = 0; c < 32; ++c) { const f32x4 kv = *(const f32x4*)(kr + 4 * c); const LAS float* qq = qs + t * 128 + 4 * c; dot += kv[0] * qq[0] + kv[1] * qq[1] + kv[2] * qq[2] + kv[3] * qq[3]; }
        sc[t * 132 + jj] = dot;
    }
    __syncthreads();
    if (tid < 256) {
        const int tw = tid >> 6, lane = tid & 63;
        const float a0 = sc[tw * 132 + lane], a1 = sc[tw * 132 + 64 + lane], a2 = lane == 0 ? sc[tw * 132 + 128] : -3.0e38f;
        const float mx = wave_max(fmaxf(fmaxf(a0, a1), a2));
        const float e0 = __builtin_amdgcn_exp2f(a0 - mx), e1 = __builtin_amdgcn_exp2f(a1 - mx), e2 = lane == 0 ? __builtin_amdgcn_exp2f(a2 - mx) : 0.f;
        const float den = wave_sum(e0 + e1 + e2);
        sc[tw * 132 + lane] = e0; sc[tw * 132 + 64 + lane] = e1; if (lane == 0) { sc[tw * 132 + 128] = e2; st[tw * 2] = den; st[tw * 2 + 1] = mx + __builtin_amdgcn_logf(den); }
    }
    __syncthreads();
    {
        float acc = 0.f;
#pragma unroll 4
        for (int jj = 0; jj <= 128; ++jj) {
            const int idx = buf + t - d * jj;
            const float* vr = (idx < buf ? cache + ((size_t)(b * buf + idx)) * 1024 : okv + ((size_t)(b * buf + idx - 4)) * 1024) + 512 + hs * 128;
            acc += sc[t * 132 + jj] * vr[j];
        }
        bf16_t* AO = (bf16_t*)(p.ws + WS_AO);
        const unsigned pk = cvt_pk_bf16(acc / st[t * 2], 0.f);
        AO[row * DM + head * 128 + j] = (bf16_t)(pk & 0xffffu);
        if (j == 0) ((float*)(p.ws + WS_LSE))[row * 12 + head] = st[t * 2 + 1];
    }
    __syncthreads();
}

__device__ __forceinline__ void conv_item(const Params& p, LAS unsigned char* lds, int item) {
    const int tid = threadIdx.x, ch = tid;
    const float* U = (const float*)(p.ws + WS_U);
    const bool samp = item >= 256;
    const int b = samp ? item - 256 : item >> 7, t0 = samp ? 0 : (item & 127) * 32;
    float wgt[31];
#pragma unroll
    for (int j = 0; j < 31; ++j) wgt[j] = p.conv_w[j * CCH + ch];
    float acc[32];
    const float bias = p.conv_b[ch];
#pragma unroll
    for (int t = 0; t < 32; ++t) acc[t] = bias;
#pragma unroll
    for (int rr = 0; rr < 62; ++rr) {
        float uv = 0.f;
        if (!samp) { const int tok = t0 - 30 + rr; if (tok >= 0) uv = U[((size_t)(b * SEQ + tok)) * CCH + ch]; }
        else { if (rr < 30) uv = p.sconv[((size_t)(b * 30 + rr)) * CCH + ch]; else if (rr < 34) uv = U[((size_t)(MP + b * 4 + rr - 30)) * CCH + ch]; }
#pragma unroll
        for (int t = 0; t < 32; ++t) { const int j = rr - t; if (j >= 0 && j <= 30) acc[t] += wgt[j] * uv; }
    }
    LAS float* ct = (LAS float*)lds;
#pragma unroll
    for (int t = 0; t < 32; ++t) ct[t * CCH + ch] = acc[t];
    __syncthreads();
    {
        const int w = tid >> 6, lane = tid & 63;
        bf16_t* AO = (bf16_t*)(p.ws + WS_AO);
        const int ntok = samp ? 4 : 32;
        for (int tt = 0; tt < 4; ++tt) {
            const int t = 4 * w + tt;
            if (t < ntok) {
                float x[8]; float sm = 0.f;
#pragma unroll
                for (int i = 0; i < 8; ++i) { x[i] = ct[t * CCH + lane + 64 * i]; sm += x[i]; }
                const float mean = wave_sum(sm) * (1.0f / CCH); float s2 = 0.f;
#pragma unroll
                for (int i = 0; i < 8; ++i) { x[i] -= mean; s2 += x[i] * x[i]; }
                const float rstd = rsqrtf(wave_sum(s2) * (1.0f / CCH) + LN_EPS);
                const size_t row = samp ? (size_t)MP + b * 4 + t : (size_t)b * SEQ + t0 + t;
#pragma unroll
                for (int i = 0; i < 8; ++i) { const int c = lane + 64 * i; float y = x[i] * rstd * p.cln_g[c] + p.cln_b[c]; y = y * fast_sigmoid(y);
                    AO[row * DM + AW + c] = (bf16_t)(cvt_pk_bf16(y, 0.f) & 0xffffu); }
            }
        }
    }
    __syncthreads();
}

__device__ __forceinline__ void phase_mixers(const Params& p, LAS unsigned char* lds) {
    constexpr int N_AP = 2 * 3 * 4 * 32, N_AS = 8 * 12, N_CV = 256 + 8;
    const int G = gridDim.x;
    for (int it = blockIdx.x; it < N_AP; it += G) attn_prompt_item(p, lds, it);
    for (int it = (blockIdx.x + N_AS) % G; it < N_AS; it += G) attn_sample_item(p, lds, it);
    for (int it = blockIdx.x; it < N_CV; it += G) conv_item(p, lds, it);
}

__device__ __forceinline__ void phase_alpha(const Params& p) {
    bf16_t* AO = (bf16_t*)(p.ws + WS_AO); const float* LSE = (const float*)(p.ws + WS_LSE);
    for (size_t i = (size_t)blockIdx.x * 512 + threadIdx.x; i < (size_t)MT * 12 * 16; i += (size_t)gridDim.x * 512) {
        const int c = (int)(i & 15), s = (int)((i >> 4) % 12); const size_t row = i / 192;
        const int g = s >> 2, hs = s & 3;
        const float l0 = LSE[row * 12 + hs], l1 = LSE[row * 12 + 4 + hs], l2 = LSE[row * 12 + 8 + hs];
        const float mx = fmaxf(l0, fmaxf(l1, l2));
        const float e0 = __builtin_amdgcn_exp2f(l0 - mx), e1 = __builtin_amdgcn_exp2f(l1 - mx), e2 = __builtin_amdgcn_exp2f(l2 - mx);
        const float al = (g == 0 ? e0 : (g == 1 ? e1 : e2)) / (e0 + e1 + e2);
        u32x4* ptr = (u32x4*)(AO + row * DM + s * 128 + c * 8);
        u32x4 v = *ptr;
#pragma unroll
        for (int k = 0; k < 4; ++k) { const float lo = __uint_as_float(v[k] << 16) * al, hi = __uint_as_float(v[k] & 0xffff0000u) * al; v[k] = cvt_pk_bf16(lo, hi); }
        *ptr = v;
    }
}

__device__ __forceinline__ void phase_ln(const float* src, float* dstf, bf16_t* dstb, const float* gam, const float* bet) {
    const int lane = threadIdx.x & 63, gw = blockIdx.x * 8 + (threadIdx.x >> 6), NW = gridDim.x * 8;
    f32x4 gv[8], bv[8];
#pragma unroll
    for (int j = 0; j < 8; ++j) { gv[j] = *(const f32x4*)(gam + 4 * lane + 256 * j); bv[j] = *(const f32x4*)(bet + 4 * lane + 256 * j); }
    for (int r = gw; r < MT; r += NW) {
        const float* xr = src + (size_t)r * DM + 4 * lane;
        f32x4 v[8]; float sm = 0.f;
#pragma unroll
        for (int j = 0; j < 8; ++j) { v[j] = *(const f32x4*)(xr + 256 * j); sm += (v[j][0] + v[j][1]) + (v[j][2] + v[j][3]); }
        const float mean = wave_sum(sm) * (1.0f / DM); float s2 = 0.f;
#pragma unroll
        for (int j = 0; j < 8; ++j) { v[j] = v[j] - mean; s2 += (v[j][0] * v[j][0] + v[j][1] * v[j][1]) + (v[j][2] * v[j][2] + v[j][3] * v[j][3]); }
        const float rstd = rsqrtf(wave_sum(s2) * (1.0f / DM) + LN_EPS);
#pragma unroll
        for (int j = 0; j < 8; ++j) {
            const f32x4 y = v[j] * rstd * gv[j] + bv[j];
            if (dstf) *(f32x4*)(dstf + (size_t)r * DM + 4 * lane + 256 * j) = y;
            if (dstb) *(u32x2*)(dstb + (size_t)r * DM + 4 * lane + 256 * j) = pack4(y);
        }
    }
}

template <int MASK>
__global__ void __launch_bounds__(512, 2) fwd_kernel(Params p) {
    extern __shared__ __attribute__((aligned(16))) unsigned char shm[];
    LAS unsigned char* lds = (LAS unsigned char*)shm;
    unsigned char* ws = p.ws;
#define PH(k) if constexpr ((MASK >> (k)) & 1)
#define SYNC(k) if constexpr (((MASK >> (k)) & 1) && (MASK & ((1 << (k)) - 1))) cg::this_grid().sync();
    PH(0) phase_convert(p, lds);
    SYNC(1)
    PH(1) { Gemm g{(const bf16_t*)(ws + WS_XB), (const bf16_t*)(ws + WS_WIN), MPAD, NIN, DM}; StaticOrder S; S.init(MPAD, NIN, gridDim.x, blockIdx.x);
            EpiIn E{(bf16_t*)(ws + WS_Q), (bf16_t*)(ws + WS_K), (bf16_t*)(ws + WS_V), (float*)(ws + WS_U), (const float*)(ws + WS_ROPE), p.out};
            gemm_phase(lds, g, S, E); }
    SYNC(2)
    PH(2) phase_mixers(p, lds);
    SYNC(3)
    PH(3) phase_alpha(p);
    SYNC(4)
    PH(4) { Gemm g{(const bf16_t*)(ws + WS_AO), (const bf16_t*)(ws + WS_WOUT), MPAD, DM, DM}; StaticOrder S; S.init(MPAD, DM, gridDim.x, blockIdx.x);
            EpiOut E{p.xp, p.xs, (float*)(ws + WS_Z1)}; gemm_phase(lds, g, S, E); }
    SYNC(5)
    PH(5) phase_ln((const float*)(ws + WS_Z1), (float*)(ws + WS_Z1), (bf16_t*)(ws + WS_AO), p.ln1_g, p.ln1_b);
    SYNC(6)
    PH(6) { Gemm g{(const bf16_t*)(ws + WS_AO), (const bf16_t*)(ws + WS_WGU), MPAD, 2 * FH, DM}; StaticOrder S; S.init(MPAD, 2 * FH, gridDim.x, blockIdx.x);
            EpiGU E{(bf16_t*)(ws + WS_H)}; gemm_phase(lds, g, S, E); }
    SYNC(7)
    PH(7) { Gemm g{(const bf16_t*)(ws + WS_H), (const bf16_t*)(ws + WS_WD), MPAD, DM, FH}; StaticOrder S; S.init(MPAD, DM, gridDim.x, blockIdx.x);
            EpiDown E{(const float*)(ws + WS_Z1), p.out}; gemm_phase(lds, g, S, E); }
    SYNC(8)
    PH(8) phase_ln(p.out, p.out, nullptr, p.ln2_g, p.ln2_b);
#undef PH
#undef SYNC
}

#ifndef N_LAUNCH_MODE
#define N_LAUNCH_MODE 1
#endif
template <int MASK> static void launch_plain(const Params& p, int grid, hipStream_t stream) {
    static bool attr = false;
    if (!attr) { (void)hipFuncSetAttribute((const void*)fwd_kernel<MASK>, hipFuncAttributeMaxDynamicSharedMemorySize, STAGE_BYTES); attr = true; }
    hipLaunchKernelGGL(fwd_kernel<MASK>, dim3(grid), dim3(512), STAGE_BYTES, stream, p);
}
extern "C" void kernel_launch(void* const* d_in, const int* in_sizes, int n_in, void* d_out, int out_size, void* d_ws, size_t ws_size, hipStream_t stream) {
    static int grid = 0;
    if (grid == 0) {
        if (n_in != 19 || (size_t)out_size != O_END || ws_size < WS_END) { fprintf(stderr, "kernel_launch: unexpected shapes: n_in %d out %d ws %zu (need %zu)\n", n_in, out_size, ws_size, (size_t)WS_END); grid = -1; return; }
        int dev = 0, cus = 0, per_cu = 0;
        (void)hipGetDevice(&dev); (void)hipDeviceGetAttribute(&cus, hipDeviceAttributeMultiprocessorCount, dev);
#if N_LAUNCH_MODE == 1
        if (hipFuncSetAttribute((const void*)fwd_kernel<0x1FF>, hipFuncAttributeMaxDynamicSharedMemorySize, STAGE_BYTES) != hipSuccess) { fprintf(stderr, "kernel_launch: hipFuncSetAttribute failed\n"); grid = -1; return; }
        if (hipOccupancyMaxActiveBlocksPerMultiprocessor(&per_cu, (const void*)fwd_kernel<0x1FF>, 512, STAGE_BYTES) != hipSuccess || per_cu < 1) { fprintf(stderr, "kernel_launch: occupancy query failed (%d)\n", per_cu); (void)hipGetLastError(); }
#endif
        grid = cus;
        fprintf(stderr, "kernel_launch: grid %d (per_cu %d)\n", grid, per_cu);
    }
    if (grid < 0) return;
    Params p{};
    p.xp = (const float*)d_in[0]; p.xs = (const float*)d_in[1]; p.c0 = (const float*)d_in[2]; p.c1 = (const float*)d_in[3]; p.c2 = (const float*)d_in[4]; p.sconv = (const float*)d_in[5];
    p.w_in = (const float*)d_in[6]; p.w_out = (const float*)d_in[7]; p.conv_w = (const float*)d_in[8]; p.conv_b = (const float*)d_in[9]; p.cln_g = (const float*)d_in[10]; p.cln_b = (const float*)d_in[11];
    p.ln1_g = (const float*)d_in[12]; p.ln1_b = (const float*)d_in[13]; p.w_gate = (const float*)d_in[14]; p.w_up = (const float*)d_in[15]; p.w_down = (const float*)d_in[16]; p.ln2_g = (const float*)d_in[17]; p.ln2_b = (const float*)d_in[18];
    p.out = (float*)d_out; p.ws = (unsigned char*)d_ws;
#if N_LAUNCH_MODE == 1
    void* args[] = {&p};
    hipError_t e = hipLaunchCooperativeKernel((const void*)fwd_kernel<0x1FF>, dim3(grid), dim3(512), args, STAGE_BYTES, stream);
    if (e != hipSuccess) fprintf(stderr, "cooperative launch failed: %s (grid %d)\n", hipGetErrorString(e), grid);
#else
    launch_plain<1>(p, grid, stream); launch_plain<2>(p, grid, stream); launch_plain<4>(p, grid, stream); launch_plain<8>(p, grid, stream); launch_plain<16>(p, grid, stream);
    launch_plain<32>(p, grid, stream); launch_plain<64>(p, grid, stream); launch_plain<128>(p, grid, stream); launch_plain<256>(p, grid, stream);
#endif
}
```

```cpp
#include <hip/hip_runtime.h>
#include <hip/hip_cooperative_groups.h>
#include <cstdio>
namespace cg = cooperative_groups;

#define LAS __attribute__((address_space(3)))
typedef unsigned short bf16_t;
typedef short bf16x8 __attribute__((ext_vector_type(8)));
typedef short bf16x4 __attribute__((ext_vector_type(4)));
typedef float f32x4 __attribute__((ext_vector_type(4)));
typedef unsigned u32x4 __attribute__((ext_vector_type(4)));
typedef unsigned u32x2 __attribute__((ext_vector_type(2)));

constexpr int DM = 2048, SEQ = 4096, MP = 8192, MS = 32, MT = MP + MS, MPAD = 8448;
constexpr int AW = 1536, CCH = 512, NIN = 5632, FH = 5632;
constexpr float ALPHA = 1.189207115002721f;
constexpr float LN_EPS = 1e-5f;
constexpr float QSCALE = 0.08838834764831845f * 1.4426950408889634f;

constexpr size_t O_KVP0 = (size_t)MT * DM;
constexpr size_t O_KVP1 = O_KVP0 + 2 * 128 * 1024;
constexpr size_t O_KVP2 = O_KVP1 + 2 * 512 * 1024;
constexpr size_t O_CONVP = O_KVP2 + 2 * 2048 * 1024;
constexpr size_t O_KVS0 = O_CONVP + 2 * 30 * 512;
constexpr size_t O_KVS1 = O_KVS0 + 8 * 128 * 1024;
constexpr size_t O_KVS2 = O_KVS1 + 8 * 512 * 1024;
constexpr size_t O_CONVS = O_KVS2 + (size_t)8 * 2048 * 1024;
constexpr size_t O_END = O_CONVS + 8 * 30 * 512;

constexpr size_t WS_WIN = 0;
constexpr size_t WS_WOUT = WS_WIN + (size_t)NIN * DM * 2;
constexpr size_t WS_WGU = WS_WOUT + (size_t)DM * DM * 2;
constexpr size_t WS_WD = WS_WGU + (size_t)2 * FH * DM * 2;
constexpr size_t WS_ROPE = WS_WD + (size_t)DM * FH * 2;
constexpr size_t WS_LSE = WS_ROPE + (size_t)4100 * 64 * 8;
constexpr size_t WS_R1 = WS_LSE + (size_t)MPAD * 12 * 4;
constexpr size_t WS_XB = WS_R1;
constexpr size_t WS_Q = WS_XB + (size_t)MPAD * DM * 2;
constexpr size_t WS_K = WS_Q + (size_t)MPAD * AW * 2;
constexpr size_t WS_V = WS_K + (size_t)MPAD * AW * 2;
constexpr size_t WS_U = WS_V + (size_t)MPAD * AW * 2;
constexpr size_t WS_R1END = WS_U + (size_t)MPAD * CCH * 4;
constexpr size_t WS_H = WS_R1;
constexpr size_t WS_AO = WS_R1END;
constexpr size_t WS_Z1 = WS_AO + (size_t)MPAD * DM * 2;
constexpr size_t WS_END = WS_Z1 + (size_t)MPAD * DM * 4;
static_assert((size_t)MPAD * FH * 2 <= WS_R1END - WS_R1, "H alias");

struct Params {
    const float *xp, *xs, *c0, *c1, *c2, *sconv, *w_in, *w_out, *conv_w, *conv_b, *cln_g, *cln_b, *ln1_g, *ln1_b, *w_gate, *w_up, *w_down, *ln2_g, *ln2_b;
    float* out; unsigned char* ws;
};

__device__ __forceinline__ unsigned cvt_pk_bf16(float lo, float hi) { unsigned r; asm volatile("v_cvt_pk_bf16_f32 %0, %1, %2" : "=v"(r) : "v"(lo), "v"(hi)); return r; }
__device__ __forceinline__ float bf2f(unsigned short b) { return __uint_as_float(((unsigned)b) << 16); }
__device__ __forceinline__ u32x2 pack4(f32x4 v) { u32x2 r; r.x = cvt_pk_bf16(v[0], v[1]); r.y = cvt_pk_bf16(v[2], v[3]); return r; }
__device__ __forceinline__ u32x4 pack8(f32x4 a, f32x4 b) { u32x4 r; r.x = cvt_pk_bf16(a[0], a[1]); r.y = cvt_pk_bf16(a[2], a[3]); r.z = cvt_pk_bf16(b[0], b[1]); r.w = cvt_pk_bf16(b[2], b[3]); return r; }
__device__ __forceinline__ float wave_sum(float v) {
#pragma unroll
    for (int o = 1; o < 64; o <<= 1) v += __shfl_xor(v, o);
    return v;
}
__device__ __forceinline__ float wave_max(float v) {
#pragma unroll
    for (int o = 1; o < 64; o <<= 1) v = fmaxf(v, __shfl_xor(v, o));
    return v;
}
__device__ __forceinline__ float fast_sigmoid(float g) { return 1.0f / (1.0f + __expf(-g)); }

constexpr int BM = 256, BK = 64, HALF = 128, HTB = HALF * BK * 2, STAGE_BYTES = 8 * HTB, NXCD = 8, WGM = 8;
__device__ __forceinline__ int lds_byte(int r, int c) { const int st = (r >> 4) * 2 + (c >> 5), rr = r & 15, cc = c & 31, ob = rr * 64 + cc * 2; return st * 1024 + (ob ^ (((ob >> 9) & 1) << 5)); }
__device__ __forceinline__ void stage_rc(int b, int& R, int& C) { const int st = b / 1024, sb = b % 1024, swz = sb ^ (((sb >> 9) & 1) << 5); R = (st >> 1) * 16 + swz / 64; C = (st & 1) * 32 + (swz % 64) / 2; }
struct Unit { int pm, pn; };
struct Gemm { const bf16_t* A; const bf16_t* Bt; int M, N, K; };
struct StaticOrder {
    int nM, nN, nwg, G, c;
    __device__ void init(int M, int N, int G_, int c_) { nM = M / BM; nN = N / BM; nwg = nM * nN; G = G_; c = c_; }
    __device__ bool next(int i, Unit& u) const {
        const long L = (long)i * G + c; if (L >= nwg) return false;
        int wgid = (int)L; { const int q = nwg / NXCD, r = nwg % NXCD, xcd = wgid % NXCD, off = wgid / NXCD; wgid = (xcd < r ? xcd * (q + 1) : r * (q + 1) + (xcd - r) * q) + off; }
        const int nig = WGM * nN, gid = wgid / nig, fm = gid * WGM, gsz = (nM - fm) < WGM ? (nM - fm) : WGM;
        u.pm = fm + ((wgid % nig) % gsz); u.pn = (wgid % nig) / gsz; return true;
    }
};

template <class Epi>
__device__ __forceinline__ void gemm_phase(LAS unsigned char* lds, const Gemm g, const StaticOrder& S, const Epi& E) {
    const int tid = threadIdx.x, wid = __builtin_amdgcn_readfirstlane(tid >> 6), lane = tid & 63, wr = wid >> 2, wc = wid & 3, fr = lane & 15, fq = lane >> 4;
    const int K = g.K, nt = K / BK;
    unsigned voffA[2];
#pragma unroll
    for (int i = 0; i < 2; ++i) { int R, C; stage_rc(tid * 16 + i * 8192, R, C); voffA[i] = (unsigned)(R * K + C) * 2u; }
    const size_t kstep = (size_t)(BK * 2);
    const size_t hstep = (size_t)HALF * K * 2;
    const size_t tstep = 2 * hstep;
    const unsigned ldsw = (unsigned)wid * 1024u;
    const int aoff = lds_byte(wr * 64 + fr, fq * 8), boff = lds_byte(wc * 32 + fr, fq * 8);
#define PG8_SA(b, h) (((b) * 2 + (h)) * HTB)
#define PG8_SB(b, h) ((4 + (b) * 2 + (h)) * HTB)
#define PG8_STAGE(bufoff, gbase, voff) do { _Pragma("unroll") for (int _i = 0; _i < 2; ++_i) \
        __builtin_amdgcn_global_load_lds((const unsigned*)((const char*)(gbase) + (voff)[_i]), (LAS unsigned*)(lds + (bufoff) + ldsw + _i * 8192), 16, 0, 0); } while (0)
#define PG8_LDA(dst, b, h) do { _Pragma("unroll") for (int m = 0; m < 4; ++m) _Pragma("unroll") for (int k = 0; k < 2; ++k) dst[m][k] = *(const LAS bf16x8*)(lds + PG8_SA(b, h) + aoff + m * 2048 + k * 1024); } while (0)
#define PG8_LDB(dst, b, h) do { _Pragma("unroll") for (int n = 0; n < 2; ++n) _Pragma("unroll") for (int k = 0; k < 2; ++k) dst[n][k] = *(const LAS bf16x8*)(lds + PG8_SB(b, h) + boff + n * 2048 + k * 1024); } while (0)
#define PG8_MMA(ai, bj, At, Bt) do { __builtin_amdgcn_s_setprio(1); _Pragma("unroll") for (int m = 0; m < 4; ++m) _Pragma("unroll") for (int n = 0; n < 2; ++n) _Pragma("unroll") for (int k = 0; k < 2; ++k) \
        acc[ai][bj][m][n] = __builtin_amdgcn_mfma_f32_16x16x32_bf16(Bt[n][k], At[m][k], acc[ai][bj][m][n], 0, 0, 0); __builtin_amdgcn_s_setprio(0); } while (0)
#define PG8_WAIT_V(n) asm volatile("s_waitcnt vmcnt(" #n ")" ::: "memory")
#define PG8_WAIT_L(n) asm volatile("s_waitcnt lgkmcnt(" #n ")" ::: "memory")
#define PG8_BAR __builtin_amdgcn_s_barrier()
#define PG8_SCHED __builtin_amdgcn_sched_barrier(0)
    Unit cur, nxt; int ui = 0;
    if (!S.next(0, cur)) return;
    f32x4 acc[2][2][4][2];
#pragma unroll
    for (int a = 0; a < 2; ++a)
#pragma unroll
        for (int b = 0; b < 2; ++b)
#pragma unroll
            for (int m = 0; m < 4; ++m)
#pragma unroll
                for (int n = 0; n < 2; ++n) acc[a][b][m][n] = (f32x4){0.f, 0.f, 0.f, 0.f};
    bf16x8 At[4][2], B0[2][2], B1[2][2];
    const char* cA = (const char*)g.A + (size_t)cur.pm * tstep; const char* cB = (const char*)g.Bt + (size_t)cur.pn * tstep;
    PG8_STAGE(PG8_SB(0, 0), cB, voffA); PG8_STAGE(PG8_SA(0, 0), cA, voffA); PG8_STAGE(PG8_SB(0, 1), cB + hstep, voffA); PG8_STAGE(PG8_SA(0, 1), cA + hstep, voffA);
    if (wr == 1) PG8_BAR;
    PG8_WAIT_V(4); PG8_BAR;
    PG8_STAGE(PG8_SB(1, 0), cB + kstep, voffA); PG8_STAGE(PG8_SA(1, 0), cA + kstep, voffA); PG8_STAGE(PG8_SB(1, 1), cB + hstep + kstep, voffA);
    PG8_WAIT_V(6); PG8_BAR;
    for (;;) {
        const bool has_next = S.next(ui + 1, nxt);
        const char* nA = has_next ? (const char*)g.A + (size_t)nxt.pm * tstep : cA; const char* nB = has_next ? (const char*)g.Bt + (size_t)nxt.pn * tstep : cB;
        for (int t = 0; t < nt; t += 2) {
            const bool last = (t == nt - 2);
            const char* a1 = cA + (size_t)(t + 1) * kstep;
            const char* a2 = last ? nA : cA + (size_t)(t + 2) * kstep; const char* b2 = last ? nB : cB + (size_t)(t + 2) * kstep;
            const char* a3 = a2 + kstep; const char* b3 = b2 + kstep;
            PG8_LDB(B0, 0, 0); PG8_SCHED; PG8_LDA(At, 0, 0); PG8_STAGE(PG8_SA(1, 1), a1 + hstep, voffA);
            PG8_WAIT_L(8); PG8_BAR; PG8_WAIT_L(0); PG8_MMA(0, 0, At, B0); PG8_BAR; PG8_SCHED;
            PG8_LDB(B1, 0, 1); PG8_STAGE(PG8_SB(0, 0), b2, voffA);
            PG8_BAR; PG8_WAIT_L(0); PG8_MMA(0, 1, At, B1); PG8_BAR;
            PG8_LDA(At, 0, 1); PG8_STAGE(PG8_SA(0, 0), a2, voffA);
            PG8_BAR; PG8_WAIT_L(0); PG8_MMA(1, 0, At, B0); PG8_BAR; PG8_SCHED;
            PG8_STAGE(PG8_SB(0, 1), b2 + hstep, voffA);
            PG8_WAIT_V(6); PG8_BAR; PG8_MMA(1, 1, At, B1); PG8_BAR;
            PG8_LDB(B0, 1, 0); PG8_SCHED; PG8_LDA(At, 1, 0); PG8_STAGE(PG8_SA(0, 1), a2 + hstep, voffA);
            PG8_WAIT_L(8); PG8_BAR; PG8_WAIT_L(0); PG8_MMA(0, 0, At, B0); PG8_BAR; PG8_SCHED;
            PG8_LDB(B1, 1, 1); PG8_STAGE(PG8_SB(1, 0), b3, voffA);
            PG8_BAR; PG8_WAIT_L(0); PG8_MMA(0, 1, At, B1); PG8_BAR;
            PG8_LDA(At, 1, 1); PG8_STAGE(PG8_SA(1, 0), a3, voffA);
            PG8_BAR; PG8_WAIT_L(0); PG8_MMA(1, 0, At, B0); PG8_BAR; PG8_SCHED;
            PG8_STAGE(PG8_SB(1, 1), b3 + hstep, voffA);
            PG8_WAIT_V(6); PG8_BAR; PG8_MMA(1, 1, At, B1); PG8_BAR;
        }
        E(acc, cur, wr, wc, fr, fq);
        if (!has_next) break;
#pragma unroll
        for (int a = 0; a < 2; ++a)
#pragma unroll
            for (int b = 0; b < 2; ++b)
#pragma unroll
                for (int m = 0; m < 4; ++m)
#pragma unroll
                    for (int n = 0; n < 2; ++n) acc[a][b][m][n] = (f32x4){0.f, 0.f, 0.f, 0.f};
        cur = nxt; cA = nA; cB = nB; ++ui;
    }
    PG8_WAIT_V(0);
    if (wr == 0) PG8_BAR;
    PG8_BAR;
#undef PG8_SA
#undef PG8_SB
#undef PG8_STAGE
#undef PG8_LDA
#undef PG8_LDB
#undef PG8_MMA
#undef PG8_WAIT_V
#undef PG8_WAIT_L
#undef PG8_BAR
#undef PG8_SCHED
}

__device__ __forceinline__ float* kv_out_ptr(float* out, int r, int gi, bool& ok) {
    const int keep = 128 << (2 * gi);
    ok = false;
    if (r < MP) {
        const int b = r >> 12, t = r & 4095;
        if (t < SEQ - keep) return out;
        ok = true;
        const size_t base = gi == 0 ? O_KVP0 : (gi == 1 ? O_KVP1 : O_KVP2);
        return out + base + ((size_t)(b * keep + t - (SEQ - keep))) * 1024;
    }
    if (r < MT) {
        const int b = (r - MP) >> 2, t = (r - MP) & 3;
        ok = true;
        const size_t base = gi == 0 ? O_KVS0 : (gi == 1 ? O_KVS1 : O_KVS2);
        return out + base + ((size_t)(b * keep + keep - 4 + t)) * 1024;
    }
    return out;
}

struct EpiIn {
    bf16_t *Qb, *Kb, *Vb; float* U; const float* rope; float* out;
    __device__ __forceinline__ void operator()(const f32x4 (&acc)[2][2][4][2], const Unit& u, int wr, int wc, int fr, int fq) const {
        const int pn = u.pn;
#pragma unroll
        for (int ai = 0; ai < 2; ++ai)
#pragma unroll
            for (int m = 0; m < 4; ++m) {
                const int r = u.pm * 256 + ai * 128 + wr * 64 + m * 16 + fr;
                if (pn < 12) {
                    const int pidx = r < MP ? (r & 4095) : (r < MT ? 4096 + ((r - MP) & 3) : 0);
                    const f32x4* rp = (const f32x4*)(rope + ((size_t)pidx * 64 + 16 * wc + 4 * fq) * 2);
                    const f32x4 cs0 = rp[0], cs1 = rp[1];
                    const f32x4 c = {cs0[0], cs0[2], cs1[0], cs1[2]}, s = {cs0[1], cs0[3], cs1[1], cs1[3]};
                    const int col = 16 * wc + 4 * fq;
#pragma unroll
                    for (int bj = 0; bj < 2; ++bj) {
                        const f32x4 x1 = acc[ai][bj][m][0], x2 = acc[ai][bj][m][1];
                        f32x4 o1 = x1 * c - x2 * s, o2 = x2 * c + x1 * s;
                        const int hq = 2 * pn + bj;
                        if (pn < 6) {
                            o1 = o1 * QSCALE; o2 = o2 * QSCALE;
                            bf16_t* dst = Qb + (size_t)r * AW + hq * 128 + col;
                            *(u32x2*)dst = pack4(o1); *(u32x2*)(dst + 64) = pack4(o2);
                        } else {
                            const int hk = hq - 12;
                            bf16_t* dst = Kb + (size_t)r * AW + hk * 128 + col;
                            *(u32x2*)dst = pack4(o1); *(u32x2*)(dst + 64) = pack4(o2);
                            bool ok; float* o = kv_out_ptr(out, r, hk >> 2, ok);
                            if (ok) { o += (hk & 3) * 128 + col; *(f32x4*)o = o1; *(f32x4*)(o + 64) = o2; }
                        }
                    }
                } else if (pn < 18) {
                    const int col = 32 * wc + 8 * fq;
#pragma unroll
                    for (int bj = 0; bj < 2; ++bj) {
                        const int hv = 2 * (pn - 12) + bj;
                        const f32x4 v0 = acc[ai][bj][m][0], v1 = acc[ai][bj][m][1];
                        *(u32x4*)(Vb + (size_t)r * AW + hv * 128 + col) = pack8(v0, v1);
                        bool ok; float* o = kv_out_ptr(out, r, hv >> 2, ok);
                        if (ok) { o += 512 + (hv & 3) * 128 + col; *(f32x4*)o = v0; *(f32x4*)(o + 4) = v1; }
                    }
                } else {
                    const int ch = 128 * (pn - 18) + 32 * wc + 8 * fq;
                    f32x4 u0, u1;
#pragma unroll
                    for (int e = 0; e < 4; ++e) { u0[e] = acc[ai][0][m][0][e] * fast_sigmoid(acc[ai][1][m][0][e]); u1[e] = acc[ai][0][m][1][e] * fast_sigmoid(acc[ai][1][m][1][e]); }
                    float* up = U + (size_t)r * CCH + ch;
                    *(f32x4*)up = u0; *(f32x4*)(up + 4) = u1;
                    float* o = nullptr;
                    if (r < MP) { const int b = r >> 12, t = r & 4095; if (t >= SEQ - 30) o = out + O_CONVP + ((size_t)(b * 30 + t - (SEQ - 30))) * CCH + ch; }
                    else if (r < MT) { const int b = (r - MP) >> 2, t = (r - MP) & 3; o = out + O_CONVS + ((size_t)(b * 30 + 26 + t)) * CCH + ch; }
                    if (o) { *(f32x4*)o = u0; *(f32x4*)(o + 4) = u1; }
                }
            }
    }
};
struct EpiOut {
    const float *xp, *xs; float* Z;
    __device__ __forceinline__ void operator()(const f32x4 (&acc)[2][2][4][2], const Unit& u, int wr, int wc, int fr, int fq) const {
#pragma unroll
        for (int ai = 0; ai < 2; ++ai)
#pragma unroll
            for (int m = 0; m < 4; ++m) {
                const int r = u.pm * 256 + ai * 128 + wr * 64 + m * 16 + fr;
                const float* xrow = r < MP ? xp + (size_t)r * DM : (r < MT ? xs + (size_t)(r - MP) * DM : nullptr);
#pragma unroll
                for (int bj = 0; bj < 2; ++bj)
#pragma unroll
                    for (int n = 0; n < 2; ++n) {
                        const int col = u.pn * 256 + bj * 128 + wc * 32 + n * 16 + 4 * fq;
                        f32x4 xv = {0.f, 0.f, 0.f, 0.f}; if (xrow) xv = *(const f32x4*)(xrow + col);
                        *(f32x4*)(Z + (size_t)r * DM + col) = xv * ALPHA + acc[ai][bj][m][n];
                    }
            }
    }
};
struct EpiGU {
    bf16_t* H;
    __device__ __forceinline__ void operator()(const f32x4 (&acc)[2][2][4][2], const Unit& u, int wr, int wc, int fr, int fq) const {
#pragma unroll
        for (int ai = 0; ai < 2; ++ai)
#pragma unroll
            for (int m = 0; m < 4; ++m) {
                const int r = u.pm * 256 + ai * 128 + wr * 64 + m * 16 + fr;
                const int col = 128 * u.pn + 32 * wc + 8 * fq;
                f32x4 h0, h1;
#pragma unroll
                for (int e = 0; e < 4; ++e) {
                    const float g0 = acc[ai][0][m][0][e], g1 = acc[ai][0][m][1][e];
                    h0[e] = g0 * fast_sigmoid(g0) * acc[ai][1][m][0][e]; h1[e] = g1 * fast_sigmoid(g1) * acc[ai][1][m][1][e];
                }
                *(u32x4*)(H + (size_t)r * FH + col) = pack8(h0, h1);
            }
    }
};
struct EpiNull {
    float* Z;
    __device__ __forceinline__ void operator()(const f32x4 (&acc)[2][2][4][2], const Unit& u, int wr, int wc, int fr, int fq) const {
        float s = 0.f;
#pragma unroll
        for (int ai = 0; ai < 2; ++ai)
#pragma unroll
            for (int bj = 0; bj < 2; ++bj)
#pragma unroll
                for (int m = 0; m < 4; ++m)
#pragma unroll
                    for (int n = 0; n < 2; ++n) s += acc[ai][bj][m][n][0] + acc[ai][bj][m][n][1] + acc[ai][bj][m][n][2] + acc[ai][bj][m][n][3];
        if (s != s) Z[threadIdx.x] = s;
    }
};
struct EpiDown {
    const float* X1; float* Y;
    __device__ __forceinline__ void operator()(const f32x4 (&acc)[2][2][4][2], const Unit& u, int wr, int wc, int fr, int fq) const {
#pragma unroll
        for (int ai = 0; ai < 2; ++ai)
#pragma unroll
            for (int m = 0; m < 4; ++m) {
                const int r = u.pm * 256 + ai * 128 + wr * 64 + m * 16 + fr;
                if (r < MT) {
#pragma unroll
                    for (int bj = 0; bj < 2; ++bj)
#pragma unroll
                        for (int n = 0; n < 2; ++n) {
                            const int col = u.pn * 256 + bj * 128 + wc * 32 + n * 16 + 4 * fq;
                            const f32x4 xv = *(const f32x4*)(X1 + (size_t)r * DM + col);
                            *(f32x4*)(Y + (size_t)r * DM + col) = xv * ALPHA + acc[ai][bj][m][n];
                        }
                }
            }
    }
};

template <int KSTEPS>
__device__ __forceinline__ void skinny_gemm(LAS unsigned char* lds, const bf16_t* A, const bf16_t* Bt, const float* resid, float* dst) {
    constexpr int K = 8 * 32 * KSTEPS;
    const int tid = threadIdx.x, w = tid >> 6, lane = tid & 63, fr = lane & 15, fq = lane >> 4;
    for (int item = blockIdx.x; item < 256; item += gridDim.x) {
        const int rh = item & 1, cb = item >> 1;
        const bf16_t* ap = A + (size_t)(rh * 16 + fr) * K + w * (32 * KSTEPS) + 8 * fq;
        const bf16_t* bp = Bt + (size_t)(cb * 16 + fr) * K + w * (32 * KSTEPS) + 8 * fq;
        f32x4 acc = {0.f, 0.f, 0.f, 0.f};
#pragma unroll (KSTEPS > 11 ? 11 : KSTEPS)
        for (int s = 0; s < KSTEPS; ++s) { const bf16x8 a = *(const bf16x8*)(ap + 32 * s), bb = *(const bf16x8*)(bp + 32 * s); acc = __builtin_amdgcn_mfma_f32_16x16x32_bf16(bb, a, acc, 0, 0, 0); }
        *(LAS f32x4*)(lds + (w * 64 + lane) * 16) = acc;
        __syncthreads();
        if (w == 0) {
            f32x4 sum = *(const LAS f32x4*)(lds + lane * 16);
#pragma unroll
            for (int ww = 1; ww < 8; ++ww) sum = sum + *(const LAS f32x4*)(lds + (ww * 64 + lane) * 16);
            const size_t o = (size_t)(rh * 16 + fr) * DM + cb * 16 + 4 * fq;
            *(f32x4*)(dst + o) = *(const f32x4*)(resid + o) * ALPHA + sum;
        }
        __syncthreads();
    }
}

__device__ __forceinline__ int perm8(int s) { return 8 * ((s >> 2) & 3) + 4 * ((s >> 4) & 1) + (s & 3); }
__device__ __forceinline__ int src_col_in(int np) {
    const int pn = np >> 8, bj = (np >> 7) & 1, s = np & 127;
    if (pn < 12) { const int wc = s >> 5, n = (s >> 4) & 1, q4 = s & 15; return (2 * pn + bj) * 128 + 64 * n + 16 * wc + q4; }
    if (pn < 18) return (2 * pn + bj) * 128 + (s & ~31) + perm8(s & 31);
    return (bj ? 5120 : 4608) + 128 * (pn - 18) + (s & ~31) + perm8(s & 31);
}
__device__ __forceinline__ void cvt_unit(const float* W, int ldw, int K, int srccol, bf16_t* Bt, int nrow, int k0, int oct) {
    const float* src = W + (size_t)(k0 + 8 * oct) * ldw + srccol;
    f32x4 v[8];
#pragma unroll
    for (int j = 0; j < 8; ++j) v[j] = *(const f32x4*)(src + (size_t)j * ldw);
#pragma unroll
    for (int e = 0; e < 4; ++e) {
        u32x4 o; o.x = cvt_pk_bf16(v[0][e], v[1][e]); o.y = cvt_pk_bf16(v[2][e], v[3][e]); o.z = cvt_pk_bf16(v[4][e], v[5][e]); o.w = cvt_pk_bf16(v[6][e], v[7][e]);
        *(u32x4*)(Bt + (size_t)(nrow + e) * K + k0 + 8 * oct) = o;
    }
}
__device__ __forceinline__ void phase_convert(const Params& p, LAS unsigned char* lds) {
    const int tid = threadIdx.x, G = gridDim.x, bid = blockIdx.x;
    unsigned char* ws = p.ws;
    { bf16_t* Xb = (bf16_t*)(ws + WS_XB);
      for (size_t i = (size_t)bid * 512 + tid; i < (size_t)MT * DM / 8; i += (size_t)G * 512) {
          const size_t e = i * 8; const float* src = e < (size_t)MP * DM ? p.xp + e : p.xs + (e - (size_t)MP * DM);
          const f32x4 a = *(const f32x4*)src, b = *(const f32x4*)(src + 4);
          *(u32x4*)(Xb + e) = pack8(a, b); } }
    { float* rope = (float*)(ws + WS_ROPE);
      for (int i = bid * 512 + tid; i < 4100 * 64; i += G * 512) {
          const int pr = i >> 6, k = i & 63; const double pos = pr < 4096 ? (double)pr : (double)(16384 + pr - 4096);
          const double inv = exp2(-(double)k * (13.287712379549449 / 64.0));
          double sn, cs; sincos(pos * inv, &sn, &cs);
          rope[2 * i] = (float)cs; rope[2 * i + 1] = (float)sn; } }
    { const int lane = tid & 63, grp = lane >> 3, oct = lane & 7, gw = bid * 8 + (tid >> 6), NW = G * 8;
      constexpr int NB_IN = NIN / 32, NB_OUT = DM / 32, NB_GU = 2 * FH / 32, NB_D = DM / 32;
      constexpr int U_IN = NB_IN * (DM / 64), U_OUT = NB_OUT * (DM / 64), U_GU = NB_GU * (DM / 64), U_D = NB_D * (FH / 64);
      for (int it = gw; it < U_IN + U_OUT + U_GU + U_D; it += NW) {
          int r = it;
          if (r < U_IN) { const int nb = r % NB_IN, kb = r / NB_IN, np = nb * 32 + 4 * grp; cvt_unit(p.w_in, NIN, DM, src_col_in(np), (bf16_t*)(ws + WS_WIN), np, kb * 64, oct); continue; }
          r -= U_IN;
          if (r < U_OUT) { const int nb = r % NB_OUT, kb = r / NB_OUT, np = nb * 32 + 4 * grp; cvt_unit(p.w_out, DM, DM, np, (bf16_t*)(ws + WS_WOUT), np, kb * 64, oct); continue; }
          r -= U_OUT;
          if (r < U_GU) { const int nb = r % NB_GU, kb = r / NB_GU, np = nb * 32 + 4 * grp, pn = np >> 8, bj = (np >> 7) & 1, sl = np & 127;
              cvt_unit(bj ? p.w_up : p.w_gate, FH, DM, 128 * pn + (sl & ~31) + perm8(sl & 31), (bf16_t*)(ws + WS_WGU), np, kb * 64, oct); continue; }
          r -= U_GU;
          { const int nb = r % NB_D, kb = r / NB_D, np = nb * 32 + 4 * grp; cvt_unit(p.w_down, DM, FH, np, (bf16_t*)(ws + WS_WD), np, kb * 64, oct); }
      } }
    { const size_t gt = (size_t)bid * 512 + tid, gs = (size_t)G * 512;
      for (int gi = 0; gi < 3; ++gi) {
          const int buf = 128 << (2 * gi); const float* src = gi == 0 ? p.c0 : (gi == 1 ? p.c1 : p.c2);
          float* dst = p.out + (gi == 0 ? O_KVS0 : (gi == 1 ? O_KVS1 : O_KVS2));
          const size_t per_b = (size_t)(buf - 4) * 256;
          for (size_t i = gt; i < 8 * per_b; i += gs) { const size_t b = i / per_b, o = i % per_b;
              ((f32x4*)dst)[b * buf * 256 + o] = ((const f32x4*)src)[b * buf * 256 + 4 * 256 + o]; } }
      const size_t per_b = 26 * 128;
      for (size_t i = gt; i < 8 * per_b; i += gs) { const size_t b = i / per_b, o = i % per_b;
          ((f32x4*)(p.out + O_CONVS))[b * 30 * 128 + o] = ((const f32x4*)p.sconv)[b * 30 * 128 + 4 * 128 + o]; } }
}

__device__ __forceinline__ unsigned off_b(unsigned row, unsigned ch) { return 256u * row + 16u * (ch ^ (((row & 3) << 2) | ((row >> 2) & 3))); }

__device__ __forceinline__ void attn_prompt_item(const Params& p, LAS unsigned char* lds, int item) {
    const int tid = threadIdx.x, w = tid >> 6, lane = tid & 63, fr = lane & 15, fq = lane >> 4;
    const int blk = item & 31, hs = (item >> 5) & 3, g = (item >> 7) % 3, b = item / 384;
    const int dsh = 2 * g, d = 1 << dsh, rcls = blk & (d - 1), n = blk >> dsh, head = g * 4 + hs;
    const bf16_t* Qb = (const bf16_t*)(p.ws + WS_Q); const bf16_t* Kb = (const bf16_t*)(p.ws + WS_K); const bf16_t* Vb = (const bf16_t*)(p.ws + WS_V);
    bf16_t* AO = (bf16_t*)(p.ws + WS_AO); float* LSE = (float*)(p.ws + WS_LSE);
    {
        const int ch = tid & 15, r0 = tid >> 4;
        u32x4 kv[8], vv[8];
#pragma unroll
        for (int i = 0; i < 8; ++i) {
            const int row = r0 + 32 * i, j = 128 * (n - 1) + row;
            kv[i] = (u32x4){0u, 0u, 0u, 0u}; vv[i] = kv[i];
            if (j >= 0) { const size_t gi = ((size_t)(b * SEQ + j * d + rcls)) * AW + head * 128 + ch * 8; kv[i] = *(const u32x4*)(Kb + gi); vv[i] = *(const u32x4*)(Vb + gi); }
        }
#pragma unroll
        for (int i = 0; i < 8; ++i) { const int row = r0 + 32 * i; *(LAS u32x4*)(lds + off_b(row, ch)) = kv[i]; *(LAS u32x4*)(lds + 65536 + off_b(row, ch)) = vv[i]; }
    }
    const int qi = 16 * w + fr;
    const size_t qrow = (size_t)(b * SEQ + (128 * n + qi) * d + rcls);
    bf16x8 qf[4];
#pragma unroll
    for (int ks = 0; ks < 4; ++ks) qf[ks] = *(const bf16x8*)(Qb + qrow * AW + head * 128 + 32 * ks + 8 * fq);
    __syncthreads();
    f32x4 s[9];
#pragma unroll
    for (int tt = 0; tt < 9; ++tt) {
        const int T = w + tt; s[tt] = (f32x4){0.f, 0.f, 0.f, 0.f};
#pragma unroll
        for (int ks = 0; ks < 4; ++ks) { const bf16x8 kf = *(const LAS bf16x8*)(lds + off_b(16 * T + fr, 4 * ks + fq)); s[tt] = __builtin_amdgcn_mfma_f32_16x16x32_bf16(kf, qf[ks], s[tt], 0, 0, 0); }
    }
    const int kmin = n == 0 ? 128 : 0;
    float mx = -3.0e38f;
#pragma unroll
    for (int tt = 0; tt < 9; ++tt)
#pragma unroll
        for (int e = 0; e < 4; ++e) { const int kk = 16 * (w + tt) + 4 * fq + e; const bool ok = kk >= qi && kk <= qi + 128 && kk >= kmin; s[tt][e] = ok ? s[tt][e] : -3.0e38f; mx = fmaxf(mx, s[tt][e]); }
    mx = fmaxf(mx, __shfl_xor(mx, 16)); mx = fmaxf(mx, __shfl_xor(mx, 32));
    float den = 0.f;
#pragma unroll
    for (int tt = 0; tt < 9; ++tt)
#pragma unroll
        for (int e = 0; e < 4; ++e) { const float pv = __builtin_amdgcn_exp2f(s[tt][e] - mx); s[tt][e] = pv; den += pv; }
    den += __shfl_xor(den, 16); den += __shfl_xor(den, 32);
    f32x4 o[8];
#pragma unroll
    for (int dt = 0; dt < 8; ++dt) o[dt] = (f32x4){0.f, 0.f, 0.f, 0.f};
    const int q4 = (lane & 15) >> 2, p4 = lane & 3;
#pragma unroll
    for (int ku = 0; ku < 5; ++ku) {
        const int T0 = w + 2 * ku, T1 = ku < 4 ? T0 + 1 : T0;
        union { bf16x8 v; unsigned u[4]; } pf;
        pf.u[0] = cvt_pk_bf16(s[2 * ku][0], s[2 * ku][1]); pf.u[1] = cvt_pk_bf16(s[2 * ku][2], s[2 * ku][3]);
        if (ku < 4) { pf.u[2] = cvt_pk_bf16(s[2 * ku + 1][0], s[2 * ku + 1][1]); pf.u[3] = cvt_pk_bf16(s[2 * ku + 1][2], s[2 * ku + 1][3]); } else { pf.u[2] = 0u; pf.u[3] = 0u; }
#pragma unroll
        for (int dt = 0; dt < 8; ++dt) {
            union { bf16x8 v; bf16x4 h[2]; } vf;
            vf.h[0] = __builtin_amdgcn_ds_read_tr16_b64_v4i16((LAS bf16x4*)(lds + 65536 + off_b(16 * T0 + 4 * fq + q4, 2 * dt + (p4 >> 1)) + 8 * (p4 & 1)));
            vf.h[1] = __builtin_amdgcn_ds_read_tr16_b64_v4i16((LAS bf16x4*)(lds + 65536 + off_b(16 * T1 + 4 * fq + q4, 2 * dt + (p4 >> 1)) + 8 * (p4 & 1)));
            o[dt] = __builtin_amdgcn_mfma_f32_16x16x32_bf16(vf.v, pf.v, o[dt], 0, 0, 0);
        }
    }
    const float rden = 1.0f / den;
    bf16_t* orow = AO + qrow * DM + head * 128 + 4 * fq;
#pragma unroll
    for (int dt = 0; dt < 8; ++dt) *(u32x2*)(orow + 16 * dt) = pack4(o[dt] * rden);
    if (fq == 0) LSE[qrow * 12 + head] = mx + __builtin_amdgcn_logf(den);
    __syncthreads();
}

__device__ __forceinline__ void attn_sample_item(const Params& p, LAS unsigned char* lds, int item) {
    const int tid = threadIdx.x;
    const int hs = item & 3, g = (item >> 2) % 3, b = item / 12, d = 1 << (2 * g), buf = 128 * d, head = g * 4 + hs;
    const float* cache = g == 0 ? p.c0 : (g == 1 ? p.c1 : p.c2);
    const float* okv = p.out + (g == 0 ? O_KVS0 : (g == 1 ? O_KVS1 : O_KVS2));
    LAS float* qs = (LAS float*)lds;
    LAS float* sc = qs + 512;
    LAS float* st = sc + 4 * 132;
    LAS float* part = st + 8;
    const bf16_t* Qb = (const bf16_t*)(p.ws + WS_Q);
    { const int t = tid >> 7, j = tid & 127; qs[tid] = bf2f(Qb[((size_t)MP + b * 4 + t) * AW + head * 128 + j]); }
    __syncthreads();
    {
        const int sub = tid & 3;
#pragma unroll
        for (int ps = 0; ps < 5; ++ps) {
            const int pi = ps * 128 + (tid >> 2);
            const bool act = pi < 516;
            const int t = act ? pi / 129 : 0, jj = act ? pi % 129 : 0;
            const int idx = buf + t - d * jj;
            const float* kr = (idx < buf ? cache + ((size_t)(b * buf + idx)) * 1024 : okv + ((size_t)(b * buf + idx - 4)) * 1024) + hs * 128 + 32 * sub;
            f32x4 kv[8];
#pragma unroll
            for (int c = 0; c < 8; ++c) kv[c] = *(const f32x4*)(kr + 4 * c);
            float dot = 0.f;
#pragma unroll
            for (int c = 0; c < 8; ++c) { const LAS float* qq = qs + t * 128 + 32 * sub + 4 * c; dot += kv[c][0] * qq[0] + kv[c][1] * qq[1] + kv[c][2] * qq[2] + kv[c][3] * qq[3]; }
            dot += __shfl_xor(dot, 1); dot += __shfl_xor(dot, 2);
            if (act && sub == 0) sc[t * 132 + jj] = dot;
        }
    }
    __syncthreads();
    if (tid < 256) {
        const int tw = tid >> 6, lane = tid & 63;
        const float a0 = sc[tw * 132 + lane], a1 = sc[tw * 132 + 64 + lane], a2 = lane == 0 ? sc[tw * 132 + 128] : -3.0e38f;
        const float mx = wave_max(fmaxf(fmaxf(a0, a1), a2));
        const float e0 = __builtin_amdgcn_exp2f(a0 - mx), e1 = __builtin_amdgcn_exp2f(a1 - mx), e2 = lane == 0 ? __builtin_amdgcn_exp2f(a2 - mx) : 0.f;
        const float den = wave_sum(e0 + e1 + e2);
        sc[tw * 132 + lane] = e0; sc[tw * 132 + 64 + lane] = e1; if (lane == 0) { sc[tw * 132 + 128] = e2; st[tw * 2] = den; st[tw * 2 + 1] = mx + __builtin_amdgcn_logf(den); }
    }
    __syncthreads();
    {
        const int t = tid >> 7, kq = (tid >> 5) & 3, dd4 = tid & 31;
        f32x4 acc = {0.f, 0.f, 0.f, 0.f};
#pragma unroll 11
        for (int i = 0; i < 33; ++i) {
            const int jj = kq + 4 * i;
            if (jj <= 128) {
                const int idx = buf + t - d * jj;
                const float* vr = (idx < buf ? cache + ((size_t)(b * buf + idx)) * 1024 : okv + ((size_t)(b * buf + idx - 4)) * 1024) + 512 + hs * 128 + 4 * dd4;
                acc = acc + *(const f32x4*)vr * sc[t * 132 + jj];
            }
        }
        *(LAS f32x4*)(part + (t * 4 + kq) * 128 + 4 * dd4) = acc;
    }
    __syncthreads();
    {
        const int t = tid >> 7, j = tid & 127;
        const size_t row = (size_t)MP + b * 4 + t;
        const float acc = (part[(t * 4 + 0) * 128 + j] + part[(t * 4 + 1) * 128 + j]) + (part[(t * 4 + 2) * 128 + j] + part[(t * 4 + 3) * 128 + j]);
        bf16_t* AO = (bf16_t*)(p.ws + WS_AO);
        AO[row * DM + head * 128 + j] = (bf16_t)(cvt_pk_bf16(acc / st[t * 2], 0.f) & 0xffffu);
        if (j == 0) ((float*)(p.ws + WS_LSE))[row * 12 + head] = st[t * 2 + 1];
    }
    __syncthreads();
}

__device__ __forceinline__ void conv_item(const Params& p, LAS unsigned char* lds, int item) {
    const int tid = threadIdx.x, ch = tid;
    const float* U = (const float*)(p.ws + WS_U);
    const bool samp = item >= 256;
    const int b = samp ? item - 256 : item >> 7, t0 = samp ? 0 : (item & 127) * 32;
    float wgt[31];
#pragma unroll
    for (int j = 0; j < 31; ++j) wgt[j] = p.conv_w[j * CCH + ch];
    float acc[32];
    const float bias = p.conv_b[ch];
#pragma unroll
    for (int t = 0; t < 32; ++t) acc[t] = bias;
#pragma unroll
    for (int rr = 0; rr < 62; ++rr) {
        float uv = 0.f;
        if (!samp) { const int tok = t0 - 30 + rr; if (tok >= 0) uv = U[((size_t)(b * SEQ + tok)) * CCH + ch]; }
        else { if (rr < 30) uv = p.sconv[((size_t)(b * 30 + rr)) * CCH + ch]; else if (rr < 34) uv = U[((size_t)(MP + b * 4 + rr - 30)) * CCH + ch]; }
#pragma unroll
        for (int t = 0; t < 32; ++t) { const int j = rr - t; if (j >= 0 && j <= 30) acc[t] += wgt[j] * uv; }
    }
    LAS float* ct = (LAS float*)lds;
#pragma unroll
    for (int t = 0; t < 32; ++t) ct[t * CCH + ch] = acc[t];
    __syncthreads();
    {
        const int w = tid >> 6, lane = tid & 63;
        bf16_t* AO = (bf16_t*)(p.ws + WS_AO);
        const int ntok = samp ? 4 : 32;
        for (int tt = 0; tt < 4; ++tt) {
            const int t = 4 * w + tt;
            if (t < ntok) {
                float x[8]; float sm = 0.f;
#pragma unroll
                for (int i = 0; i < 8; ++i) { x[i] = ct[t * CCH + lane + 64 * i]; sm += x[i]; }
                const float mean = wave_sum(sm) * (1.0f / CCH); float s2 = 0.f;
#pragma unroll
                for (int i = 0; i < 8; ++i) { x[i] -= mean; s2 += x[i] * x[i]; }
                const float rstd = rsqrtf(wave_sum(s2) * (1.0f / CCH) + LN_EPS);
                const size_t row = samp ? (size_t)MP + b * 4 + t : (size_t)b * SEQ + t0 + t;
#pragma unroll
                for (int i = 0; i < 8; ++i) { const int c = lane + 64 * i; float y = x[i] * rstd * p.cln_g[c] + p.cln_b[c]; y = y * fast_sigmoid(y);
                    AO[row * DM + AW + c] = (bf16_t)(cvt_pk_bf16(y, 0.f) & 0xffffu); }
            }
        }
    }
    __syncthreads();
}

__device__ __forceinline__ void phase_mixers(const Params& p, LAS unsigned char* lds) {
    constexpr int N_AP = 2 * 3 * 4 * 32, N_AS = 8 * 12, N_CV = 256 + 8;
    const int G = gridDim.x;
    for (int it = blockIdx.x; it < N_AP; it += G) attn_prompt_item(p, lds, it);
    for (int it = (blockIdx.x + N_AS) % G; it < N_AS; it += G) attn_sample_item(p, lds, it);
    for (int it = blockIdx.x; it < N_CV; it += G) conv_item(p, lds, it);
}

__device__ __forceinline__ void phase_alpha(const Params& p) {
    bf16_t* AO = (bf16_t*)(p.ws + WS_AO); const float* LSE = (const float*)(p.ws + WS_LSE);
    for (size_t i = (size_t)blockIdx.x * 512 + threadIdx.x; i < (size_t)MT * 12 * 16; i += (size_t)gridDim.x * 512) {
        const int c = (int)(i & 15), s = (int)((i >> 4) % 12); const size_t row = i / 192;
        const int g = s >> 2, hs = s & 3;
        const float l0 = LSE[row * 12 + hs], l1 = LSE[row * 12 + 4 + hs], l2 = LSE[row * 12 + 8 + hs];
        const float mx = fmaxf(l0, fmaxf(l1, l2));
        const float e0 = __builtin_amdgcn_exp2f(l0 - mx), e1 = __builtin_amdgcn_exp2f(l1 - mx), e2 = __builtin_amdgcn_exp2f(l2 - mx);
        const float al = (g == 0 ? e0 : (g == 1 ? e1 : e2)) / (e0 + e1 + e2);
        u32x4* ptr = (u32x4*)(AO + row * DM + s * 128 + c * 8);
        u32x4 v = *ptr;
#pragma unroll
        for (int k = 0; k < 4; ++k) { const float lo = __uint_as_float(v[k] << 16) * al, hi = __uint_as_float(v[k] & 0xffff0000u) * al; v[k] = cvt_pk_bf16(lo, hi); }
        *ptr = v;
    }
}

__device__ __forceinline__ void phase_ln(const float* src, float* dstf, bf16_t* dstb, const float* gam, const float* bet) {
    const int lane = threadIdx.x & 63, gw = blockIdx.x * 8 + (threadIdx.x >> 6), NW = gridDim.x * 8;
    f32x4 gv[8], bv[8];
#pragma unroll
    for (int j = 0; j < 8; ++j) { gv[j] = *(const f32x4*)(gam + 4 * lane + 256 * j); bv[j] = *(const f32x4*)(bet + 4 * lane + 256 * j); }
    for (int r = gw; r < MT; r += NW) {
        const float* xr = src + (size_t)r * DM + 4 * lane;
        f32x4 v[8]; float sm = 0.f;
#pragma unroll
        for (int j = 0; j < 8; ++j) { v[j] = *(const f32x4*)(xr + 256 * j); sm += (v[j][0] + v[j][1]) + (v[j][2] + v[j][3]); }
        const float mean = wave_sum(sm) * (1.0f / DM); float s2 = 0.f;
#pragma unroll
        for (int j = 0; j < 8; ++j) { v[j] = v[j] - mean; s2 += (v[j][0] * v[j][0] + v[j][1] * v[j][1]) + (v[j][2] * v[j][2] + v[j][3] * v[j][3]); }
        const float rstd = rsqrtf(wave_sum(s2) * (1.0f / DM) + LN_EPS);
#pragma unroll
        for (int j = 0; j < 8; ++j) {
            const f32x4 y = v[j] * rstd * gv[j] + bv[j];
            if (dstf) *(f32x4*)(dstf + (size_t)r * DM + 4 * lane + 256 * j) = y;
            if (dstb) *(u32x2*)(dstb + (size_t)r * DM + 4 * lane + 256 * j) = pack4(y);
        }
    }
}

constexpr int REP0 = 1, REP2 = 1, REPG = 1, PROBE_NULLGU = 0;
template <int MASK>
__global__ void __launch_bounds__(512, 2) fwd_kernel(Params p) {
    extern __shared__ __attribute__((aligned(16))) unsigned char shm[];
    LAS unsigned char* lds = (LAS unsigned char*)shm;
    unsigned char* ws = p.ws;
#define PH(k) if constexpr ((MASK >> (k)) & 1)
#define SYNC(k) if constexpr (((MASK >> (k)) & 1) && (MASK & ((1 << (k)) - 1))) cg::this_grid().sync();
    PH(0) for (int rep = 0; rep < REP0; ++rep) { phase_convert(p, lds); if (rep + 1 < REP0) cg::this_grid().sync(); }
    SYNC(1)
    PH(1) { Gemm g{(const bf16_t*)(ws + WS_XB), (const bf16_t*)(ws + WS_WIN), MPAD, NIN, DM}; StaticOrder S; S.init(MPAD, NIN, gridDim.x, blockIdx.x);
            EpiIn E{(bf16_t*)(ws + WS_Q), (bf16_t*)(ws + WS_K), (bf16_t*)(ws + WS_V), (float*)(ws + WS_U), (const float*)(ws + WS_ROPE), p.out};
            gemm_phase(lds, g, S, E); if constexpr (REPG == 2) { cg::this_grid().sync(); gemm_phase(lds, g, S, E); } }
    SYNC(2)
    PH(2) { phase_mixers(p, lds); if constexpr (REP2 == 2) { cg::this_grid().sync(); phase_mixers(p, lds); } }
    SYNC(3)
    PH(3) phase_alpha(p);
    SYNC(4)
    PH(4) { skinny_gemm<8>(lds, (const bf16_t*)(ws + WS_AO) + (size_t)MP * DM, (const bf16_t*)(ws + WS_WOUT), p.xs, (float*)(ws + WS_Z1) + (size_t)MP * DM);
            Gemm g{(const bf16_t*)(ws + WS_AO), (const bf16_t*)(ws + WS_WOUT), MP, DM, DM}; StaticOrder S; S.init(MP, DM, gridDim.x, blockIdx.x);
            EpiOut E{p.xp, p.xs, (float*)(ws + WS_Z1)}; gemm_phase(lds, g, S, E); if constexpr (REPG == 2) { cg::this_grid().sync(); gemm_phase(lds, g, S, E); } }
    SYNC(5)
    PH(5) phase_ln((const float*)(ws + WS_Z1), (float*)(ws + WS_Z1), (bf16_t*)(ws + WS_AO), p.ln1_g, p.ln1_b);
    SYNC(6)
    PH(6) { Gemm g{(const bf16_t*)(ws + WS_AO), (const bf16_t*)(ws + WS_WGU), MPAD, 2 * FH, DM}; StaticOrder S; S.init(MPAD, 2 * FH, gridDim.x, blockIdx.x);
            if constexpr (PROBE_NULLGU) { EpiNull EN{(float*)(ws + WS_LSE)}; gemm_phase(lds, g, S, EN); cg::this_grid().sync(); }
            EpiGU E{(bf16_t*)(ws + WS_H)}; gemm_phase(lds, g, S, E); if constexpr (REPG == 2) { cg::this_grid().sync(); gemm_phase(lds, g, S, E); } }
    SYNC(7)
    PH(7) { skinny_gemm<22>(lds, (const bf16_t*)(ws + WS_H) + (size_t)MP * FH, (const bf16_t*)(ws + WS_WD), (const float*)(ws + WS_Z1) + (size_t)MP * DM, p.out + (size_t)MP * DM);
            Gemm g{(const bf16_t*)(ws + WS_H), (const bf16_t*)(ws + WS_WD), MP, DM, FH}; StaticOrder S; S.init(MP, DM, gridDim.x, blockIdx.x);
            EpiDown E{(const float*)(ws + WS_Z1), p.out}; gemm_phase(lds, g, S, E); if constexpr (REPG == 2) { cg::this_grid().sync(); gemm_phase(lds, g, S, E); } }
    SYNC(8)
    PH(8) phase_ln(p.out, p.out, nullptr, p.ln2_g, p.ln2_b);
#undef PH
#undef SYNC
}

#ifndef N_LAUNCH_MODE
#define N_LAUNCH_MODE 1
#endif
template <int MASK> static void launch_plain(const Params& p, int grid, hipStream_t stream) {
    static bool attr = false;
    if (!attr) { (void)hipFuncSetAttribute((const void*)fwd_kernel<MASK>, hipFuncAttributeMaxDynamicSharedMemorySize, STAGE_BYTES); attr = true; }
    hipLaunchKernelGGL(fwd_kernel<MASK>, dim3(grid), dim3(512), STAGE_BYTES, stream, p);
}
extern "C" void kernel_launch(void* const* d_in, const int* in_sizes, int n_in, void* d_out, int out_size, void* d_ws, size_t ws_size, hipStream_t stream) {
    static int grid = 0;
    if (grid == 0) {
        if (n_in != 19 || (size_t)out_size != O_END || ws_size < WS_END) { fprintf(stderr, "kernel_launch: unexpected shapes: n_in %d out %d ws %zu (need %zu)\n", n_in, out_size, ws_size, (size_t)WS_END); grid = -1; return; }
        int dev = 0, cus = 0, per_cu = 0;
        (void)hipGetDevice(&dev); (void)hipDeviceGetAttribute(&cus, hipDeviceAttributeMultiprocessorCount, dev);
#if N_LAUNCH_MODE == 1
        if (hipFuncSetAttribute((const void*)fwd_kernel<0x1FF>, hipFuncAttributeMaxDynamicSharedMemorySize, STAGE_BYTES) != hipSuccess) { fprintf(stderr, "kernel_launch: hipFuncSetAttribute failed\n"); grid = -1; return; }
        if (hipOccupancyMaxActiveBlocksPerMultiprocessor(&per_cu, (const void*)fwd_kernel<0x1FF>, 512, STAGE_BYTES) != hipSuccess || per_cu < 1) { fprintf(stderr, "kernel_launch: occupancy query failed (%d)\n", per_cu); (void)hipGetLastError(); }
#endif
        grid = cus;
        fprintf(stderr, "kernel_launch: grid %d (per_cu %d)\n", grid, per_cu);
    }
    if (grid < 0) return;
    Params p{};
    p.xp = (const float*)d_in[0]; p.xs = (const float*)d_in[1]; p.c0 = (const float*)d_in[2]; p.c1 = (const float*)d_in[3]; p.c2 = (const float*)d_in[4]; p.sconv = (const float*)d_in[5];
    p.w_in = (const float*)d_in[6]; p.w_out = (const float*)d_in[7]; p.conv_w = (const float*)d_in[8]; p.conv_b = (const float*)d_in[9]; p.cln_g = (const float*)d_in[10]; p.cln_b = (const float*)d_in[11];
    p.ln1_g = (const float*)d_in[12]; p.ln1_b = (const float*)d_in[13]; p.w_gate = (const float*)d_in[14]; p.w_up = (const float*)d_in[15]; p.w_down = (const float*)d_in[16]; p.ln2_g = (const float*)d_in[17]; p.ln2_b = (const float*)d_in[18];
    p.out = (float*)d_out; p.ws = (unsigned char*)d_ws;
#if N_LAUNCH_MODE == 1
    void* args[] = {&p};
    hipError_t e = hipLaunchCooperativeKernel((const void*)fwd_kernel<0x1FF>, dim3(grid), dim3(512), args, STAGE_BYTES, stream);
    if (e != hipSuccess) fprintf(stderr, "cooperative launch failed: %s (grid %d)\n", hipGetErrorString(e), grid);
#else
    launch_plain<1>(p, grid, stream); launch_plain<2>(p, grid, stream); launch_plain<4>(p, grid, stream); launch_plain<8>(p, grid, stream); launch_plain<16>(p, grid, stream);
    launch_plain<32>(p, grid, stream); launch_plain<64>(p, grid, stream); launch_plain<128>(p, grid, stream); launch_plain<256>(p, grid, stream);
#endif
}
```

```cpp
#include <hip/hip_runtime.h>
#include <hip/hip_cooperative_groups.h>
#include <cstdio>
namespace cg = cooperative_groups;

#define LAS __attribute__((address_space(3)))
typedef unsigned short bf16_t;
typedef short bf16x8 __attribute__((ext_vector_type(8)));
typedef short bf16x4 __attribute__((ext_vector_type(4)));
typedef float f32x4 __attribute__((ext_vector_type(4)));
typedef unsigned u32x4 __attribute__((ext_vector_type(4)));
typedef unsigned u32x2 __attribute__((ext_vector_type(2)));

constexpr int DM = 2048, SEQ = 4096, MP = 8192, MS = 32, MT = MP + MS, MPAD = 8448;
constexpr int AW = 1536, CCH = 512, NIN = 5632, FH = 5632;
constexpr float ALPHA = 1.189207115002721f;
constexpr float LN_EPS = 1e-5f;
constexpr float QSCALE = 0.08838834764831845f * 1.4426950408889634f;

constexpr size_t O_KVP0 = (size_t)MT * DM;
constexpr size_t O_KVP1 = O_KVP0 + 2 * 128 * 1024;
constexpr size_t O_KVP2 = O_KVP1 + 2 * 512 * 1024;
constexpr size_t O_CONVP = O_KVP2 + 2 * 2048 * 1024;
constexpr size_t O_KVS0 = O_CONVP + 2 * 30 * 512;
constexpr size_t O_KVS1 = O_KVS0 + 8 * 128 * 1024;
constexpr size_t O_KVS2 = O_KVS1 + 8 * 512 * 1024;
constexpr size_t O_CONVS = O_KVS2 + (size_t)8 * 2048 * 1024;
constexpr size_t O_END = O_CONVS + 8 * 30 * 512;

constexpr size_t WS_WIN = 0;
constexpr size_t WS_WOUT = WS_WIN + (size_t)NIN * DM * 2;
constexpr size_t WS_WGU = WS_WOUT + (size_t)DM * DM * 2;
constexpr size_t WS_WD = WS_WGU + (size_t)2 * FH * DM * 2;
constexpr size_t WS_ROPE = WS_WD + (size_t)DM * FH * 2;
constexpr size_t WS_LSE = WS_ROPE + (size_t)4100 * 64 * 8;
constexpr size_t WS_R1 = WS_LSE + (size_t)MPAD * 12 * 4;
constexpr size_t WS_XB = WS_R1;
constexpr size_t WS_Q = WS_XB + (size_t)MPAD * DM * 2;
constexpr size_t WS_K = WS_Q + (size_t)MPAD * AW * 2;
constexpr size_t WS_V = WS_K + (size_t)MPAD * AW * 2;
constexpr size_t WS_U = WS_V + (size_t)MPAD * AW * 2;
constexpr size_t WS_R1END = WS_U + (size_t)MPAD * CCH * 4;
constexpr size_t WS_H = WS_R1;
constexpr size_t WS_AO = WS_R1END;
constexpr size_t WS_Z1 = WS_AO + (size_t)MPAD * DM * 2;
constexpr size_t WS_BAR = WS_Z1 + (size_t)MPAD * DM * 4;
constexpr size_t WS_END = WS_BAR + 16384;
static_assert((size_t)MPAD * FH * 2 <= WS_R1END - WS_R1, "H alias");

struct Params {
    const float *xp, *xs, *c0, *c1, *c2, *sconv, *w_in, *w_out, *conv_w, *conv_b, *cln_g, *cln_b, *ln1_g, *ln1_b, *w_gate, *w_up, *w_down, *ln2_g, *ln2_b;
    float* out; unsigned char* ws;
};

__device__ __forceinline__ unsigned cvt_pk_bf16(float lo, float hi) { unsigned r; asm volatile("v_cvt_pk_bf16_f32 %0, %1, %2" : "=v"(r) : "v"(lo), "v"(hi)); return r; }
__device__ __forceinline__ float bf2f(unsigned short b) { return __uint_as_float(((unsigned)b) << 16); }
__device__ __forceinline__ u32x2 pack4(f32x4 v) { u32x2 r; r.x = cvt_pk_bf16(v[0], v[1]); r.y = cvt_pk_bf16(v[2], v[3]); return r; }
__device__ __forceinline__ u32x4 pack8(f32x4 a, f32x4 b) { u32x4 r; r.x = cvt_pk_bf16(a[0], a[1]); r.y = cvt_pk_bf16(a[2], a[3]); r.z = cvt_pk_bf16(b[0], b[1]); r.w = cvt_pk_bf16(b[2], b[3]); return r; }
__device__ __forceinline__ float wave_sum(float v) {
#pragma unroll
    for (int o = 1; o < 64; o <<= 1) v += __shfl_xor(v, o);
    return v;
}
__device__ __forceinline__ float wave_max(float v) {
#pragma unroll
    for (int o = 1; o < 64; o <<= 1) v = fmaxf(v, __shfl_xor(v, o));
    return v;
}
__device__ __forceinline__ float fast_sigmoid(float g) { return 1.0f / (1.0f + __expf(-g)); }

#define XB_TMO      128
#define XB_XCNT(j)  (256  + 64 * (j))
#define XB_XSUB(j)  (1280 + 64 * (j))
#define XB_XGEN(j)  (2304 + 64 * (j))
#define XB_TOP      3328
#define XB_TOPGEN   3392
#define XCD_BAR_WORDS 3456
#define XB_SPIN_CAP (1u << 18)
__device__ __forceinline__ unsigned xb_ld(unsigned* p)              { return __hip_atomic_load(p, __ATOMIC_RELAXED, __HIP_MEMORY_SCOPE_AGENT); }
__device__ __forceinline__ unsigned xb_add(unsigned* p, unsigned v) { return __hip_atomic_fetch_add(p, v, __ATOMIC_RELAXED, __HIP_MEMORY_SCOPE_AGENT); }
__device__ __forceinline__ unsigned xb_xcc_id() { return (unsigned)__builtin_amdgcn_s_getreg((3 << 11) | 20) & 0xFu; }
#define XB_SPIN(cond, bar) do { unsigned _sp = 0; while (cond) { __builtin_amdgcn_s_sleep(1); \
    if ((++_sp & 255u) == 0u) { if (xb_ld(&(bar)[XB_TMO])) break; if (_sp > XB_SPIN_CAP) { atomicAdd(&(bar)[XB_TMO], 1u); break; } } } } while (0)
struct XcdBarrier { unsigned* bar; unsigned x; volatile LAS unsigned* st; };
__device__ __forceinline__ XcdBarrier xcd_barrier_post(unsigned* bar, volatile LAS unsigned* st) {
    XcdBarrier b; b.bar = bar; b.x = xb_xcc_id(); b.st = st;
    if (threadIdx.x == 0) (void)xb_add(&bar[XB_XCNT(b.x)], 1u);
    return b;
}
__device__ __forceinline__ void xcd_barrier_complete(unsigned* bar, unsigned x, unsigned& nloc, unsigned& nx) {
    const unsigned G = gridDim.x * gridDim.y * gridDim.z;
    unsigned sum, cnt, mine, sp = 0u;
    for (;;) {
        sum = 0u; cnt = 0u; mine = 0u;
#pragma unroll
        for (unsigned j = 0; j < 16; ++j) { const unsigned c = xb_ld(&bar[XB_XCNT(j)]); sum += c; cnt += (c > 0u) ? 1u : 0u; mine = (j == x) ? c : mine; }
        if (sum == G) break;
        __builtin_amdgcn_s_sleep(1);
        if ((++sp & 255u) == 0u) { if (xb_ld(&bar[XB_TMO])) break; if (sp > XB_SPIN_CAP) { atomicAdd(&bar[XB_TMO], 1u); break; } }
    }
    nloc = mine > 0u ? mine : 1u; nx = cnt > 0u ? cnt : 1u;
}
__device__ __forceinline__ void xcd_barrier(const XcdBarrier& b) {
    asm volatile("s_waitcnt vmcnt(0)" ::: "memory");
    __syncthreads();
    if (threadIdx.x == 0) {
        unsigned* bar = b.bar;
        __builtin_amdgcn_s_waitcnt(0);
        unsigned nloc = b.st[0], nx = b.st[1];
        if (nloc == 0u) { xcd_barrier_complete(bar, b.x, nloc, nx); b.st[0] = nloc; b.st[1] = nx; }
        const unsigned old = xb_add(&bar[XB_XSUB(b.x)], 1u);
        const unsigned gen = old / nloc;
        if (old + 1u == (gen + 1u) * nloc) {
            __builtin_amdgcn_fence(__ATOMIC_RELEASE, "agent");
            asm volatile("s_waitcnt vmcnt(0)" ::: "memory");
            const unsigned og = xb_add(&bar[XB_TOP], 1u);
            const unsigned tg = og / nx;
            if (og + 1u == (tg + 1u) * nx) xb_add(&bar[XB_TOPGEN], 1u);
            else XB_SPIN(xb_ld(&bar[XB_TOPGEN]) == tg, bar);
            __builtin_amdgcn_fence(__ATOMIC_ACQUIRE, "agent");
            xb_add(&bar[XB_XGEN(b.x)], 1u);
            asm volatile("s_waitcnt vmcnt(0)" ::: "memory");
        } else {
            XB_SPIN(xb_ld(&bar[XB_XGEN(b.x)]) == gen, bar);
            __builtin_amdgcn_fence(__ATOMIC_ACQUIRE, "agent");
            asm volatile("s_waitcnt vmcnt(0)" ::: "memory");
        }
    }
    __syncthreads();
}

constexpr int BM = 256, BK = 64, HALF = 128, HTB = HALF * BK * 2, STAGE_BYTES = 8 * HTB, NXCD = 8, WGM = 8;
__device__ __forceinline__ int lds_byte(int r, int c) { const int st = (r >> 4) * 2 + (c >> 5), rr = r & 15, cc = c & 31, ob = rr * 64 + cc * 2; return st * 1024 + (ob ^ (((ob >> 9) & 1) << 5)); }
__device__ __forceinline__ void stage_rc(int b, int& R, int& C) { const int st = b / 1024, sb = b % 1024, swz = sb ^ (((sb >> 9) & 1) << 5); R = (st >> 1) * 16 + swz / 64; C = (st & 1) * 32 + (swz % 64) / 2; }
struct Unit { int pm, pn; };
struct Gemm { const bf16_t* A; const bf16_t* Bt; int M, N, K; };
struct StaticOrder {
    int nM, nN, nwg, G, c;
    __device__ void init(int M, int N, int G_, int c_) { nM = M / BM; nN = N / BM; nwg = nM * nN; G = G_; c = c_; }
    __device__ bool next(int i, Unit& u) const {
        const long L = (long)i * G + c; if (L >= nwg) return false;
        int wgid = (int)L; { const int q = nwg / NXCD, r = nwg % NXCD, xcd = wgid % NXCD, off = wgid / NXCD; wgid = (xcd < r ? xcd * (q + 1) : r * (q + 1) + (xcd - r) * q) + off; }
        const int nig = WGM * nN, gid = wgid / nig, fm = gid * WGM, gsz = (nM - fm) < WGM ? (nM - fm) : WGM;
        u.pm = fm + ((wgid % nig) % gsz); u.pn = (wgid % nig) / gsz; return true;
    }
};

template <class Epi>
__device__ __forceinline__ void gemm_phase(LAS unsigned char* lds, const Gemm g, const StaticOrder& S, const Epi& E) {
    const int tid = threadIdx.x, wid = __builtin_amdgcn_readfirstlane(tid >> 6), lane = tid & 63, wr = wid >> 2, wc = wid & 3, fr = lane & 15, fq = lane >> 4;
    const int K = g.K, nt = K / BK;
    unsigned voffA[2];
#pragma unroll
    for (int i = 0; i < 2; ++i) { int R, C; stage_rc(tid * 16 + i * 8192, R, C); voffA[i] = (unsigned)(R * K + C) * 2u; }
    const size_t kstep = (size_t)(BK * 2);
    const size_t hstep = (size_t)HALF * K * 2;
    const size_t tstep = 2 * hstep;
    const unsigned ldsw = (unsigned)wid * 1024u;
    const int aoff = lds_byte(wr * 64 + fr, fq * 8), boff = lds_byte(wc * 32 + fr, fq * 8);
#define PG8_SA(b, h) (((b) * 2 + (h)) * HTB)
#define PG8_SB(b, h) ((4 + (b) * 2 + (h)) * HTB)
#define PG8_STAGE(bufoff, gbase, voff) do { _Pragma("unroll") for (int _i = 0; _i < 2; ++_i) \
        __builtin_amdgcn_global_load_lds((const unsigned*)((const char*)(gbase) + (voff)[_i]), (LAS unsigned*)(lds + (bufoff) + ldsw + _i * 8192), 16, 0, 0); } while (0)
#define PG8_LDA(dst, b, h) do { _Pragma("unroll") for (int m = 0; m < 4; ++m) _Pragma("unroll") for (int k = 0; k < 2; ++k) dst[m][k] = *(const LAS bf16x8*)(lds + PG8_SA(b, h) + aoff + m * 2048 + k * 1024); } while (0)
#define PG8_LDB(dst, b, h) do { _Pragma("unroll") for (int n = 0; n < 2; ++n) _Pragma("unroll") for (int k = 0; k < 2; ++k) dst[n][k] = *(const LAS bf16x8*)(lds + PG8_SB(b, h) + boff + n * 2048 + k * 1024); } while (0)
#define PG8_MMA(ai, bj, At, Bt) do { __builtin_amdgcn_s_setprio(1); _Pragma("unroll") for (int m = 0; m < 4; ++m) _Pragma("unroll") for (int n = 0; n < 2; ++n) _Pragma("unroll") for (int k = 0; k < 2; ++k) \
        acc[ai][bj][m][n] = __builtin_amdgcn_mfma_f32_16x16x32_bf16(Bt[n][k], At[m][k], acc[ai][bj][m][n], 0, 0, 0); __builtin_amdgcn_s_setprio(0); } while (0)
#define PG8_WAIT_V(n) asm volatile("s_waitcnt vmcnt(" #n ")" ::: "memory")
#define PG8_WAIT_L(n) asm volatile("s_waitcnt lgkmcnt(" #n ")" ::: "memory")
#define PG8_BAR __builtin_amdgcn_s_barrier()
#define PG8_SCHED __builtin_amdgcn_sched_barrier(0)
    Unit cur, nxt; int ui = 0;
    if (!S.next(0, cur)) return;
    f32x4 acc[2][2][4][2];
#pragma unroll
    for (int a = 0; a < 2; ++a)
#pragma unroll
        for (int b = 0; b < 2; ++b)
#pragma unroll
            for (int m = 0; m < 4; ++m)
#pragma unroll
                for (int n = 0; n < 2; ++n) acc[a][b][m][n] = (f32x4){0.f, 0.f, 0.f, 0.f};
    bf16x8 At[4][2], B0[2][2], B1[2][2];
    const char* cA = (const char*)g.A + (size_t)cur.pm * tstep; const char* cB = (const char*)g.Bt + (size_t)cur.pn * tstep;
    PG8_STAGE(PG8_SB(0, 0), cB, voffA); PG8_STAGE(PG8_SA(0, 0), cA, voffA); PG8_STAGE(PG8_SB(0, 1), cB + hstep, voffA); PG8_STAGE(PG8_SA(0, 1), cA + hstep, voffA);
    if (wr == 1) PG8_BAR;
    PG8_WAIT_V(4); PG8_BAR;
    PG8_STAGE(PG8_SB(1, 0), cB + kstep, voffA); PG8_STAGE(PG8_SA(1, 0), cA + kstep, voffA); PG8_STAGE(PG8_SB(1, 1), cB + hstep + kstep, voffA);
    PG8_WAIT_V(6); PG8_BAR;
    for (;;) {
        const bool has_next = S.next(ui + 1, nxt);
        const char* nA = has_next ? (const char*)g.A + (size_t)nxt.pm * tstep : cA; const char* nB = has_next ? (const char*)g.Bt + (size_t)nxt.pn * tstep : cB;
        for (int t = 0; t < nt; t += 2) {
            const bool last = (t == nt - 2);
            const char* a1 = cA + (size_t)(t + 1) * kstep;
            const char* a2 = last ? nA : cA + (size_t)(t + 2) * kstep; const char* b2 = last ? nB : cB + (size_t)(t + 2) * kstep;
            const char* a3 = a2 + kstep; const char* b3 = b2 + kstep;
            PG8_LDB(B0, 0, 0); PG8_SCHED; PG8_LDA(At, 0, 0); PG8_STAGE(PG8_SA(1, 1), a1 + hstep, voffA);
            PG8_WAIT_L(8); PG8_BAR; PG8_WAIT_L(0); PG8_MMA(0, 0, At, B0); PG8_BAR; PG8_SCHED;
            PG8_LDB(B1, 0, 1); PG8_STAGE(PG8_SB(0, 0), b2, voffA);
            PG8_BAR; PG8_WAIT_L(0); PG8_MMA(0, 1, At, B1); PG8_BAR;
            PG8_LDA(At, 0, 1); PG8_STAGE(PG8_SA(0, 0), a2, voffA);
            PG8_BAR; PG8_WAIT_L(0); PG8_MMA(1, 0, At, B0); PG8_BAR; PG8_SCHED;
            PG8_STAGE(PG8_SB(0, 1), b2 + hstep, voffA);
            PG8_WAIT_V(6); PG8_BAR; PG8_MMA(1, 1, At, B1); PG8_BAR;
            PG8_LDB(B0, 1, 0); PG8_SCHED; PG8_LDA(At, 1, 0); PG8_STAGE(PG8_SA(0, 1), a2 + hstep, voffA);
            PG8_WAIT_L(8); PG8_BAR; PG8_WAIT_L(0); PG8_MMA(0, 0, At, B0); PG8_BAR; PG8_SCHED;
            PG8_LDB(B1, 1, 1); PG8_STAGE(PG8_SB(1, 0), b3, voffA);
            PG8_BAR; PG8_WAIT_L(0); PG8_MMA(0, 1, At, B1); PG8_BAR;
            PG8_LDA(At, 1, 1); PG8_STAGE(PG8_SA(1, 0), a3, voffA);
            PG8_BAR; PG8_WAIT_L(0); PG8_MMA(1, 0, At, B0); PG8_BAR; PG8_SCHED;
            PG8_STAGE(PG8_SB(1, 1), b3 + hstep, voffA);
            PG8_WAIT_V(6); PG8_BAR; PG8_MMA(1, 1, At, B1); PG8_BAR;
        }
        E(acc, cur, wr, wc, fr, fq);
        if (!has_next) break;
#pragma unroll
        for (int a = 0; a < 2; ++a)
#pragma unroll
            for (int b = 0; b < 2; ++b)
#pragma unroll
                for (int m = 0; m < 4; ++m)
#pragma unroll
                    for (int n = 0; n < 2; ++n) acc[a][b][m][n] = (f32x4){0.f, 0.f, 0.f, 0.f};
        cur = nxt; cA = nA; cB = nB; ++ui;
    }
    PG8_WAIT_V(0);
    if (wr == 0) PG8_BAR;
    PG8_BAR;
#undef PG8_SA
#undef PG8_SB
#undef PG8_STAGE
#undef PG8_LDA
#undef PG8_LDB
#undef PG8_MMA
#undef PG8_WAIT_V
#undef PG8_WAIT_L
#undef PG8_BAR
#undef PG8_SCHED
}

__device__ __forceinline__ float* kv_out_ptr(float* out, int r, int gi, bool& ok) {
    const int keep = 128 << (2 * gi);
    ok = false;
    if (r < MP) {
        const int b = r >> 12, t = r & 4095;
        if (t < SEQ - keep) return out;
        ok = true;
        const size_t base = gi == 0 ? O_KVP0 : (gi == 1 ? O_KVP1 : O_KVP2);
        return out + base + ((size_t)(b * keep + t - (SEQ - keep))) * 1024;
    }
    if (r < MT) {
        const int b = (r - MP) >> 2, t = (r - MP) & 3;
        ok = true;
        const size_t base = gi == 0 ? O_KVS0 : (gi == 1 ? O_KVS1 : O_KVS2);
        return out + base + ((size_t)(b * keep + keep - 4 + t)) * 1024;
    }
    return out;
}

struct EpiIn {
    bf16_t *Qb, *Kb, *Vb; float* U; const float* rope; float* out;
    __device__ __forceinline__ void operator()(const f32x4 (&acc)[2][2][4][2], const Unit& u, int wr, int wc, int fr, int fq) const {
        const int pn = u.pn;
#pragma unroll
        for (int ai = 0; ai < 2; ++ai)
#pragma unroll
            for (int m = 0; m < 4; ++m) {
                const int r = u.pm * 256 + ai * 128 + wr * 64 + m * 16 + fr;
                if (pn < 12) {
                    const int pidx = r < MP ? (r & 4095) : (r < MT ? 4096 + ((r - MP) & 3) : 0);
                    const f32x4* rp = (const f32x4*)(rope + ((size_t)pidx * 64 + 16 * wc + 4 * fq) * 2);
                    const f32x4 cs0 = rp[0], cs1 = rp[1];
                    const f32x4 c = {cs0[0], cs0[2], cs1[0], cs1[2]}, s = {cs0[1], cs0[3], cs1[1], cs1[3]};
                    const int col = 16 * wc + 4 * fq;
#pragma unroll
                    for (int bj = 0; bj < 2; ++bj) {
                        const f32x4 x1 = acc[ai][bj][m][0], x2 = acc[ai][bj][m][1];
                        f32x4 o1 = x1 * c - x2 * s, o2 = x2 * c + x1 * s;
                        const int hq = 2 * pn + bj;
                        if (pn < 6) {
                            o1 = o1 * QSCALE; o2 = o2 * QSCALE;
                            bf16_t* dst = Qb + (size_t)r * AW + hq * 128 + col;
                            *(u32x2*)dst = pack4(o1); *(u32x2*)(dst + 64) = pack4(o2);
                        } else {
                            const int hk = hq - 12;
                            bf16_t* dst = Kb + (size_t)r * AW + hk * 128 + col;
                            *(u32x2*)dst = pack4(o1); *(u32x2*)(dst + 64) = pack4(o2);
                            bool ok; float* o = kv_out_ptr(out, r, hk >> 2, ok);
                            if (ok) { o += (hk & 3) * 128 + col; *(f32x4*)o = o1; *(f32x4*)(o + 64) = o2; }
                        }
                    }
                } else if (pn < 18) {
                    const int col = 32 * wc + 8 * fq;
#pragma unroll
                    for (int bj = 0; bj < 2; ++bj) {
                        const int hv = 2 * (pn - 12) + bj;
                        const f32x4 v0 = acc[ai][bj][m][0], v1 = acc[ai][bj][m][1];
                        *(u32x4*)(Vb + (size_t)r * AW + hv * 128 + col) = pack8(v0, v1);
                        bool ok; float* o = kv_out_ptr(out, r, hv >> 2, ok);
                        if (ok) { o += 512 + (hv & 3) * 128 + col; *(f32x4*)o = v0; *(f32x4*)(o + 4) = v1; }
                    }
                } else {
                    const int ch = 128 * (pn - 18) + 32 * wc + 8 * fq;
                    f32x4 u0, u1;
#pragma unroll
                    for (int e = 0; e < 4; ++e) { u0[e] = acc[ai][0][m][0][e] * fast_sigmoid(acc[ai][1][m][0][e]); u1[e] = acc[ai][0][m][1][e] * fast_sigmoid(acc[ai][1][m][1][e]); }
                    float* up = U + (size_t)r * CCH + ch;
                    *(f32x4*)up = u0; *(f32x4*)(up + 4) = u1;
                    float* o = nullptr;
                    if (r < MP) { const int b = r >> 12, t = r & 4095; if (t >= SEQ - 30) o = out + O_CONVP + ((size_t)(b * 30 + t - (SEQ - 30))) * CCH + ch; }
                    else if (r < MT) { const int b = (r - MP) >> 2, t = (r - MP) & 3; o = out + O_CONVS + ((size_t)(b * 30 + 26 + t)) * CCH + ch; }
                    if (o) { *(f32x4*)o = u0; *(f32x4*)(o + 4) = u1; }
                }
            }
    }
};
struct EpiOut {
    const float *xp, *xs; float* Z;
    __device__ __forceinline__ void operator()(const f32x4 (&acc)[2][2][4][2], const Unit& u, int wr, int wc, int fr, int fq) const {
#pragma unroll
        for (int ai = 0; ai < 2; ++ai)
#pragma unroll
            for (int m = 0; m < 4; ++m) {
                const int r = u.pm * 256 + ai * 128 + wr * 64 + m * 16 + fr;
                const float* xrow = r < MP ? xp + (size_t)r * DM : (r < MT ? xs + (size_t)(r - MP) * DM : nullptr);
#pragma unroll
                for (int bj = 0; bj < 2; ++bj)
#pragma unroll
                    for (int n = 0; n < 2; ++n) {
                        const int col = u.pn * 256 + bj * 128 + wc * 32 + n * 16 + 4 * fq;
                        f32x4 xv = {0.f, 0.f, 0.f, 0.f}; if (xrow) xv = *(const f32x4*)(xrow + col);
                        *(f32x4*)(Z + (size_t)r * DM + col) = xv * ALPHA + acc[ai][bj][m][n];
                    }
            }
    }
};
struct EpiGU {
    bf16_t* H;
    __device__ __forceinline__ void operator()(const f32x4 (&acc)[2][2][4][2], const Unit& u, int wr, int wc, int fr, int fq) const {
#pragma unroll
        for (int ai = 0; ai < 2; ++ai)
#pragma unroll
            for (int m = 0; m < 4; ++m) {
                const int r = u.pm * 256 + ai * 128 + wr * 64 + m * 16 + fr;
                const int col = 128 * u.pn + 32 * wc + 8 * fq;
                f32x4 h0, h1;
#pragma unroll
                for (int e = 0; e < 4; ++e) {
                    const float g0 = acc[ai][0][m][0][e], g1 = acc[ai][0][m][1][e];
                    h0[e] = g0 * fast_sigmoid(g0) * acc[ai][1][m][0][e]; h1[e] = g1 * fast_sigmoid(g1) * acc[ai][1][m][1][e];
                }
                *(u32x4*)(H + (size_t)r * FH + col) = pack8(h0, h1);
            }
    }
};
struct EpiNull {
    float* Z;
    __device__ __forceinline__ void operator()(const f32x4 (&acc)[2][2][4][2], const Unit& u, int wr, int wc, int fr, int fq) const {
        float s = 0.f;
#pragma unroll
        for (int ai = 0; ai < 2; ++ai)
#pragma unroll
            for (int bj = 0; bj < 2; ++bj)
#pragma unroll
                for (int m = 0; m < 4; ++m)
#pragma unroll
                    for (int n = 0; n < 2; ++n) s += acc[ai][bj][m][n][0] + acc[ai][bj][m][n][1] + acc[ai][bj][m][n][2] + acc[ai][bj][m][n][3];
        if (s != s) Z[threadIdx.x] = s;
    }
};
struct EpiDown {
    const float* X1; float* Y;
    __device__ __forceinline__ void operator()(const f32x4 (&acc)[2][2][4][2], const Unit& u, int wr, int wc, int fr, int fq) const {
#pragma unroll
        for (int ai = 0; ai < 2; ++ai)
#pragma unroll
            for (int m = 0; m < 4; ++m) {
                const int r = u.pm * 256 + ai * 128 + wr * 64 + m * 16 + fr;
                if (r < MT) {
#pragma unroll
                    for (int bj = 0; bj < 2; ++bj)
#pragma unroll
                        for (int n = 0; n < 2; ++n) {
                            const int col = u.pn * 256 + bj * 128 + wc * 32 + n * 16 + 4 * fq;
                            const f32x4 xv = *(const f32x4*)(X1 + (size_t)r * DM + col);
                            *(f32x4*)(Y + (size_t)r * DM + col) = xv * ALPHA + acc[ai][bj][m][n];
                        }
                }
            }
    }
};

template <int KSTEPS>
__device__ __forceinline__ void skinny_gemm(LAS unsigned char* lds, const bf16_t* A, const bf16_t* Bt, const float* resid, float* dst) {
    constexpr int K = 8 * 32 * KSTEPS;
    const int tid = threadIdx.x, w = tid >> 6, lane = tid & 63, fr = lane & 15, fq = lane >> 4;
    for (int item = blockIdx.x; item < 256; item += gridDim.x) {
        const int rh = item & 1, cb = item >> 1;
        const bf16_t* ap = A + (size_t)(rh * 16 + fr) * K + w * (32 * KSTEPS) + 8 * fq;
        const bf16_t* bp = Bt + (size_t)(cb * 16 + fr) * K + w * (32 * KSTEPS) + 8 * fq;
        f32x4 acc = {0.f, 0.f, 0.f, 0.f};
#pragma unroll (KSTEPS > 11 ? 11 : KSTEPS)
        for (int s = 0; s < KSTEPS; ++s) { const bf16x8 a = *(const bf16x8*)(ap + 32 * s), bb = *(const bf16x8*)(bp + 32 * s); acc = __builtin_amdgcn_mfma_f32_16x16x32_bf16(bb, a, acc, 0, 0, 0); }
        *(LAS f32x4*)(lds + (w * 64 + lane) * 16) = acc;
        __syncthreads();
        if (w == 0) {
            f32x4 sum = *(const LAS f32x4*)(lds + lane * 16);
#pragma unroll
            for (int ww = 1; ww < 8; ++ww) sum = sum + *(const LAS f32x4*)(lds + (ww * 64 + lane) * 16);
            const size_t o = (size_t)(rh * 16 + fr) * DM + cb * 16 + 4 * fq;
            *(f32x4*)(dst + o) = *(const f32x4*)(resid + o) * ALPHA + sum;
        }
        __syncthreads();
    }
}

__device__ __forceinline__ int perm8(int s) { return 8 * ((s >> 2) & 3) + 4 * ((s >> 4) & 1) + (s & 3); }
__device__ __forceinline__ int src_col_in(int np) {
    const int pn = np >> 8, bj = (np >> 7) & 1, s = np & 127;
    if (pn < 12) { const int wc = s >> 5, n = (s >> 4) & 1, q4 = s & 15; return (2 * pn + bj) * 128 + 64 * n + 16 * wc + q4; }
    if (pn < 18) return (2 * pn + bj) * 128 + (s & ~31) + perm8(s & 31);
    return (bj ? 5120 : 4608) + 128 * (pn - 18) + (s & ~31) + perm8(s & 31);
}
__device__ __forceinline__ void cvt_unit(const float* W, int ldw, int K, int srccol, bf16_t* Bt, int nrow, int k0, int oct) {
    const float* src = W + (size_t)(k0 + 8 * oct) * ldw + srccol;
    f32x4 v[8];
#pragma unroll
    for (int j = 0; j < 8; ++j) v[j] = *(const f32x4*)(src + (size_t)j * ldw);
#pragma unroll
    for (int e = 0; e < 4; ++e) {
        u32x4 o; o.x = cvt_pk_bf16(v[0][e], v[1][e]); o.y = cvt_pk_bf16(v[2][e], v[3][e]); o.z = cvt_pk_bf16(v[4][e], v[5][e]); o.w = cvt_pk_bf16(v[6][e], v[7][e]);
        *(u32x4*)(Bt + (size_t)(nrow + e) * K + k0 + 8 * oct) = o;
    }
}
__device__ __forceinline__ void phase_convert(const Params& p, LAS unsigned char* lds) {
    const int tid = threadIdx.x, G = gridDim.x, bid = blockIdx.x;
    unsigned char* ws = p.ws;
    { bf16_t* Xb = (bf16_t*)(ws + WS_XB);
      for (size_t i = (size_t)bid * 512 + tid; i < (size_t)MT * DM / 8; i += (size_t)G * 512) {
          const size_t e = i * 8; const float* src = e < (size_t)MP * DM ? p.xp + e : p.xs + (e - (size_t)MP * DM);
          const f32x4 a = *(const f32x4*)src, b = *(const f32x4*)(src + 4);
          *(u32x4*)(Xb + e) = pack8(a, b); } }
    { float* rope = (float*)(ws + WS_ROPE);
      for (int i = bid * 512 + tid; i < 4100 * 64; i += G * 512) {
          const int pr = i >> 6, k = i & 63; const double pos = pr < 4096 ? (double)pr : (double)(16384 + pr - 4096);
          const double inv = exp2(-(double)k * (13.287712379549449 / 64.0));
          double sn, cs; sincos(pos * inv, &sn, &cs);
          rope[2 * i] = (float)cs; rope[2 * i + 1] = (float)sn; } }
    { const int lane = tid & 63, grp = lane >> 3, oct = lane & 7, gw = bid * 8 + (tid >> 6), NW = G * 8;
      constexpr int NB_IN = NIN / 32, NB_OUT = DM / 32, NB_GU = 2 * FH / 32, NB_D = DM / 32;
      constexpr int U_IN = NB_IN * (DM / 64), U_OUT = NB_OUT * (DM / 64), U_GU = NB_GU * (DM / 64), U_D = NB_D * (FH / 64);
      for (int it = gw; it < U_IN + U_OUT + U_GU + U_D; it += NW) {
          int r = it;
          if (r < U_IN) { const int nb = r % NB_IN, kb = r / NB_IN, np = nb * 32 + 4 * grp; cvt_unit(p.w_in, NIN, DM, src_col_in(np), (bf16_t*)(ws + WS_WIN), np, kb * 64, oct); continue; }
          r -= U_IN;
          if (r < U_OUT) { const int nb = r % NB_OUT, kb = r / NB_OUT, np = nb * 32 + 4 * grp; cvt_unit(p.w_out, DM, DM, np, (bf16_t*)(ws + WS_WOUT), np, kb * 64, oct); continue; }
          r -= U_OUT;
          if (r < U_GU) { const int nb = r % NB_GU, kb = r / NB_GU, np = nb * 32 + 4 * grp, pn = np >> 8, bj = (np >> 7) & 1, sl = np & 127;
              cvt_unit(bj ? p.w_up : p.w_gate, FH, DM, 128 * pn + (sl & ~31) + perm8(sl & 31), (bf16_t*)(ws + WS_WGU), np, kb * 64, oct); continue; }
          r -= U_GU;
          { const int nb = r % NB_D, kb = r / NB_D, np = nb * 32 + 4 * grp; cvt_unit(p.w_down, DM, FH, np, (bf16_t*)(ws + WS_WD), np, kb * 64, oct); }
      } }
    { const size_t gt = (size_t)bid * 512 + tid, gs = (size_t)G * 512;
      for (int gi = 0; gi < 3; ++gi) {
          const int buf = 128 << (2 * gi); const float* src = gi == 0 ? p.c0 : (gi == 1 ? p.c1 : p.c2);
          float* dst = p.out + (gi == 0 ? O_KVS0 : (gi == 1 ? O_KVS1 : O_KVS2));
          const size_t per_b = (size_t)(buf - 4) * 256;
          for (size_t i = gt; i < 8 * per_b; i += gs) { const size_t b = i / per_b, o = i % per_b;
              ((f32x4*)dst)[b * buf * 256 + o] = ((const f32x4*)src)[b * buf * 256 + 4 * 256 + o]; } }
      const size_t per_b = 26 * 128;
      for (size_t i = gt; i < 8 * per_b; i += gs) { const size_t b = i / per_b, o = i % per_b;
          ((f32x4*)(p.out + O_CONVS))[b * 30 * 128 + o] = ((const f32x4*)p.sconv)[b * 30 * 128 + 4 * 128 + o]; } }
}

__device__ __forceinline__ unsigned off_b(unsigned row, unsigned ch) { return 256u * row + 16u * (ch ^ (((row & 3) << 2) | ((row >> 2) & 3))); }

__device__ __forceinline__ void attn_prompt_item(const Params& p, LAS unsigned char* lds, int item) {
    const int tid = threadIdx.x, w = tid >> 6, lane = tid & 63, fr = lane & 15, fq = lane >> 4;
    const int blk = item & 31, hs = (item >> 5) & 3, g = (item >> 7) % 3, b = item / 384;
    const int dsh = 2 * g, d = 1 << dsh, rcls = blk & (d - 1), n = blk >> dsh, head = g * 4 + hs;
    const bf16_t* Qb = (const bf16_t*)(p.ws + WS_Q); const bf16_t* Kb = (const bf16_t*)(p.ws + WS_K); const bf16_t* Vb = (const bf16_t*)(p.ws + WS_V);
    bf16_t* AO = (bf16_t*)(p.ws + WS_AO); float* LSE = (float*)(p.ws + WS_LSE);
    {
        const int ch = tid & 15, r0 = tid >> 4;
        u32x4 kv[8], vv[8];
#pragma unroll
        for (int i = 0; i < 8; ++i) {
            const int row = r0 + 32 * i, j = 128 * (n - 1) + row;
            kv[i] = (u32x4){0u, 0u, 0u, 0u}; vv[i] = kv[i];
            if (j >= 0) { const size_t gi = ((size_t)(b * SEQ + j * d + rcls)) * AW + head * 128 + ch * 8; kv[i] = *(const u32x4*)(Kb + gi); vv[i] = *(const u32x4*)(Vb + gi); }
        }
#pragma unroll
        for (int i = 0; i < 8; ++i) { const int row = r0 + 32 * i; *(LAS u32x4*)(lds + off_b(row, ch)) = kv[i]; *(LAS u32x4*)(lds + 65536 + off_b(row, ch)) = vv[i]; }
    }
    const int qi = 16 * w + fr;
    const size_t qrow = (size_t)(b * SEQ + (128 * n + qi) * d + rcls);
    bf16x8 qf[4];
#pragma unroll
    for (int ks = 0; ks < 4; ++ks) qf[ks] = *(const bf16x8*)(Qb + qrow * AW + head * 128 + 32 * ks + 8 * fq);
    __syncthreads();
    f32x4 s[9];
#pragma unroll
    for (int tt = 0; tt < 9; ++tt) {
        const int T = w + tt; s[tt] = (f32x4){0.f, 0.f, 0.f, 0.f};
#pragma unroll
        for (int ks = 0; ks < 4; ++ks) { const bf16x8 kf = *(const LAS bf16x8*)(lds + off_b(16 * T + fr, 4 * ks + fq)); s[tt] = __builtin_amdgcn_mfma_f32_16x16x32_bf16(kf, qf[ks], s[tt], 0, 0, 0); }
    }
    const int kmin = n == 0 ? 128 : 0;
    float mx = -3.0e38f;
#pragma unroll
    for (int tt = 0; tt < 9; ++tt)
#pragma unroll
        for (int e = 0; e < 4; ++e) { const int kk = 16 * (w + tt) + 4 * fq + e; const bool ok = kk >= qi && kk <= qi + 128 && kk >= kmin; s[tt][e] = ok ? s[tt][e] : -3.0e38f; mx = fmaxf(mx, s[tt][e]); }
    mx = fmaxf(mx, __shfl_xor(mx, 16)); mx = fmaxf(mx, __shfl_xor(mx, 32));
    float den = 0.f;
#pragma unroll
    for (int tt = 0; tt < 9; ++tt)
#pragma unroll
        for (int e = 0; e < 4; ++e) { const float pv = __builtin_amdgcn_exp2f(s[tt][e] - mx); s[tt][e] = pv; den += pv; }
    den += __shfl_xor(den, 16); den += __shfl_xor(den, 32);
    f32x4 o[8];
#pragma unroll
    for (int dt = 0; dt < 8; ++dt) o[dt] = (f32x4){0.f, 0.f, 0.f, 0.f};
    const int q4 = (lane & 15) >> 2, p4 = lane & 3;
#pragma unroll
    for (int ku = 0; ku < 5; ++ku) {
        const int T0 = w + 2 * ku, T1 = ku < 4 ? T0 + 1 : T0;
        union { bf16x8 v; unsigned u[4]; } pf;
        pf.u[0] = cvt_pk_bf16(s[2 * ku][0], s[2 * ku][1]); pf.u[1] = cvt_pk_bf16(s[2 * ku][2], s[2 * ku][3]);
        if (ku < 4) { pf.u[2] = cvt_pk_bf16(s[2 * ku + 1][0], s[2 * ku + 1][1]); pf.u[3] = cvt_pk_bf16(s[2 * ku + 1][2], s[2 * ku + 1][3]); } else { pf.u[2] = 0u; pf.u[3] = 0u; }
#pragma unroll
        for (int dt = 0; dt < 8; ++dt) {
            union { bf16x8 v; bf16x4 h[2]; } vf;
            vf.h[0] = __builtin_amdgcn_ds_read_tr16_b64_v4i16((LAS bf16x4*)(lds + 65536 + off_b(16 * T0 + 4 * fq + q4, 2 * dt + (p4 >> 1)) + 8 * (p4 & 1)));
            vf.h[1] = __builtin_amdgcn_ds_read_tr16_b64_v4i16((LAS bf16x4*)(lds + 65536 + off_b(16 * T1 + 4 * fq + q4, 2 * dt + (p4 >> 1)) + 8 * (p4 & 1)));
            o[dt] = __builtin_amdgcn_mfma_f32_16x16x32_bf16(vf.v, pf.v, o[dt], 0, 0, 0);
        }
    }
    const float rden = 1.0f / den;
    bf16_t* orow = AO + qrow * DM + head * 128 + 4 * fq;
#pragma unroll
    for (int dt = 0; dt < 8; ++dt) *(u32x2*)(orow + 16 * dt) = pack4(o[dt] * rden);
    if (fq == 0) LSE[qrow * 12 + head] = mx + __builtin_amdgcn_logf(den);
    __syncthreads();
}

__device__ __forceinline__ void attn_sample_item(const Params& p, LAS unsigned char* lds, int item) {
    const int tid = threadIdx.x;
    const int hs = item & 3, g = (item >> 2) % 3, b = item / 12, d = 1 << (2 * g), buf = 128 * d, head = g * 4 + hs;
    const float* cache = g == 0 ? p.c0 : (g == 1 ? p.c1 : p.c2);
    const float* okv = p.out + (g == 0 ? O_KVS0 : (g == 1 ? O_KVS1 : O_KVS2));
    LAS float* qs = (LAS float*)lds;
    LAS float* sc = qs + 512;
    LAS float* st = sc + 4 * 132;
    LAS float* part = st + 8;
    const bf16_t* Qb = (const bf16_t*)(p.ws + WS_Q);
    { const int t = tid >> 7, j = tid & 127; qs[tid] = bf2f(Qb[((size_t)MP + b * 4 + t) * AW + head * 128 + j]); }
    __syncthreads();
    {
        const int sub = tid & 3;
#pragma unroll
        for (int ps = 0; ps < 5; ++ps) {
            const int pi = ps * 128 + (tid >> 2);
            const bool act = pi < 516;
            const int t = act ? pi / 129 : 0, jj = act ? pi % 129 : 0;
            const int idx = buf + t - d * jj;
            const float* kr = (idx < buf ? cache + ((size_t)(b * buf + idx)) * 1024 : okv + ((size_t)(b * buf + idx - 4)) * 1024) + hs * 128 + 32 * sub;
            f32x4 kv[8];
#pragma unroll
            for (int c = 0; c < 8; ++c) kv[c] = *(const f32x4*)(kr + 4 * c);
            float dot = 0.f;
#pragma unroll
            for (int c = 0; c < 8; ++c) { const LAS float* qq = qs + t * 128 + 32 * sub + 4 * c; dot += kv[c][0] * qq[0] + kv[c][1] * qq[1] + kv[c][2] * qq[2] + kv[c][3] * qq[3]; }
            dot += __shfl_xor(dot, 1); dot += __shfl_xor(dot, 2);
            if (act && sub == 0) sc[t * 132 + jj] = dot;
        }
    }
    __syncthreads();
    if (tid < 256) {
        const int tw = tid >> 6, lane = tid & 63;
        const float a0 = sc[tw * 132 + lane], a1 = sc[tw * 132 + 64 + lane], a2 = lane == 0 ? sc[tw * 132 + 128] : -3.0e38f;
        const float mx = wave_max(fmaxf(fmaxf(a0, a1), a2));
        const float e0 = __builtin_amdgcn_exp2f(a0 - mx), e1 = __builtin_amdgcn_exp2f(a1 - mx), e2 = lane == 0 ? __builtin_amdgcn_exp2f(a2 - mx) : 0.f;
        const float den = wave_sum(e0 + e1 + e2);
        sc[tw * 132 + lane] = e0; sc[tw * 132 + 64 + lane] = e1; if (lane == 0) { sc[tw * 132 + 128] = e2; st[tw * 2] = den; st[tw * 2 + 1] = mx + __builtin_amdgcn_logf(den); }
    }
    __syncthreads();
    {
        const int t = tid >> 7, kq = (tid >> 5) & 3, dd4 = tid & 31;
        f32x4 acc = {0.f, 0.f, 0.f, 0.f};
#pragma unroll 11
        for (int i = 0; i < 33; ++i) {
            const int jj = kq + 4 * i;
            if (jj <= 128) {
                const int idx = buf + t - d * jj;
                const float* vr = (idx < buf ? cache + ((size_t)(b * buf + idx)) * 1024 : okv + ((size_t)(b * buf + idx - 4)) * 1024) + 512 + hs * 128 + 4 * dd4;
                acc = acc + *(const f32x4*)vr * sc[t * 132 + jj];
            }
        }
        *(LAS f32x4*)(part + (t * 4 + kq) * 128 + 4 * dd4) = acc;
    }
    __syncthreads();
    {
        const int t = tid >> 7, j = tid & 127;
        const size_t row = (size_t)MP + b * 4 + t;
        const float acc = (part[(t * 4 + 0) * 128 + j] + part[(t * 4 + 1) * 128 + j]) + (part[(t * 4 + 2) * 128 + j] + part[(t * 4 + 3) * 128 + j]);
        bf16_t* AO = (bf16_t*)(p.ws + WS_AO);
        AO[row * DM + head * 128 + j] = (bf16_t)(cvt_pk_bf16(acc / st[t * 2], 0.f) & 0xffffu);
        if (j == 0) ((float*)(p.ws + WS_LSE))[row * 12 + head] = st[t * 2 + 1];
    }
    __syncthreads();
}

__device__ __forceinline__ void conv_item(const Params& p, LAS unsigned char* lds, int item) {
    const int tid = threadIdx.x, ch = tid;
    const float* U = (const float*)(p.ws + WS_U);
    const bool samp = item >= 256;
    const int b = samp ? item - 256 : item >> 7, t0 = samp ? 0 : (item & 127) * 32;
    float wgt[31];
#pragma unroll
    for (int j = 0; j < 31; ++j) wgt[j] = p.conv_w[j * CCH + ch];
    float acc[32];
    const float bias = p.conv_b[ch];
#pragma unroll
    for (int t = 0; t < 32; ++t) acc[t] = bias;
#pragma unroll
    for (int rr = 0; rr < 62; ++rr) {
        float uv = 0.f;
        if (!samp) { const int tok = t0 - 30 + rr; if (tok >= 0) uv = U[((size_t)(b * SEQ + tok)) * CCH + ch]; }
        else { if (rr < 30) uv = p.sconv[((size_t)(b * 30 + rr)) * CCH + ch]; else if (rr < 34) uv = U[((size_t)(MP + b * 4 + rr - 30)) * CCH + ch]; }
#pragma unroll
        for (int t = 0; t < 32; ++t) { const int j = rr - t; if (j >= 0 && j <= 30) acc[t] += wgt[j] * uv; }
    }
    LAS float* ct = (LAS float*)lds;
#pragma unroll
    for (int t = 0; t < 32; ++t) ct[t * CCH + ch] = acc[t];
    __syncthreads();
    {
        const int w = tid >> 6, lane = tid & 63;
        bf16_t* AO = (bf16_t*)(p.ws + WS_AO);
        const int ntok = samp ? 4 : 32;
        for (int tt = 0; tt < 4; ++tt) {
            const int t = 4 * w + tt;
            if (t < ntok) {
                float x[8]; float sm = 0.f;
#pragma unroll
                for (int i = 0; i < 8; ++i) { x[i] = ct[t * CCH + lane + 64 * i]; sm += x[i]; }
                const float mean = wave_sum(sm) * (1.0f / CCH); float s2 = 0.f;
#pragma unroll
                for (int i = 0; i < 8; ++i) { x[i] -= mean; s2 += x[i] * x[i]; }
                const float rstd = rsqrtf(wave_sum(s2) * (1.0f / CCH) + LN_EPS);
                const size_t row = samp ? (size_t)MP + b * 4 + t : (size_t)b * SEQ + t0 + t;
#pragma unroll
                for (int i = 0; i < 8; ++i) { const int c = lane + 64 * i; float y = x[i] * rstd * p.cln_g[c] + p.cln_b[c]; y = y * fast_sigmoid(y);
                    AO[row * DM + AW + c] = (bf16_t)(cvt_pk_bf16(y, 0.f) & 0xffffu); }
            }
        }
    }
    __syncthreads();
}

__device__ __forceinline__ void phase_mixers(const Params& p, LAS unsigned char* lds) {
    constexpr int N_AP = 2 * 3 * 4 * 32, N_AS = 8 * 12, N_CV = 256 + 8;
    const int G = gridDim.x;
    for (int it = blockIdx.x; it < N_AP; it += G) attn_prompt_item(p, lds, it);
    for (int it = (blockIdx.x + N_AS) % G; it < N_AS; it += G) attn_sample_item(p, lds, it);
    for (int it = blockIdx.x; it < N_CV; it += G) conv_item(p, lds, it);
}

__device__ __forceinline__ void phase_alpha(const Params& p) {
    bf16_t* AO = (bf16_t*)(p.ws + WS_AO); const float* LSE = (const float*)(p.ws + WS_LSE);
    for (size_t i = (size_t)blockIdx.x * 512 + threadIdx.x; i < (size_t)MT * 12 * 16; i += (size_t)gridDim.x * 512) {
        const int c = (int)(i & 15), s = (int)((i >> 4) % 12); const size_t row = i / 192;
        const int g = s >> 2, hs = s & 3;
        const float l0 = LSE[row * 12 + hs], l1 = LSE[row * 12 + 4 + hs], l2 = LSE[row * 12 + 8 + hs];
        const float mx = fmaxf(l0, fmaxf(l1, l2));
        const float e0 = __builtin_amdgcn_exp2f(l0 - mx), e1 = __builtin_amdgcn_exp2f(l1 - mx), e2 = __builtin_amdgcn_exp2f(l2 - mx);
        const float al = (g == 0 ? e0 : (g == 1 ? e1 : e2)) / (e0 + e1 + e2);
        u32x4* ptr = (u32x4*)(AO + row * DM + s * 128 + c * 8);
        u32x4 v = *ptr;
#pragma unroll
        for (int k = 0; k < 4; ++k) { const float lo = __uint_as_float(v[k] << 16) * al, hi = __uint_as_float(v[k] & 0xffff0000u) * al; v[k] = cvt_pk_bf16(lo, hi); }
        *ptr = v;
    }
}

__device__ __forceinline__ void phase_ln(const float* src, float* dstf, bf16_t* dstb, const float* gam, const float* bet) {
    const int lane = threadIdx.x & 63, gw = blockIdx.x * 8 + (threadIdx.x >> 6), NW = gridDim.x * 8;
    f32x4 gv[8], bv[8];
#pragma unroll
    for (int j = 0; j < 8; ++j) { gv[j] = *(const f32x4*)(gam + 4 * lane + 256 * j); bv[j] = *(const f32x4*)(bet + 4 * lane + 256 * j); }
    for (int r = gw; r < MT; r += NW) {
        const float* xr = src + (size_t)r * DM + 4 * lane;
        f32x4 v[8]; float sm = 0.f;
#pragma unroll
        for (int j = 0; j < 8; ++j) { v[j] = *(const f32x4*)(xr + 256 * j); sm += (v[j][0] + v[j][1]) + (v[j][2] + v[j][3]); }
        const float mean = wave_sum(sm) * (1.0f / DM); float s2 = 0.f;
#pragma unroll
        for (int j = 0; j < 8; ++j) { v[j] = v[j] - mean; s2 += (v[j][0] * v[j][0] + v[j][1] * v[j][1]) + (v[j][2] * v[j][2] + v[j][3] * v[j][3]); }
        const float rstd = rsqrtf(wave_sum(s2) * (1.0f / DM) + LN_EPS);
#pragma unroll
        for (int j = 0; j < 8; ++j) {
            const f32x4 y = v[j] * rstd * gv[j] + bv[j];
            if (dstf) *(f32x4*)(dstf + (size_t)r * DM + 4 * lane + 256 * j) = y;
            if (dstb) *(u32x2*)(dstb + (size_t)r * DM + 4 * lane + 256 * j) = pack4(y);
        }
    }
}

constexpr int REP0 = 1, REP2 = 1, REPG = 1, PROBE_NULLGU = 0, REPMASK = 0, NSYNC_PROBE = 0;
template <int MASK>
__global__ void __launch_bounds__(512, 2) fwd_kernel(Params p) {
    extern __shared__ __attribute__((aligned(16))) unsigned char shm[];
    LAS unsigned char* lds = (LAS unsigned char*)shm;
    unsigned char* ws = p.ws;
    __shared__ uint4 xb_words;
    if (threadIdx.x == 0) xb_words = make_uint4(0u, 0u, 0u, 0u);
    __syncthreads();
    const XcdBarrier xb = xcd_barrier_post((unsigned*)(ws + WS_BAR), (volatile LAS unsigned*)&xb_words);
    if (p.out == nullptr) cg::this_grid().sync();
#define GSYNC() xcd_barrier(xb)
#define PH(k) if constexpr ((MASK >> (k)) & 1)
#define SYNC(k) if constexpr (((MASK >> (k)) & 1) && (MASK & ((1 << (k)) - 1))) GSYNC();
    PH(0) for (int rep = 0; rep < REP0; ++rep) { phase_convert(p, lds); if (rep + 1 < REP0) GSYNC(); }
    SYNC(1)
    PH(1) { Gemm g{(const bf16_t*)(ws + WS_XB), (const bf16_t*)(ws + WS_WIN), MPAD, NIN, DM}; StaticOrder S; S.init(MPAD, NIN, gridDim.x, blockIdx.x);
            EpiIn E{(bf16_t*)(ws + WS_Q), (bf16_t*)(ws + WS_K), (bf16_t*)(ws + WS_V), (float*)(ws + WS_U), (const float*)(ws + WS_ROPE), p.out};
            gemm_phase(lds, g, S, E); if constexpr ((REPMASK >> 1) & 1) { GSYNC(); gemm_phase(lds, g, S, E); } }
    SYNC(2)
    PH(2) { phase_mixers(p, lds); if constexpr (REP2 == 2) { GSYNC(); phase_mixers(p, lds); } }
    SYNC(3)
    PH(3) phase_alpha(p);
    SYNC(4)
    PH(4) { skinny_gemm<8>(lds, (const bf16_t*)(ws + WS_AO) + (size_t)MP * DM, (const bf16_t*)(ws + WS_WOUT), p.xs, (float*)(ws + WS_Z1) + (size_t)MP * DM);
            Gemm g{(const bf16_t*)(ws + WS_AO), (const bf16_t*)(ws + WS_WOUT), MP, DM, DM}; StaticOrder S; S.init(MP, DM, gridDim.x, blockIdx.x);
            EpiOut E{p.xp, p.xs, (float*)(ws + WS_Z1)}; gemm_phase(lds, g, S, E); if constexpr ((REPMASK >> 4) & 1) { GSYNC(); gemm_phase(lds, g, S, E); } }
    SYNC(5)
    PH(5) phase_ln((const float*)(ws + WS_Z1), (float*)(ws + WS_Z1), (bf16_t*)(ws + WS_AO), p.ln1_g, p.ln1_b);
    SYNC(6)
    PH(6) { Gemm g{(const bf16_t*)(ws + WS_AO), (const bf16_t*)(ws + WS_WGU), MPAD, 2 * FH, DM}; StaticOrder S; S.init(MPAD, 2 * FH, gridDim.x, blockIdx.x);
            if constexpr (PROBE_NULLGU) { EpiNull EN{(float*)(ws + WS_LSE)}; gemm_phase(lds, g, S, EN); GSYNC(); }
            EpiGU E{(bf16_t*)(ws + WS_H)}; gemm_phase(lds, g, S, E); if constexpr ((REPMASK >> 6) & 1) { GSYNC(); gemm_phase(lds, g, S, E); } }
    SYNC(7)
    PH(7) { skinny_gemm<22>(lds, (const bf16_t*)(ws + WS_H) + (size_t)MP * FH, (const bf16_t*)(ws + WS_WD), (const float*)(ws + WS_Z1) + (size_t)MP * DM, p.out + (size_t)MP * DM);
            Gemm g{(const bf16_t*)(ws + WS_H), (const bf16_t*)(ws + WS_WD), MP, DM, FH}; StaticOrder S; S.init(MP, DM, gridDim.x, blockIdx.x);
            EpiDown E{(const float*)(ws + WS_Z1), p.out}; gemm_phase(lds, g, S, E); if constexpr ((REPMASK >> 7) & 1) { GSYNC(); gemm_phase(lds, g, S, E); } }
    SYNC(8)
    PH(8) phase_ln(p.out, p.out, nullptr, p.ln2_g, p.ln2_b);
    if constexpr (NSYNC_PROBE > 0) { for (int i = 0; i < NSYNC_PROBE; ++i) GSYNC(); }
#undef PH
#undef SYNC
}

#ifndef N_LAUNCH_MODE
#define N_LAUNCH_MODE 1
#endif
template <int MASK> static void launch_plain(const Params& p, int grid, hipStream_t stream) {
    static bool attr = false;
    if (!attr) { (void)hipFuncSetAttribute((const void*)fwd_kernel<MASK>, hipFuncAttributeMaxDynamicSharedMemorySize, STAGE_BYTES); attr = true; }
    hipLaunchKernelGGL(fwd_kernel<MASK>, dim3(grid), dim3(512), STAGE_BYTES, stream, p);
}
extern "C" void kernel_launch(void* const* d_in, const int* in_sizes, int n_in, void* d_out, int out_size, void* d_ws, size_t ws_size, hipStream_t stream) {
    static int grid = 0;
    if (grid == 0) {
        if (n_in != 19 || (size_t)out_size != O_END || ws_size < WS_END) { fprintf(stderr, "kernel_launch: unexpected shapes: n_in %d out %d ws %zu (need %zu)\n", n_in, out_size, ws_size, (size_t)WS_END); grid = -1; return; }
        int dev = 0, cus = 0, per_cu = 0;
        (void)hipGetDevice(&dev); (void)hipDeviceGetAttribute(&cus, hipDeviceAttributeMultiprocessorCount, dev);
#if N_LAUNCH_MODE == 1
        if (hipFuncSetAttribute((const void*)fwd_kernel<0x1FF>, hipFuncAttributeMaxDynamicSharedMemorySize, STAGE_BYTES) != hipSuccess) { fprintf(stderr, "kernel_launch: hipFuncSetAttribute failed\n"); grid = -1; return; }
        if (hipOccupancyMaxActiveBlocksPerMultiprocessor(&per_cu, (const void*)fwd_kernel<0x1FF>, 512, STAGE_BYTES) != hipSuccess || per_cu < 1) { fprintf(stderr, "kernel_launch: occupancy query failed (%d)\n", per_cu); (void)hipGetLastError(); }
#endif
        grid = cus;
        fprintf(stderr, "kernel_launch: grid %d (per_cu %d)\n", grid, per_cu);
    }
    if (grid < 0) return;
    Params p{};
    p.xp = (const float*)d_in[0]; p.xs = (const float*)d_in[1]; p.c0 = (const float*)d_in[2]; p.c1 = (const float*)d_in[3]; p.c2 = (const float*)d_in[4]; p.sconv = (const float*)d_in[5];
    p.w_in = (const float*)d_in[6]; p.w_out = (const float*)d_in[7]; p.conv_w = (const float*)d_in[8]; p.conv_b = (const float*)d_in[9]; p.cln_g = (const float*)d_in[10]; p.cln_b = (const float*)d_in[11];
    p.ln1_g = (const float*)d_in[12]; p.ln1_b = (const float*)d_in[13]; p.w_gate = (const float*)d_in[14]; p.w_up = (const float*)d_in[15]; p.w_down = (const float*)d_in[16]; p.ln2_g = (const float*)d_in[17]; p.ln2_b = (const float*)d_in[18];
    p.out = (float*)d_out; p.ws = (unsigned char*)d_ws;
#if N_LAUNCH_MODE == 1
    if (hipMemsetAsync((unsigned char*)d_ws + WS_BAR, 0, 16384, stream) != hipSuccess) { fprintf(stderr, "kernel_launch: memset of the barrier words failed\n"); return; }
    void* args[] = {&p};
    hipError_t e = hipLaunchCooperativeKernel((const void*)fwd_kernel<0x1FF>, dim3(grid), dim3(512), args, STAGE_BYTES, stream);
    if (e != hipSuccess) fprintf(stderr, "cooperative launch failed: %s (grid %d)\n", hipGetErrorString(e), grid);
#else
    launch_plain<1>(p, grid, stream); launch_plain<2>(p, grid, stream); launch_plain<4>(p, grid, stream); launch_plain<8>(p, grid, stream); launch_plain<16>(p, grid, stream);
    launch_plain<32>(p, grid, stream); launch_plain<64>(p, grid, stream); launch_plain<128>(p, grid, stream); launch_plain<256>(p, grid, stream);
#endif
}
```

```cpp
#include <hip/hip_runtime.h>
#include <hip/hip_cooperative_groups.h>
#include <cstdio>
namespace cg = cooperative_groups;

#define LAS __attribute__((address_space(3)))
typedef unsigned short bf16_t;
typedef short bf16x8 __attribute__((ext_vector_type(8)));
typedef short bf16x4 __attribute__((ext_vector_type(4)));
typedef float f32x4 __attribute__((ext_vector_type(4)));
typedef unsigned u32x4 __attribute__((ext_vector_type(4)));
typedef unsigned u32x2 __attribute__((ext_vector_type(2)));

constexpr int DM = 2048, SEQ = 4096, MP = 8192, MS = 32, MT = MP + MS, MPAD = 8448;
constexpr int AW = 1536, CCH = 512, NIN = 5632, FH = 5632;
constexpr float ALPHA = 1.189207115002721f;
constexpr float LN_EPS = 1e-5f;
constexpr float QSCALE = 0.08838834764831845f * 1.4426950408889634f;

constexpr size_t O_KVP0 = (size_t)MT * DM;
constexpr size_t O_KVP1 = O_KVP0 + 2 * 128 * 1024;
constexpr size_t O_KVP2 = O_KVP1 + 2 * 512 * 1024;
constexpr size_t O_CONVP = O_KVP2 + 2 * 2048 * 1024;
constexpr size_t O_KVS0 = O_CONVP + 2 * 30 * 512;
constexpr size_t O_KVS1 = O_KVS0 + 8 * 128 * 1024;
constexpr size_t O_KVS2 = O_KVS1 + 8 * 512 * 1024;
constexpr size_t O_CONVS = O_KVS2 + (size_t)8 * 2048 * 1024;
constexpr size_t O_END = O_CONVS + 8 * 30 * 512;

constexpr size_t WS_WIN = 0;
constexpr size_t WS_WOUT = WS_WIN + (size_t)NIN * DM * 2;
constexpr size_t WS_WGU = WS_WOUT + (size_t)DM * DM * 2;
constexpr size_t WS_WD = WS_WGU + (size_t)2 * FH * DM * 2;
constexpr size_t WS_ROPE = WS_WD + (size_t)DM * FH * 2;
constexpr size_t WS_LSE = WS_ROPE + (size_t)4100 * 64 * 8;
constexpr size_t WS_R1 = WS_LSE + (size_t)MPAD * 12 * 4;
constexpr size_t WS_XB = WS_R1;
constexpr size_t WS_Q = WS_XB + (size_t)MPAD * DM * 2;
constexpr size_t WS_K = WS_Q + (size_t)MPAD * AW * 2;
constexpr size_t WS_V = WS_K + (size_t)MPAD * AW * 2;
constexpr size_t WS_U = WS_V + (size_t)MPAD * AW * 2;
constexpr size_t WS_R1END = WS_U + (size_t)MPAD * CCH * 4;
constexpr size_t WS_H = WS_R1;
constexpr size_t WS_AO = WS_R1END;
constexpr size_t WS_Z1 = WS_AO + (size_t)MPAD * DM * 2;
constexpr size_t WS_BAR = WS_Z1 + (size_t)MPAD * DM * 4;
constexpr size_t WS_END = WS_BAR + 16384;
static_assert((size_t)MPAD * FH * 2 <= WS_R1END - WS_R1, "H alias");

struct Params {
    const float *xp, *xs, *c0, *c1, *c2, *sconv, *w_in, *w_out, *conv_w, *conv_b, *cln_g, *cln_b, *ln1_g, *ln1_b, *w_gate, *w_up, *w_down, *ln2_g, *ln2_b;
    float* out; unsigned char* ws;
};

__device__ __forceinline__ unsigned cvt_pk_bf16(float lo, float hi) { unsigned r; asm volatile("v_cvt_pk_bf16_f32 %0, %1, %2" : "=v"(r) : "v"(lo), "v"(hi)); return r; }
__device__ __forceinline__ float bf2f(unsigned short b) { return __uint_as_float(((unsigned)b) << 16); }
__device__ __forceinline__ u32x2 pack4(f32x4 v) { u32x2 r; r.x = cvt_pk_bf16(v[0], v[1]); r.y = cvt_pk_bf16(v[2], v[3]); return r; }
__device__ __forceinline__ u32x4 pack8(f32x4 a, f32x4 b) { u32x4 r; r.x = cvt_pk_bf16(a[0], a[1]); r.y = cvt_pk_bf16(a[2], a[3]); r.z = cvt_pk_bf16(b[0], b[1]); r.w = cvt_pk_bf16(b[2], b[3]); return r; }
__device__ __forceinline__ float wave_sum(float v) {
#pragma unroll
    for (int o = 1; o < 64; o <<= 1) v += __shfl_xor(v, o);
    return v;
}
__device__ __forceinline__ float wave_max(float v) {
#pragma unroll
    for (int o = 1; o < 64; o <<= 1) v = fmaxf(v, __shfl_xor(v, o));
    return v;
}
__device__ __forceinline__ int perm8(int s) { return 8 * ((s >> 2) & 3) + 4 * ((s >> 4) & 1) + (s & 3); }
__device__ __forceinline__ float fast_sigmoid(float g) { return 1.0f / (1.0f + __expf(-g)); }

#define XB_TMO      128
#define XB_XCNT(j)  (256  + 64 * (j))
#define XB_XSUB(j)  (1280 + 64 * (j))
#define XB_XGEN(j)  (2304 + 64 * (j))
#define XB_TOP      3328
#define XB_TOPGEN   3392
#define XCD_BAR_WORDS 3456
#define XB_SPIN_CAP (1u << 18)
__device__ __forceinline__ unsigned xb_ld(unsigned* p)              { return __hip_atomic_load(p, __ATOMIC_RELAXED, __HIP_MEMORY_SCOPE_AGENT); }
__device__ __forceinline__ unsigned xb_add(unsigned* p, unsigned v) { return __hip_atomic_fetch_add(p, v, __ATOMIC_RELAXED, __HIP_MEMORY_SCOPE_AGENT); }
__device__ __forceinline__ unsigned xb_xcc_id() { return (unsigned)__builtin_amdgcn_s_getreg((3 << 11) | 20) & 0xFu; }
#define XB_SPIN(cond, bar) do { unsigned _sp = 0; while (cond) { __builtin_amdgcn_s_sleep(1); \
    if ((++_sp & 255u) == 0u) { if (xb_ld(&(bar)[XB_TMO])) break; if (_sp > XB_SPIN_CAP) { atomicAdd(&(bar)[XB_TMO], 1u); break; } } } } while (0)
struct XcdBarrier { unsigned* bar; unsigned x; volatile LAS unsigned* st; };
__device__ __forceinline__ XcdBarrier xcd_barrier_post(unsigned* bar, volatile LAS unsigned* st) {
    XcdBarrier b; b.bar = bar; b.x = xb_xcc_id(); b.st = st;
    if (threadIdx.x == 0) (void)xb_add(&bar[XB_XCNT(b.x)], 1u);
    return b;
}
__device__ __forceinline__ void xcd_barrier_complete(unsigned* bar, unsigned x, unsigned& nloc, unsigned& nx) {
    const unsigned G = gridDim.x * gridDim.y * gridDim.z;
    unsigned sum, cnt, mine, sp = 0u;
    for (;;) {
        sum = 0u; cnt = 0u; mine = 0u;
#pragma unroll
        for (unsigned j = 0; j < 16; ++j) { const unsigned c = xb_ld(&bar[XB_XCNT(j)]); sum += c; cnt += (c > 0u) ? 1u : 0u; mine = (j == x) ? c : mine; }
        if (sum == G) break;
        __builtin_amdgcn_s_sleep(1);
        if ((++sp & 255u) == 0u) { if (xb_ld(&bar[XB_TMO])) break; if (sp > XB_SPIN_CAP) { atomicAdd(&bar[XB_TMO], 1u); break; } }
    }
    nloc = mine > 0u ? mine : 1u; nx = cnt > 0u ? cnt : 1u;
}
__device__ __forceinline__ void xcd_barrier(const XcdBarrier& b) {
    asm volatile("s_waitcnt vmcnt(0)" ::: "memory");
    __syncthreads();
    if (threadIdx.x == 0) {
        unsigned* bar = b.bar;
        __builtin_amdgcn_s_waitcnt(0);
        unsigned nloc = b.st[0], nx = b.st[1];
        if (nloc == 0u) { xcd_barrier_complete(bar, b.x, nloc, nx); b.st[0] = nloc; b.st[1] = nx; }
        const unsigned old = xb_add(&bar[XB_XSUB(b.x)], 1u);
        const unsigned gen = old / nloc;
        if (old + 1u == (gen + 1u) * nloc) {
            __builtin_amdgcn_fence(__ATOMIC_RELEASE, "agent");
            asm volatile("s_waitcnt vmcnt(0)" ::: "memory");
            const unsigned og = xb_add(&bar[XB_TOP], 1u);
            const unsigned tg = og / nx;
            if (og + 1u == (tg + 1u) * nx) xb_add(&bar[XB_TOPGEN], 1u);
            else XB_SPIN(xb_ld(&bar[XB_TOPGEN]) == tg, bar);
            __builtin_amdgcn_fence(__ATOMIC_ACQUIRE, "agent");
            xb_add(&bar[XB_XGEN(b.x)], 1u);
            asm volatile("s_waitcnt vmcnt(0)" ::: "memory");
        } else {
            XB_SPIN(xb_ld(&bar[XB_XGEN(b.x)]) == gen, bar);
            __builtin_amdgcn_fence(__ATOMIC_ACQUIRE, "agent");
            asm volatile("s_waitcnt vmcnt(0)" ::: "memory");
        }
    }
    __syncthreads();
}

constexpr int BM = 256, BK = 64, HALF = 128, HTB = HALF * BK * 2, STAGE_BYTES = 8 * HTB, NXCD = 8, WGM = 8;
__device__ __forceinline__ int lds_byte(int r, int c) { const int st = (r >> 4) * 2 + (c >> 5), rr = r & 15, cc = c & 31, ob = rr * 64 + cc * 2; return st * 1024 + (ob ^ (((ob >> 9) & 1) << 5)); }
__device__ __forceinline__ void stage_rc(int b, int& R, int& C) { const int st = b / 1024, sb = b % 1024, swz = sb ^ (((sb >> 9) & 1) << 5); R = (st >> 1) * 16 + swz / 64; C = (st & 1) * 32 + (swz % 64) / 2; }
struct Unit { int pm, pn; };
struct Gemm { const bf16_t* A; const bf16_t* Bt; int M, N, K; };
struct StaticOrder {
    int nM, nN, nwg, G, c;
    __device__ void init(int M, int N, int G_, int c_) { nM = M / BM; nN = N / BM; nwg = nM * nN; G = G_; c = c_; }
    __device__ bool next(int i, Unit& u) const {
        const long L = (long)i * G + c; if (L >= nwg) return false;
        int wgid = (int)L; { const int q = nwg / NXCD, r = nwg % NXCD, xcd = wgid % NXCD, off = wgid / NXCD; wgid = (xcd < r ? xcd * (q + 1) : r * (q + 1) + (xcd - r) * q) + off; }
        const int nig = WGM * nN, gid = wgid / nig, fm = gid * WGM, gsz = (nM - fm) < WGM ? (nM - fm) : WGM;
        u.pm = fm + ((wgid % nig) % gsz); u.pn = (wgid % nig) / gsz; return true;
    }
};

template <class Epi>
__device__ __forceinline__ void gemm_phase(LAS unsigned char* lds, const Gemm g, const StaticOrder& S, const Epi& E) {
    const int tid = threadIdx.x, wid = __builtin_amdgcn_readfirstlane(tid >> 6), lane = tid & 63, wr = wid >> 2, wc = wid & 3, fr = lane & 15, fq = lane >> 4;
    const int K = g.K, nt = K / BK;
    unsigned voffA[2];
#pragma unroll
    for (int i = 0; i < 2; ++i) { int R, C; stage_rc(tid * 16 + i * 8192, R, C); voffA[i] = (unsigned)(R * K + C) * 2u; }
    const size_t kstep = (size_t)(BK * 2);
    const size_t hstep = (size_t)HALF * K * 2;
    const size_t tstep = 2 * hstep;
    const unsigned ldsw = (unsigned)wid * 1024u;
    const int aoff = lds_byte(wr * 64 + fr, fq * 8), boff = lds_byte(wc * 32 + fr, fq * 8);
#define PG8_SA(b, h) (((b) * 2 + (h)) * HTB)
#define PG8_SB(b, h) ((4 + (b) * 2 + (h)) * HTB)
#define PG8_STAGE(bufoff, gbase, voff) do { _Pragma("unroll") for (int _i = 0; _i < 2; ++_i) \
        __builtin_amdgcn_global_load_lds((const unsigned*)((const char*)(gbase) + (voff)[_i]), (LAS unsigned*)(lds + (bufoff) + ldsw + _i * 8192), 16, 0, 0); } while (0)
#define PG8_LDA(dst, b, h) do { _Pragma("unroll") for (int m = 0; m < 4; ++m) _Pragma("unroll") for (int k = 0; k < 2; ++k) dst[m][k] = *(const LAS bf16x8*)(lds + PG8_SA(b, h) + aoff + m * 2048 + k * 1024); } while (0)
#define PG8_LDB(dst, b, h) do { _Pragma("unroll") for (int n = 0; n < 2; ++n) _Pragma("unroll") for (int k = 0; k < 2; ++k) dst[n][k] = *(const LAS bf16x8*)(lds + PG8_SB(b, h) + boff + n * 2048 + k * 1024); } while (0)
#define PG8_MMA(ai, bj, At, Bt) do { __builtin_amdgcn_s_setprio(1); _Pragma("unroll") for (int m = 0; m < 4; ++m) _Pragma("unroll") for (int n = 0; n < 2; ++n) _Pragma("unroll") for (int k = 0; k < 2; ++k) \
        acc[ai][bj][m][n] = __builtin_amdgcn_mfma_f32_16x16x32_bf16(Bt[n][k], At[m][k], acc[ai][bj][m][n], 0, 0, 0); __builtin_amdgcn_s_setprio(0); } while (0)
#define PG8_WAIT_V(n) asm volatile("s_waitcnt vmcnt(" #n ")" ::: "memory")
#define PG8_WAIT_L(n) asm volatile("s_waitcnt lgkmcnt(" #n ")" ::: "memory")
#define PG8_BAR __builtin_amdgcn_s_barrier()
#define PG8_SCHED __builtin_amdgcn_sched_barrier(0)
    Unit cur, nxt; int ui = 0;
    if (!S.next(0, cur)) return;
    f32x4 acc[2][2][4][2];
#pragma unroll
    for (int a = 0; a < 2; ++a)
#pragma unroll
        for (int b = 0; b < 2; ++b)
#pragma unroll
            for (int m = 0; m < 4; ++m)
#pragma unroll
                for (int n = 0; n < 2; ++n) acc[a][b][m][n] = (f32x4){0.f, 0.f, 0.f, 0.f};
    bf16x8 At[4][2], B0[2][2], B1[2][2];
    const char* cA = (const char*)g.A + (size_t)cur.pm * tstep; const char* cB = (const char*)g.Bt + (size_t)cur.pn * tstep;
    PG8_STAGE(PG8_SB(0, 0), cB, voffA); PG8_STAGE(PG8_SA(0, 0), cA, voffA); PG8_STAGE(PG8_SB(0, 1), cB + hstep, voffA); PG8_STAGE(PG8_SA(0, 1), cA + hstep, voffA);
    if (wr == 1) PG8_BAR;
    PG8_WAIT_V(4); PG8_BAR;
    PG8_STAGE(PG8_SB(1, 0), cB + kstep, voffA); PG8_STAGE(PG8_SA(1, 0), cA + kstep, voffA); PG8_STAGE(PG8_SB(1, 1), cB + hstep + kstep, voffA);
    PG8_WAIT_V(6); PG8_BAR;
    for (;;) {
        const bool has_next = S.next(ui + 1, nxt);
        const char* nA = has_next ? (const char*)g.A + (size_t)nxt.pm * tstep : cA; const char* nB = has_next ? (const char*)g.Bt + (size_t)nxt.pn * tstep : cB;
        for (int t = 0; t < nt; t += 2) {
            const bool last = (t == nt - 2);
            const char* a1 = cA + (size_t)(t + 1) * kstep;
            const char* a2 = last ? nA : cA + (size_t)(t + 2) * kstep; const char* b2 = last ? nB : cB + (size_t)(t + 2) * kstep;
            const char* a3 = a2 + kstep; const char* b3 = b2 + kstep;
            PG8_LDB(B0, 0, 0); PG8_SCHED; PG8_LDA(At, 0, 0); PG8_STAGE(PG8_SA(1, 1), a1 + hstep, voffA);
            PG8_WAIT_L(8); PG8_BAR; PG8_WAIT_L(0); PG8_MMA(0, 0, At, B0); PG8_BAR; PG8_SCHED;
            PG8_LDB(B1, 0, 1); PG8_STAGE(PG8_SB(0, 0), b2, voffA);
            PG8_BAR; PG8_WAIT_L(0); PG8_MMA(0, 1, At, B1); PG8_BAR;
            PG8_LDA(At, 0, 1); PG8_STAGE(PG8_SA(0, 0), a2, voffA);
            PG8_BAR; PG8_WAIT_L(0); PG8_MMA(1, 0, At, B0); PG8_BAR; PG8_SCHED;
            PG8_STAGE(PG8_SB(0, 1), b2 + hstep, voffA);
            PG8_WAIT_V(6); PG8_BAR; PG8_MMA(1, 1, At, B1); PG8_BAR;
            PG8_LDB(B0, 1, 0); PG8_SCHED; PG8_LDA(At, 1, 0); PG8_STAGE(PG8_SA(0, 1), a2 + hstep, voffA);
            PG8_WAIT_L(8); PG8_BAR; PG8_WAIT_L(0); PG8_MMA(0, 0, At, B0); PG8_BAR; PG8_SCHED;
            PG8_LDB(B1, 1, 1); PG8_STAGE(PG8_SB(1, 0), b3, voffA);
            PG8_BAR; PG8_WAIT_L(0); PG8_MMA(0, 1, At, B1); PG8_BAR;
            PG8_LDA(At, 1, 1); PG8_STAGE(PG8_SA(1, 0), a3, voffA);
            PG8_BAR; PG8_WAIT_L(0); PG8_MMA(1, 0, At, B0); PG8_BAR; PG8_SCHED;
            PG8_STAGE(PG8_SB(1, 1), b3 + hstep, voffA);
            PG8_WAIT_V(6); PG8_BAR; PG8_MMA(1, 1, At, B1); PG8_BAR;
        }
        E(acc, cur, wr, wc, fr, fq);
        if (!has_next) break;
#pragma unroll
        for (int a = 0; a < 2; ++a)
#pragma unroll
            for (int b = 0; b < 2; ++b)
#pragma unroll
                for (int m = 0; m < 4; ++m)
#pragma unroll
                    for (int n = 0; n < 2; ++n) acc[a][b][m][n] = (f32x4){0.f, 0.f, 0.f, 0.f};
        cur = nxt; cA = nA; cB = nB; ++ui;
    }
    PG8_WAIT_V(0);
    if (wr == 0) PG8_BAR;
    PG8_BAR;
#undef PG8_SA
#undef PG8_SB
#undef PG8_STAGE
#undef PG8_LDA
#undef PG8_LDB
#undef PG8_MMA
#undef PG8_WAIT_V
#undef PG8_WAIT_L
#undef PG8_BAR
#undef PG8_SCHED
}

__device__ __forceinline__ float* kv_out_ptr(float* out, int r, int gi, bool& ok) {
    const int keep = 128 << (2 * gi);
    ok = false;
    if (r < MP) {
        const int b = r >> 12, t = r & 4095;
        if (t < SEQ - keep) return out;
        ok = true;
        const size_t base = gi == 0 ? O_KVP0 : (gi == 1 ? O_KVP1 : O_KVP2);
        return out + base + ((size_t)(b * keep + t - (SEQ - keep))) * 1024;
    }
    if (r < MT) {
        const int b = (r - MP) >> 2, t = (r - MP) & 3;
        ok = true;
        const size_t base = gi == 0 ? O_KVS0 : (gi == 1 ? O_KVS1 : O_KVS2);
        return out + base + ((size_t)(b * keep + keep - 4 + t)) * 1024;
    }
    return out;
}

struct EpiIn {
    bf16_t *Qb, *Kb, *Vb; float* U; const float* rope; float* out;
    __device__ __forceinline__ void operator()(const f32x4 (&acc)[2][2][4][2], const Unit& u, int wr, int wc, int fr, int fq) const {
        const int pn = u.pn;
#pragma unroll
        for (int ai = 0; ai < 2; ++ai)
#pragma unroll
            for (int m = 0; m < 4; ++m) {
                const int r = u.pm * 256 + ai * 128 + wr * 64 + m * 16 + fr;
                if (pn < 12) {
                    const int pidx = r < MP ? (r & 4095) : (r < MT ? 4096 + ((r - MP) & 3) : 0);
                    const f32x4* rp = (const f32x4*)(rope + ((size_t)pidx * 64 + 16 * wc + 4 * fq) * 2);
                    const f32x4 cs0 = rp[0], cs1 = rp[1];
                    const f32x4 c = {cs0[0], cs0[2], cs1[0], cs1[2]}, s = {cs0[1], cs0[3], cs1[1], cs1[3]};
                    const int col = 16 * wc + 4 * fq;
#pragma unroll
                    for (int bj = 0; bj < 2; ++bj) {
                        const f32x4 x1 = acc[ai][bj][m][0], x2 = acc[ai][bj][m][1];
                        f32x4 o1 = x1 * c - x2 * s, o2 = x2 * c + x1 * s;
                        const int hq = 2 * pn + bj;
                        if (pn < 6) {
                            o1 = o1 * QSCALE; o2 = o2 * QSCALE;
                            bf16_t* dst = Qb + (size_t)r * AW + hq * 128 + col;
                            *(u32x2*)dst = pack4(o1); *(u32x2*)(dst + 64) = pack4(o2);
                        } else {
                            const int hk = hq - 12;
                            bf16_t* dst = Kb + (size_t)r * AW + hk * 128 + col;
                            *(u32x2*)dst = pack4(o1); *(u32x2*)(dst + 64) = pack4(o2);
                            bool ok; float* o = kv_out_ptr(out, r, hk >> 2, ok);
                            if (ok) { o += (hk & 3) * 128 + col; *(f32x4*)o = o1; *(f32x4*)(o + 64) = o2; }
                        }
                    }
                } else if (pn < 18) {
                    const int col = 32 * wc + 8 * fq;
#pragma unroll
                    for (int bj = 0; bj < 2; ++bj) {
                        const int hv = 2 * (pn - 12) + bj;
                        const f32x4 v0 = acc[ai][bj][m][0], v1 = acc[ai][bj][m][1];
                        *(u32x4*)(Vb + (size_t)r * AW + hv * 128 + col) = pack8(v0, v1);
                        bool ok; float* o = kv_out_ptr(out, r, hv >> 2, ok);
                        if (ok) { o += 512 + (hv & 3) * 128 + col; *(f32x4*)o = v0; *(f32x4*)(o + 4) = v1; }
                    }
                } else {
                    const int ch = 128 * (pn - 18) + 32 * wc + 8 * fq;
                    f32x4 u0, u1;
#pragma unroll
                    for (int e = 0; e < 4; ++e) { u0[e] = acc[ai][0][m][0][e] * fast_sigmoid(acc[ai][1][m][0][e]); u1[e] = acc[ai][0][m][1][e] * fast_sigmoid(acc[ai][1][m][1][e]); }
                    float* up = U + (size_t)r * CCH + ch;
                    *(f32x4*)up = u0; *(f32x4*)(up + 4) = u1;
                    float* o = nullptr;
                    if (r < MP) { const int b = r >> 12, t = r & 4095; if (t >= SEQ - 30) o = out + O_CONVP + ((size_t)(b * 30 + t - (SEQ - 30))) * CCH + ch; }
                    else if (r < MT) { const int b = (r - MP) >> 2, t = (r - MP) & 3; o = out + O_CONVS + ((size_t)(b * 30 + 26 + t)) * CCH + ch; }
                    if (o) { *(f32x4*)o = u0; *(f32x4*)(o + 4) = u1; }
                }
            }
    }
};
struct EpiOut {
    const bf16_t* Xb; bf16_t* Z;
    __device__ __forceinline__ void operator()(const f32x4 (&acc)[2][2][4][2], const Unit& u, int wr, int wc, int fr, int fq) const {
#pragma unroll
        for (int ai = 0; ai < 2; ++ai)
#pragma unroll
            for (int m = 0; m < 4; ++m) {
                const int r = u.pm * 256 + ai * 128 + wr * 64 + m * 16 + fr;
#pragma unroll
                for (int bj = 0; bj < 2; ++bj) {
                    const size_t o = (size_t)r * DM + u.pn * 256 + bj * 128 + wc * 32 + 8 * fq;
                    const u32x4 xv = *(const u32x4*)(Xb + o);
                    f32x4 z0, z1;
#pragma unroll
                    for (int k = 0; k < 2; ++k) { z0[2 * k] = __uint_as_float(xv[k] << 16); z0[2 * k + 1] = __uint_as_float(xv[k] & 0xffff0000u); z1[2 * k] = __uint_as_float(xv[2 + k] << 16); z1[2 * k + 1] = __uint_as_float(xv[2 + k] & 0xffff0000u); }
                    *(u32x4*)(Z + o) = pack8(z0 * ALPHA + acc[ai][bj][m][0], z1 * ALPHA + acc[ai][bj][m][1]);
                }
            }
    }
};
struct EpiGU {
    bf16_t* H;
    __device__ __forceinline__ void operator()(const f32x4 (&acc)[2][2][4][2], const Unit& u, int wr, int wc, int fr, int fq) const {
#pragma unroll
        for (int ai = 0; ai < 2; ++ai)
#pragma unroll
            for (int m = 0; m < 4; ++m) {
                const int r = u.pm * 256 + ai * 128 + wr * 64 + m * 16 + fr;
                const int col = 128 * u.pn + 32 * wc + 8 * fq;
                f32x4 h0, h1;
#pragma unroll
                for (int e = 0; e < 4; ++e) {
                    const float g0 = acc[ai][0][m][0][e], g1 = acc[ai][0][m][1][e];
                    h0[e] = g0 * fast_sigmoid(g0) * acc[ai][1][m][0][e]; h1[e] = g1 * fast_sigmoid(g1) * acc[ai][1][m][1][e];
                }
                *(u32x4*)(H + (size_t)r * FH + col) = pack8(h0, h1);
            }
    }
};
struct EpiNull {
    float* Z;
    __device__ __forceinline__ void operator()(const f32x4 (&acc)[2][2][4][2], const Unit& u, int wr, int wc, int fr, int fq) const {
        float s = 0.f;
#pragma unroll
        for (int ai = 0; ai < 2; ++ai)
#pragma unroll
            for (int bj = 0; bj < 2; ++bj)
#pragma unroll
                for (int m = 0; m < 4; ++m)
#pragma unroll
                    for (int n = 0; n < 2; ++n) s += acc[ai][bj][m][n][0] + acc[ai][bj][m][n][1] + acc[ai][bj][m][n][2] + acc[ai][bj][m][n][3];
        if (s != s) Z[threadIdx.x] = s;
    }
};
struct EpiDown {
    const bf16_t* X1; float* Y;
    __device__ __forceinline__ void operator()(const f32x4 (&acc)[2][2][4][2], const Unit& u, int wr, int wc, int fr, int fq) const {
#pragma unroll
        for (int ai = 0; ai < 2; ++ai)
#pragma unroll
            for (int m = 0; m < 4; ++m) {
                const int r = u.pm * 256 + ai * 128 + wr * 64 + m * 16 + fr;
#pragma unroll
                for (int bj = 0; bj < 2; ++bj) {
                    const size_t o = (size_t)r * DM + u.pn * 256 + bj * 128 + wc * 32 + 8 * fq;
                    const u32x4 xv = *(const u32x4*)(X1 + o);
                    f32x4 z0, z1;
#pragma unroll
                    for (int k = 0; k < 2; ++k) { z0[2 * k] = __uint_as_float(xv[k] << 16); z0[2 * k + 1] = __uint_as_float(xv[k] & 0xffff0000u); z1[2 * k] = __uint_as_float(xv[2 + k] << 16); z1[2 * k + 1] = __uint_as_float(xv[2 + k] & 0xffff0000u); }
                    *(f32x4*)(Y + o) = z0 * ALPHA + acc[ai][bj][m][0]; *(f32x4*)(Y + o + 4) = z1 * ALPHA + acc[ai][bj][m][1];
                }
            }
    }
};

template <int KSTEPS, bool DST_BF16>
__device__ __forceinline__ void skinny_gemm(LAS unsigned char* lds, const bf16_t* A, const bf16_t* Bt, const bf16_t* resid, void* dst) {
    constexpr int K = 8 * 32 * KSTEPS;
    const int tid = threadIdx.x, w = tid >> 6, lane = tid & 63, fr = lane & 15, fq = lane >> 4;
    for (int item = blockIdx.x; item < 256; item += gridDim.x) {
        const int rh = item & 1, cb = item >> 1;
        const bf16_t* ap = A + (size_t)(rh * 16 + fr) * K + w * (32 * KSTEPS) + 8 * fq;
        const bf16_t* bp = Bt + (size_t)(cb * 16 + fr) * K + w * (32 * KSTEPS) + 8 * fq;
        f32x4 acc = {0.f, 0.f, 0.f, 0.f};
#pragma unroll (KSTEPS > 11 ? 11 : KSTEPS)
        for (int s = 0; s < KSTEPS; ++s) { const bf16x8 a = *(const bf16x8*)(ap + 32 * s), bb = *(const bf16x8*)(bp + 32 * s); acc = __builtin_amdgcn_mfma_f32_16x16x32_bf16(bb, a, acc, 0, 0, 0); }
        *(LAS f32x4*)(lds + (w * 64 + lane) * 16) = acc;
        __syncthreads();
        if (w == 0) {
            f32x4 sum = *(const LAS f32x4*)(lds + lane * 16);
#pragma unroll
            for (int ww = 1; ww < 8; ++ww) sum = sum + *(const LAS f32x4*)(lds + (ww * 64 + lane) * 16);
            const int slot = cb * 16 + 4 * fq, col = (slot & ~31) + perm8(slot & 31);
            const size_t o = (size_t)(rh * 16 + fr) * DM + col;
            const u32x2 xv = *(const u32x2*)(resid + o);
            f32x4 z; z[0] = __uint_as_float(xv[0] << 16); z[1] = __uint_as_float(xv[0] & 0xffff0000u); z[2] = __uint_as_float(xv[1] << 16); z[3] = __uint_as_float(xv[1] & 0xffff0000u);
            z = z * ALPHA + sum;
            if (DST_BF16) *(u32x2*)((bf16_t*)dst + o) = pack4(z); else *(f32x4*)((float*)dst + o) = z;
        }
        __syncthreads();
    }
}

__device__ __forceinline__ int src_col_in(int np) {
    const int pn = np >> 8, bj = (np >> 7) & 1, s = np & 127;
    if (pn < 12) { const int wc = s >> 5, n = (s >> 4) & 1, q4 = s & 15; return (2 * pn + bj) * 128 + 64 * n + 16 * wc + q4; }
    if (pn < 18) return (2 * pn + bj) * 128 + (s & ~31) + perm8(s & 31);
    return (bj ? 5120 : 4608) + 128 * (pn - 18) + (s & ~31) + perm8(s & 31);
}
__device__ __forceinline__ void cvt_unit(const float* W, int ldw, int K, int srccol, bf16_t* Bt, int nrow, int k0, int oct) {
    const float* src = W + (size_t)(k0 + 8 * oct) * ldw + srccol;
    f32x4 v[8];
#pragma unroll
    for (int j = 0; j < 8; ++j) v[j] = *(const f32x4*)(src + (size_t)j * ldw);
#pragma unroll
    for (int e = 0; e < 4; ++e) {
        u32x4 o; o.x = cvt_pk_bf16(v[0][e], v[1][e]); o.y = cvt_pk_bf16(v[2][e], v[3][e]); o.z = cvt_pk_bf16(v[4][e], v[5][e]); o.w = cvt_pk_bf16(v[6][e], v[7][e]);
        *(u32x4*)(Bt + (size_t)(nrow + e) * K + k0 + 8 * oct) = o;
    }
}
constexpr int NB_IN = NIN / 32, NB_OUT = DM / 32, NB_GU = 2 * FH / 32, NB_D = DM / 32;
constexpr int U_IN = NB_IN * (DM / 64), U_OUT = NB_OUT * (DM / 64), U_GU = NB_GU * (DM / 64), U_D = NB_D * (FH / 64);
__device__ __forceinline__ void cvt_range(const Params& p, int u0, int u1, int gw, int NW) {
    unsigned char* ws = p.ws;
    const int lane = threadIdx.x & 63, grp = lane >> 3, oct = lane & 7;
    for (int it = u0 + gw; it < u1; it += NW) {
        int r = it;
        if (r < U_IN) { const int nb = r % NB_IN, kb = r / NB_IN, np = nb * 32 + 4 * grp; cvt_unit(p.w_in, NIN, DM, src_col_in(np), (bf16_t*)(ws + WS_WIN), np, kb * 64, oct); continue; }
        r -= U_IN;
        if (r < U_OUT) { const int nb = r % NB_OUT, kb = r / NB_OUT, np = nb * 32 + 4 * grp; cvt_unit(p.w_out, DM, DM, (np & ~31) + perm8(np & 31), (bf16_t*)(ws + WS_WOUT), np, kb * 64, oct); continue; }
        r -= U_OUT;
        if (r < U_GU) { const int nb = r % NB_GU, kb = r / NB_GU, np = nb * 32 + 4 * grp, pn = np >> 8, bj = (np >> 7) & 1, sl = np & 127;
            cvt_unit(bj ? p.w_up : p.w_gate, FH, DM, 128 * pn + (sl & ~31) + perm8(sl & 31), (bf16_t*)(ws + WS_WGU), np, kb * 64, oct); continue; }
        r -= U_GU;
        { const int nb = r % NB_D, kb = r / NB_D, np = nb * 32 + 4 * grp; cvt_unit(p.w_down, DM, FH, (np & ~31) + perm8(np & 31), (bf16_t*)(ws + WS_WD), np, kb * 64, oct); }
    }
}
__device__ __forceinline__ void copy_rows(const f32x4* src, f32x4* dst, size_t per_b, size_t bstride, size_t soff, size_t gt, size_t gs) {
    const size_t n = 8 * per_b;
    for (size_t i0 = gt; i0 < n; i0 += 8 * gs) {
        f32x4 v[8];
#pragma unroll
        for (int u = 0; u < 8; ++u) { const size_t i = i0 + (size_t)u * gs; if (i < n) { const size_t b = i / per_b, o = i - b * per_b; v[u] = __builtin_nontemporal_load(src + b * bstride + soff + o); } }
#pragma unroll
        for (int u = 0; u < 8; ++u) { const size_t i = i0 + (size_t)u * gs; if (i < n) { const size_t b = i / per_b, o = i - b * per_b; __builtin_nontemporal_store(v[u], dst + b * bstride + o); } }
    }
}
__device__ __forceinline__ void copy_caches(const Params& p, size_t gt, size_t gs) {
    copy_rows((const f32x4*)p.c2, (f32x4*)(p.out + O_KVS2), (size_t)(2048 - 4) * 256, (size_t)2048 * 256, 4 * 256, gt, gs);
    copy_rows((const f32x4*)p.c1, (f32x4*)(p.out + O_KVS1), (size_t)(512 - 4) * 256, (size_t)512 * 256, 4 * 256, gt, gs);
    copy_rows((const f32x4*)p.c0, (f32x4*)(p.out + O_KVS0), (size_t)(128 - 4) * 256, (size_t)128 * 256, 4 * 256, gt, gs);
    copy_rows((const f32x4*)p.sconv, (f32x4*)(p.out + O_CONVS), (size_t)26 * 128, (size_t)30 * 128, 4 * 128, gt, gs);
}
__device__ __forceinline__ void phase_convert(const Params& p, LAS unsigned char* lds) {
    const int tid = threadIdx.x, G = gridDim.x, bid = blockIdx.x;
    unsigned char* ws = p.ws;
    { bf16_t* Xb = (bf16_t*)(ws + WS_XB);
      for (size_t i = (size_t)bid * 512 + tid; i < (size_t)MT * DM / 8; i += (size_t)G * 512) {
          const size_t e = i * 8; const float* src = e < (size_t)MP * DM ? p.xp + e : p.xs + (e - (size_t)MP * DM);
          const f32x4 a = *(const f32x4*)src, b = *(const f32x4*)(src + 4);
          *(u32x4*)(Xb + e) = pack8(a, b); } }
    { float* rope = (float*)(ws + WS_ROPE);
      for (int i = bid * 512 + tid; i < 4100 * 64; i += G * 512) {
          const int pr = i >> 6, k = i & 63; const double pos = pr < 4096 ? (double)pr : (double)(16384 + pr - 4096);
          const double inv = exp2(-(double)k * (13.287712379549449 / 64.0));
          double sn, cs; sincos(pos * inv, &sn, &cs);
          rope[2 * i] = (float)cs; rope[2 * i + 1] = (float)sn; } }
    { const int gw = bid * 8 + (tid >> 6), NW = G * 8;
      cvt_range(p, 0, U_IN, gw, NW);
      cvt_range(p, U_IN + U_OUT, U_IN + U_OUT + U_GU, gw, NW); }
}

constexpr int MIXPROBE = 0;
__device__ __forceinline__ unsigned off_b(unsigned row, unsigned ch) { return 256u * row + 16u * (ch ^ (((row & 3) << 2) | ((row >> 2) & 3))); }

__device__ __forceinline__ void attn_prompt_item(const Params& p, LAS unsigned char* lds, int item) {
    const int tid = threadIdx.x, w = tid >> 6, lane = tid & 63, fr = lane & 15, fq = lane >> 4;
    const int blk = item & 31, hs = (item >> 5) & 3, g = (item >> 7) % 3, b = item / 384;
    const int dsh = 2 * g, d = 1 << dsh, rcls = blk & (d - 1), n = blk >> dsh, head = g * 4 + hs;
    const bf16_t* Qb = (const bf16_t*)(p.ws + WS_Q); const bf16_t* Kb = (const bf16_t*)(p.ws + WS_K); const bf16_t* Vb = (const bf16_t*)(p.ws + WS_V);
    bf16_t* AO = (bf16_t*)(p.ws + WS_AO); float* LSE = (float*)(p.ws + WS_LSE);
    {
        const int ch = tid & 15, r0 = tid >> 4;
        u32x4 kv[8], vv[8];
#pragma unroll
        for (int i = 0; i < 8; ++i) {
            const int row = r0 + 32 * i, j = 128 * (n - 1) + row;
            kv[i] = (u32x4){0u, 0u, 0u, 0u}; vv[i] = kv[i];
            if (j >= 0) { const size_t gi = ((size_t)(b * SEQ + j * d + rcls)) * AW + head * 128 + ch * 8; kv[i] = *(const u32x4*)(Kb + gi); vv[i] = *(const u32x4*)(Vb + gi); }
        }
#pragma unroll
        for (int i = 0; i < 8; ++i) { const int row = r0 + 32 * i; *(LAS u32x4*)(lds + off_b(row, ch)) = kv[i]; *(LAS u32x4*)(lds + 65536 + off_b(row, ch)) = vv[i]; }
    }
    const int qi = 16 * w + fr;
    const size_t qrow = (size_t)(b * SEQ + (128 * n + qi) * d + rcls);
    bf16x8 qf[4];
#pragma unroll
    for (int ks = 0; ks < 4; ++ks) qf[ks] = *(const bf16x8*)(Qb + qrow * AW + head * 128 + 32 * ks + 8 * fq);
    __syncthreads();
    f32x4 s[9];
#pragma unroll
    for (int tt = 0; tt < 9; ++tt) {
        const int T = w + tt; s[tt] = (f32x4){0.f, 0.f, 0.f, 0.f};
#pragma unroll
        for (int ks = 0; ks < 4; ++ks) { const bf16x8 kf = *(const LAS bf16x8*)(lds + off_b(16 * T + fr, 4 * ks + fq)); s[tt] = __builtin_amdgcn_mfma_f32_16x16x32_bf16(kf, qf[ks], s[tt], 0, 0, 0); }
    }
    const int kmin = n == 0 ? 128 : 0;
    float mx = -3.0e38f;
#pragma unroll
    for (int tt = 0; tt < 9; ++tt)
#pragma unroll
        for (int e = 0; e < 4; ++e) { const int kk = 16 * (w + tt) + 4 * fq + e; const bool ok = kk >= qi && kk <= qi + 128 && kk >= kmin; s[tt][e] = ok ? s[tt][e] : -3.0e38f; mx = fmaxf(mx, s[tt][e]); }
    mx = fmaxf(mx, __shfl_xor(mx, 16)); mx = fmaxf(mx, __shfl_xor(mx, 32));
    float den = 0.f;
#pragma unroll
    for (int tt = 0; tt < 9; ++tt)
#pragma unroll
        for (int e = 0; e < 4; ++e) { const float pv = __builtin_amdgcn_exp2f(s[tt][e] - mx); s[tt][e] = pv; den += pv; }
    den += __shfl_xor(den, 16); den += __shfl_xor(den, 32);
    f32x4 o[8];
#pragma unroll
    for (int dt = 0; dt < 8; ++dt) o[dt] = (f32x4){0.f, 0.f, 0.f, 0.f};
    const int q4 = (lane & 15) >> 2, p4 = lane & 3;
#pragma unroll
    for (int ku = 0; ku < 5; ++ku) {
        const int T0 = w + 2 * ku, T1 = ku < 4 ? T0 + 1 : T0;
        union { bf16x8 v; unsigned u[4]; } pf;
        pf.u[0] = cvt_pk_bf16(s[2 * ku][0], s[2 * ku][1]); pf.u[1] = cvt_pk_bf16(s[2 * ku][2], s[2 * ku][3]);
        if (ku < 4) { pf.u[2] = cvt_pk_bf16(s[2 * ku + 1][0], s[2 * ku + 1][1]); pf.u[3] = cvt_pk_bf16(s[2 * ku + 1][2], s[2 * ku + 1][3]); } else { pf.u[2] = 0u; pf.u[3] = 0u; }
#pragma unroll
        for (int dt = 0; dt < 8; ++dt) {
            union { bf16x8 v; bf16x4 h[2]; } vf;
            vf.h[0] = __builtin_amdgcn_ds_read_tr16_b64_v4i16((LAS bf16x4*)(lds + 65536 + off_b(16 * T0 + 4 * fq + q4, 2 * dt + (p4 >> 1)) + 8 * (p4 & 1)));
            vf.h[1] = __builtin_amdgcn_ds_read_tr16_b64_v4i16((LAS bf16x4*)(lds + 65536 + off_b(16 * T1 + 4 * fq + q4, 2 * dt + (p4 >> 1)) + 8 * (p4 & 1)));
            o[dt] = __builtin_amdgcn_mfma_f32_16x16x32_bf16(vf.v, pf.v, o[dt], 0, 0, 0);
        }
    }
    const float rden = 1.0f / den;
    bf16_t* orow = AO + qrow * DM + head * 128 + 4 * fq;
#pragma unroll
    for (int dt = 0; dt < 8; ++dt) *(u32x2*)(orow + 16 * dt) = pack4(o[dt] * rden);
    if (fq == 0) LSE[qrow * 12 + head] = mx + __builtin_amdgcn_logf(den);
    __syncthreads();
}

__device__ __forceinline__ void attn_sample_item(const Params& p, LAS unsigned char* lds, int item) {
    const int tid = threadIdx.x;
    const int hs = item & 3, g = (item >> 2) % 3, b = item / 12, d = 1 << (2 * g), buf = 128 * d, head = g * 4 + hs;
    const float* cache = g == 0 ? p.c0 : (g == 1 ? p.c1 : p.c2);
    const float* okv = p.out + (g == 0 ? O_KVS0 : (g == 1 ? O_KVS1 : O_KVS2));
    LAS float* qs = (LAS float*)lds;
    LAS float* sc = qs + 512;
    LAS float* st = sc + 4 * 132;
    LAS float* part = st + 8;
    const bf16_t* Qb = (const bf16_t*)(p.ws + WS_Q);
    { const int t = tid >> 7, j = tid & 127; qs[tid] = bf2f(Qb[((size_t)MP + b * 4 + t) * AW + head * 128 + j]); }
    __syncthreads();
    {
        const int sub = tid & 3;
#pragma unroll
        for (int ps = 0; ps < 5; ++ps) {
            const int pi = ps * 128 + (tid >> 2);
            const bool act = pi < 516;
            const int t = act ? pi / 129 : 0, jj = act ? pi % 129 : 0;
            const int idx = buf + t - d * jj;
            const float* kr = (idx < buf ? cache + ((size_t)(b * buf + idx)) * 1024 : okv + ((size_t)(b * buf + idx - 4)) * 1024) + hs * 128 + 32 * sub;
            f32x4 kv[8];
#pragma unroll
            for (int c = 0; c < 8; ++c) kv[c] = *(const f32x4*)(kr + 4 * c);
            float dot = 0.f;
#pragma unroll
            for (int c = 0; c < 8; ++c) { const LAS float* qq = qs + t * 128 + 32 * sub + 4 * c; dot += kv[c][0] * qq[0] + kv[c][1] * qq[1] + kv[c][2] * qq[2] + kv[c][3] * qq[3]; }
            dot += __shfl_xor(dot, 1); dot += __shfl_xor(dot, 2);
            if (act && sub == 0) sc[t * 132 + jj] = dot;
        }
    }
    __syncthreads();
    if (tid < 256) {
        const int tw = tid >> 6, lane = tid & 63;
        const float a0 = sc[tw * 132 + lane], a1 = sc[tw * 132 + 64 + lane], a2 = lane == 0 ? sc[tw * 132 + 128] : -3.0e38f;
        const float mx = wave_max(fmaxf(fmaxf(a0, a1), a2));
        const float e0 = __builtin_amdgcn_exp2f(a0 - mx), e1 = __builtin_amdgcn_exp2f(a1 - mx), e2 = lane == 0 ? __builtin_amdgcn_exp2f(a2 - mx) : 0.f;
        const float den = wave_sum(e0 + e1 + e2);
        sc[tw * 132 + lane] = e0; sc[tw * 132 + 64 + lane] = e1; if (lane == 0) { sc[tw * 132 + 128] = e2; st[tw * 2] = den; st[tw * 2 + 1] = mx + __builtin_amdgcn_logf(den); }
    }
    __syncthreads();
    {
        const int t = tid >> 7, kq = (tid >> 5) & 3, dd4 = tid & 31;
        f32x4 acc = {0.f, 0.f, 0.f, 0.f};
#pragma unroll 11
        for (int i = 0; i < 33; ++i) {
            const int jj = kq + 4 * i;
            if (jj <= 128) {
                const int idx = buf + t - d * jj;
                const float* vr = (idx < buf ? cache + ((size_t)(b * buf + idx)) * 1024 : okv + ((size_t)(b * buf + idx - 4)) * 1024) + 512 + hs * 128 + 4 * dd4;
                acc = acc + *(const f32x4*)vr * sc[t * 132 + jj];
            }
        }
        *(LAS f32x4*)(part + (t * 4 + kq) * 128 + 4 * dd4) = acc;
    }
    __syncthreads();
    {
        const int t = tid >> 7, j = tid & 127;
        const size_t row = (size_t)MP + b * 4 + t;
        const float acc = (part[(t * 4 + 0) * 128 + j] + part[(t * 4 + 1) * 128 + j]) + (part[(t * 4 + 2) * 128 + j] + part[(t * 4 + 3) * 128 + j]);
        bf16_t* AO = (bf16_t*)(p.ws + WS_AO);
        AO[row * DM + head * 128 + j] = (bf16_t)(cvt_pk_bf16(acc / st[t * 2], 0.f) & 0xffffu);
        if (j == 0) ((float*)(p.ws + WS_LSE))[row * 12 + head] = st[t * 2 + 1];
    }
    __syncthreads();
}

__device__ __forceinline__ void conv_item(const Params& p, LAS unsigned char* lds, int item) {
    const int tid = threadIdx.x, ch = tid;
    const float* U = (const float*)(p.ws + WS_U);
    const bool samp = item >= 256;
    const int b = samp ? item - 256 : item >> 7, t0 = samp ? 0 : (item & 127) * 32;
    float wgt[31];
#pragma unroll
    for (int j = 0; j < 31; ++j) wgt[j] = p.conv_w[j * CCH + ch];
    float acc[32];
    const float bias = p.conv_b[ch];
#pragma unroll
    for (int t = 0; t < 32; ++t) acc[t] = bias;
#pragma unroll
    for (int rr = 0; rr < 62; ++rr) {
        float uv = 0.f;
        if (!samp) { const int tok = t0 - 30 + rr; if (tok >= 0) uv = U[((size_t)(b * SEQ + tok)) * CCH + ch]; }
        else { if (rr < 30) uv = p.sconv[((size_t)(b * 30 + rr)) * CCH + ch]; else if (rr < 34) uv = U[((size_t)(MP + b * 4 + rr - 30)) * CCH + ch]; }
#pragma unroll
        for (int t = 0; t < 32; ++t) { const int j = rr - t; if (j >= 0 && j <= 30) acc[t] += wgt[j] * uv; }
    }
    LAS float* ct = (LAS float*)lds;
#pragma unroll
    for (int t = 0; t < 32; ++t) ct[t * CCH + ch] = acc[t];
    __syncthreads();
    {
        const int w = tid >> 6, lane = tid & 63;
        bf16_t* AO = (bf16_t*)(p.ws + WS_AO);
        const int ntok = samp ? 4 : 32;
        for (int tt = 0; tt < 4; ++tt) {
            const int t = 4 * w + tt;
            if (t < ntok) {
                float x[8]; float sm = 0.f;
#pragma unroll
                for (int i = 0; i < 8; ++i) { x[i] = ct[t * CCH + lane + 64 * i]; sm += x[i]; }
                const float mean = wave_sum(sm) * (1.0f / CCH); float s2 = 0.f;
#pragma unroll
                for (int i = 0; i < 8; ++i) { x[i] -= mean; s2 += x[i] * x[i]; }
                const float rstd = rsqrtf(wave_sum(s2) * (1.0f / CCH) + LN_EPS);
                const size_t row = samp ? (size_t)MP + b * 4 + t : (size_t)b * SEQ + t0 + t;
#pragma unroll
                for (int i = 0; i < 8; ++i) { const int c = lane + 64 * i; float y = x[i] * rstd * p.cln_g[c] + p.cln_b[c]; y = y * fast_sigmoid(y);
                    AO[row * DM + AW + c] = (bf16_t)(cvt_pk_bf16(y, 0.f) & 0xffffu); }
            }
        }
    }
    __syncthreads();
}

__device__ __forceinline__ void phase_mixers(const Params& p, LAS unsigned char* lds) {
    constexpr int N_AP = 2 * 3 * 4 * 32, N_AS = 8 * 12, N_CV = 256 + 8;
    const int G = gridDim.x;
    for (int it = blockIdx.x; it < N_AP; it += G) attn_prompt_item(p, lds, it);
    if constexpr (MIXPROBE == 1) { for (int it = blockIdx.x; it < N_AP; it += G) attn_prompt_item(p, lds, it); }
    for (int it = (blockIdx.x + N_AS) % G; it < N_AS; it += G) attn_sample_item(p, lds, it);
    if constexpr (MIXPROBE == 2) { for (int it = (blockIdx.x + N_AS) % G; it < N_AS; it += G) attn_sample_item(p, lds, it); }
    for (int it = blockIdx.x; it < N_CV; it += G) conv_item(p, lds, it);
    if constexpr (MIXPROBE == 3) { for (int it = blockIdx.x; it < N_CV; it += G) conv_item(p, lds, it); }
}

__device__ __forceinline__ void phase_alpha(const Params& p) {
    bf16_t* AO = (bf16_t*)(p.ws + WS_AO); const float* LSE = (const float*)(p.ws + WS_LSE);
    for (size_t i = (size_t)blockIdx.x * 512 + threadIdx.x; i < (size_t)MT * 12 * 16; i += (size_t)gridDim.x * 512) {
        const int c = (int)(i & 15), s = (int)((i >> 4) % 12); const size_t row = i / 192;
        const int g = s >> 2, hs = s & 3;
        const float l0 = LSE[row * 12 + hs], l1 = LSE[row * 12 + 4 + hs], l2 = LSE[row * 12 + 8 + hs];
        const float mx = fmaxf(l0, fmaxf(l1, l2));
        const float e0 = __builtin_amdgcn_exp2f(l0 - mx), e1 = __builtin_amdgcn_exp2f(l1 - mx), e2 = __builtin_amdgcn_exp2f(l2 - mx);
        const float al = (g == 0 ? e0 : (g == 1 ? e1 : e2)) / (e0 + e1 + e2);
        u32x4* ptr = (u32x4*)(AO + row * DM + s * 128 + c * 8);
        u32x4 v = *ptr;
#pragma unroll
        for (int k = 0; k < 4; ++k) { const float lo = __uint_as_float(v[k] << 16) * al, hi = __uint_as_float(v[k] & 0xffff0000u) * al; v[k] = cvt_pk_bf16(lo, hi); }
        *ptr = v;
    }
}

__device__ __forceinline__ void phase_ln(const float* src, float* dstf, bf16_t* dstb, const float* gam, const float* bet) {
    const int lane = threadIdx.x & 63, gw = blockIdx.x * 8 + (threadIdx.x >> 6), NW = gridDim.x * 8;
    f32x4 gv[8], bv[8];
#pragma unroll
    for (int j = 0; j < 8; ++j) { gv[j] = *(const f32x4*)(gam + 4 * lane + 256 * j); bv[j] = *(const f32x4*)(bet + 4 * lane + 256 * j); }
    for (int r = gw; r < MT; r += NW) {
        const float* xr = src + (size_t)r * DM + 4 * lane;
        f32x4 v[8]; float sm = 0.f;
#pragma unroll
        for (int j = 0; j < 8; ++j) { v[j] = *(const f32x4*)(xr + 256 * j); sm += (v[j][0] + v[j][1]) + (v[j][2] + v[j][3]); }
        const float mean = wave_sum(sm) * (1.0f / DM); float s2 = 0.f;
#pragma unroll
        for (int j = 0; j < 8; ++j) { v[j] = v[j] - mean; s2 += (v[j][0] * v[j][0] + v[j][1] * v[j][1]) + (v[j][2] * v[j][2] + v[j][3] * v[j][3]); }
        const float rstd = rsqrtf(wave_sum(s2) * (1.0f / DM) + LN_EPS);
#pragma unroll
        for (int j = 0; j < 8; ++j) {
            const f32x4 y = v[j] * rstd * gv[j] + bv[j];
            if (dstf) *(f32x4*)(dstf + (size_t)r * DM + 4 * lane + 256 * j) = y;
            if (dstb) *(u32x2*)(dstb + (size_t)r * DM + 4 * lane + 256 * j) = pack4(y);
        }
    }
}

__device__ __forceinline__ void phase_ln_bf16(bf16_t* X, const float* gam, const float* bet) {
    const int lane = threadIdx.x & 63, gw = blockIdx.x * 8 + (threadIdx.x >> 6), NW = gridDim.x * 8;
    for (int r = gw; r < MT; r += NW) {
        bf16_t* xr = X + (size_t)r * DM + 8 * lane;
        float v[32]; float sm = 0.f;
#pragma unroll
        for (int j = 0; j < 4; ++j) { const u32x4 q = *(const u32x4*)(xr + 512 * j);
#pragma unroll
            for (int k = 0; k < 4; ++k) { v[8 * j + 2 * k] = __uint_as_float(q[k] << 16); v[8 * j + 2 * k + 1] = __uint_as_float(q[k] & 0xffff0000u); sm += v[8 * j + 2 * k] + v[8 * j + 2 * k + 1]; } }
        const float mean = wave_sum(sm) * (1.0f / DM); float s2 = 0.f;
#pragma unroll
        for (int i = 0; i < 32; ++i) { v[i] -= mean; s2 += v[i] * v[i]; }
        const float rstd = rsqrtf(wave_sum(s2) * (1.0f / DM) + LN_EPS);
#pragma unroll
        for (int j = 0; j < 4; ++j) {
            const f32x4 g0 = *(const f32x4*)(gam + 8 * lane + 512 * j), g1 = *(const f32x4*)(gam + 8 * lane + 512 * j + 4), b0 = *(const f32x4*)(bet + 8 * lane + 512 * j), b1 = *(const f32x4*)(bet + 8 * lane + 512 * j + 4);
            f32x4 y0, y1;
#pragma unroll
            for (int k = 0; k < 4; ++k) { y0[k] = v[8 * j + k] * rstd * g0[k] + b0[k]; y1[k] = v[8 * j + 4 + k] * rstd * g1[k] + b1[k]; }
            *(u32x4*)(xr + 512 * j) = pack8(y0, y1);
        }
    }
}

constexpr int REP0 = 1, REP2 = 1, REPG = 1, PROBE_NULLGU = 0, REPMASK = 0, NSYNC_PROBE = 0;
template <int MASK>
__global__ void __launch_bounds__(512, 2) fwd_kernel(Params p) {
    extern __shared__ __attribute__((aligned(16))) unsigned char shm[];
    LAS unsigned char* lds = (LAS unsigned char*)shm;
    unsigned char* ws = p.ws;
    __shared__ uint4 xb_words;
    if (threadIdx.x == 0) xb_words = make_uint4(0u, 0u, 0u, 0u);
    __syncthreads();
    const XcdBarrier xb = xcd_barrier_post((unsigned*)(ws + WS_BAR), (volatile LAS unsigned*)&xb_words);
    if (p.out == nullptr) cg::this_grid().sync();
#define GSYNC() xcd_barrier(xb)
#define PH(k) if constexpr ((MASK >> (k)) & 1)
#define SYNC(k) if constexpr (((MASK >> (k)) & 1) && (MASK & ((1 << (k)) - 1))) GSYNC();
    PH(0) for (int rep = 0; rep < REP0; ++rep) { phase_convert(p, lds); if (rep + 1 < REP0) GSYNC(); }
    SYNC(1)
    PH(1) { Gemm g{(const bf16_t*)(ws + WS_XB), (const bf16_t*)(ws + WS_WIN), MPAD, NIN, DM}; StaticOrder S; S.init(MPAD, NIN, gridDim.x, blockIdx.x);
            EpiIn E{(bf16_t*)(ws + WS_Q), (bf16_t*)(ws + WS_K), (bf16_t*)(ws + WS_V), (float*)(ws + WS_U), (const float*)(ws + WS_ROPE), p.out};
            gemm_phase(lds, g, S, E); if constexpr ((REPMASK >> 1) & 1) { GSYNC(); gemm_phase(lds, g, S, E); }
            { const int ntile = (MPAD / 256) * (NIN / 256), G = gridDim.x, full = ntile % G;
              if (full != 0 && (int)blockIdx.x >= full) { const int gw = ((int)blockIdx.x - full) * 8 + (threadIdx.x >> 6), NW = (G - full) * 8;
                  cvt_range(p, U_IN, U_IN + U_OUT, gw, NW); cvt_range(p, U_IN + U_OUT + U_GU, U_IN + U_OUT + U_GU + U_D, gw, NW); }
              else if (full == 0) { const int gw = blockIdx.x * 8 + (threadIdx.x >> 6), NW = G * 8; cvt_range(p, U_IN, U_IN + U_OUT, gw, NW); cvt_range(p, U_IN + U_OUT + U_GU, U_IN + U_OUT + U_GU + U_D, gw, NW); } } }
    SYNC(2)
    PH(2) { phase_mixers(p, lds); if constexpr (REP2 == 2) { GSYNC(); phase_mixers(p, lds); } }
    SYNC(3)
    PH(3) phase_alpha(p);
    SYNC(4)
    PH(4) { skinny_gemm<8, true>(lds, (const bf16_t*)(ws + WS_AO) + (size_t)MP * DM, (const bf16_t*)(ws + WS_WOUT), (const bf16_t*)(ws + WS_XB) + (size_t)MP * DM, (bf16_t*)(ws + WS_Z1) + (size_t)MP * DM);
            Gemm g{(const bf16_t*)(ws + WS_AO), (const bf16_t*)(ws + WS_WOUT), MP, DM, DM}; StaticOrder S; S.init(MP, DM, gridDim.x, blockIdx.x);
            EpiOut E{(const bf16_t*)(ws + WS_XB), (bf16_t*)(ws + WS_Z1)}; gemm_phase(lds, g, S, E); if constexpr ((REPMASK >> 4) & 1) { GSYNC(); gemm_phase(lds, g, S, E); } }
    SYNC(5)
    PH(5) phase_ln_bf16((bf16_t*)(ws + WS_Z1), p.ln1_g, p.ln1_b);
    SYNC(6)
    PH(6) { Gemm g{(const bf16_t*)(ws + WS_Z1), (const bf16_t*)(ws + WS_WGU), MPAD, 2 * FH, DM}; StaticOrder S; S.init(MPAD, 2 * FH, gridDim.x, blockIdx.x);
            if constexpr (PROBE_NULLGU) { EpiNull EN{(float*)(ws + WS_LSE)}; gemm_phase(lds, g, S, EN); GSYNC(); }
            EpiGU E{(bf16_t*)(ws + WS_H)}; gemm_phase(lds, g, S, E); if constexpr ((REPMASK >> 6) & 1) { GSYNC(); gemm_phase(lds, g, S, E); }
            { const int ntile = (MPAD / 256) * (2 * FH / 256), G = gridDim.x, full = ntile % G;
              if (full != 0 && (int)blockIdx.x >= full) copy_caches(p, (size_t)((int)blockIdx.x - full) * 512 + threadIdx.x, (size_t)(G - full) * 512);
              else if (full == 0) copy_caches(p, (size_t)blockIdx.x * 512 + threadIdx.x, (size_t)G * 512); } }
    SYNC(7)
    PH(7) { skinny_gemm<22, false>(lds, (const bf16_t*)(ws + WS_H) + (size_t)MP * FH, (const bf16_t*)(ws + WS_WD), (const bf16_t*)(ws + WS_Z1) + (size_t)MP * DM, p.out + (size_t)MP * DM);
            Gemm g{(const bf16_t*)(ws + WS_H), (const bf16_t*)(ws + WS_WD), MP, DM, FH}; StaticOrder S; S.init(MP, DM, gridDim.x, blockIdx.x);
            EpiDown E{(const bf16_t*)(ws + WS_Z1), p.out}; gemm_phase(lds, g, S, E); if constexpr ((REPMASK >> 7) & 1) { GSYNC(); gemm_phase(lds, g, S, E); } }
    SYNC(8)
    PH(8) phase_ln(p.out, p.out, nullptr, p.ln2_g, p.ln2_b);
    if constexpr (NSYNC_PROBE > 0) { for (int i = 0; i < NSYNC_PROBE; ++i) GSYNC(); }
#undef PH
#undef SYNC
}

#ifndef N_LAUNCH_MODE
#define N_LAUNCH_MODE 1
#endif
template <int MASK> static void launch_plain(const Params& p, int grid, hipStream_t stream) {
    static bool attr = false;
    if (!attr) { (void)hipFuncSetAttribute((const void*)fwd_kernel<MASK>, hipFuncAttributeMaxDynamicSharedMemorySize, STAGE_BYTES); attr = true; }
    hipLaunchKernelGGL(fwd_kernel<MASK>, dim3(grid), dim3(512), STAGE_BYTES, stream, p);
}
extern "C" void kernel_launch(void* const* d_in, const int* in_sizes, int n_in, void* d_out, int out_size, void* d_ws, size_t ws_size, hipStream_t stream) {
    static int grid = 0;
    if (grid == 0) {
        if (n_in != 19 || (size_t)out_size != O_END || ws_size < WS_END) { fprintf(stderr, "kernel_launch: unexpected shapes: n_in %d out %d ws %zu (need %zu)\n", n_in, out_size, ws_size, (size_t)WS_END); grid = -1; return; }
        int dev = 0, cus = 0, per_cu = 0;
        (void)hipGetDevice(&dev); (void)hipDeviceGetAttribute(&cus, hipDeviceAttributeMultiprocessorCount, dev);
#if N_LAUNCH_MODE == 1
        if (hipFuncSetAttribute((const void*)fwd_kernel<0x1FF>, hipFuncAttributeMaxDynamicSharedMemorySize, STAGE_BYTES) != hipSuccess) { fprintf(stderr, "kernel_launch: hipFuncSetAttribute failed\n"); grid = -1; return; }
        if (hipOccupancyMaxActiveBlocksPerMultiprocessor(&per_cu, (const void*)fwd_kernel<0x1FF>, 512, STAGE_BYTES) != hipSuccess || per_cu < 1) { fprintf(stderr, "kernel_launch: occupancy query failed (%d)\n", per_cu); (void)hipGetLastError(); }
#endif
        grid = cus;
        fprintf(stderr, "kernel_launch: grid %d (per_cu %d)\n", grid, per_cu);
    }
    if (grid < 0) return;
    Params p{};
    p.xp = (const float*)d_in[0]; p.xs = (const float*)d_in[1]; p.c0 = (const float*)d_in[2]; p.c1 = (const float*)d_in[3]; p.c2 = (const float*)d_in[4]; p.sconv = (const float*)d_in[5];
    p.w_in = (const float*)d_in[6]; p.w_out = (const float*)d_in[7]; p.conv_w = (const float*)d_in[8]; p.conv_b = (const float*)d_in[9]; p.cln_g = (const float*)d_in[10]; p.cln_b = (const float*)d_in[11];
    p.ln1_g = (const float*)d_in[12]; p.ln1_b = (const float*)d_in[13]; p.w_gate = (const float*)d_in[14]; p.w_up = (const float*)d_in[15]; p.w_down = (const float*)d_in[16]; p.ln2_g = (const float*)d_in[17]; p.ln2_b = (const float*)d_in[18];
    p.out = (float*)d_out; p.ws = (unsigned char*)d_ws;
#if N_LAUNCH_MODE == 1
    if (hipMemsetAsync((unsigned char*)d_ws + WS_BAR, 0, 16384, stream) != hipSuccess) { fprintf(stderr, "kernel_launch: memset of the barrier words failed\n"); return; }
    void* args[] = {&p};
    hipError_t e = hipLaunchCooperativeKernel((const void*)fwd_kernel<0x1FF>, dim3(grid), dim3(512), args, STAGE_BYTES, stream);
    if (e != hipSuccess) fprintf(stderr, "cooperative launch failed: %s (grid %d)\n", hipGetErrorString(e), grid);
#else
    launch_plain<1>(p, grid, stream); launch_plain<2>(p, grid, stream); launch_plain<4>(p, grid, stream); launch_plain<8>(p, grid, stream); launch_plain<16>(p, grid, stream);
    launch_plain<32>(p, grid, stream); launch_plain<64>(p, grid, stream); launch_plain<128>(p, grid, stream); launch_plain<256>(p, grid, stream);
#endif
}
```

```cpp
#include <hip/hip_runtime.h>
#include <hip/hip_cooperative_groups.h>
#include <cstdio>
namespace cg = cooperative_groups;

#define LAS __attribute__((address_space(3)))
typedef unsigned short bf16_t;
typedef short bf16x8 __attribute__((ext_vector_type(8)));
typedef short bf16x4 __attribute__((ext_vector_type(4)));
typedef float f32x4 __attribute__((ext_vector_type(4)));
typedef unsigned u32x4 __attribute__((ext_vector_type(4)));
typedef unsigned u32x2 __attribute__((ext_vector_type(2)));

constexpr int DM = 2048, SEQ = 4096, MP = 8192, MS = 32, MT = MP + MS, MPAD = 8448;
constexpr int AW = 1536, CCH = 512, NIN = 5632, FH = 5632;
constexpr float ALPHA = 1.189207115002721f;
constexpr float LN_EPS = 1e-5f;
constexpr float QSCALE = 0.08838834764831845f * 1.4426950408889634f;

constexpr size_t O_KVP0 = (size_t)MT * DM;
constexpr size_t O_KVP1 = O_KVP0 + 2 * 128 * 1024;
constexpr size_t O_KVP2 = O_KVP1 + 2 * 512 * 1024;
constexpr size_t O_CONVP = O_KVP2 + 2 * 2048 * 1024;
constexpr size_t O_KVS0 = O_CONVP + 2 * 30 * 512;
constexpr size_t O_KVS1 = O_KVS0 + 8 * 128 * 1024;
constexpr size_t O_KVS2 = O_KVS1 + 8 * 512 * 1024;
constexpr size_t O_CONVS = O_KVS2 + (size_t)8 * 2048 * 1024;
constexpr size_t O_END = O_CONVS + 8 * 30 * 512;

constexpr size_t WS_WIN = 0;
constexpr size_t WS_WOUT = WS_WIN + (size_t)NIN * DM * 2;
constexpr size_t WS_WGU = WS_WOUT + (size_t)DM * DM * 2;
constexpr size_t WS_WD = WS_WGU + (size_t)2 * FH * DM * 2;
constexpr size_t WS_ROPE = WS_WD + (size_t)DM * FH * 2;
constexpr size_t WS_LSE = WS_ROPE + (size_t)4100 * 64 * 8;
constexpr size_t WS_R1 = WS_LSE + (size_t)MPAD * 12 * 4;
constexpr size_t WS_XB = WS_R1;
constexpr size_t WS_Q = WS_XB + (size_t)MPAD * DM * 2;
constexpr size_t WS_K = WS_Q + (size_t)MPAD * AW * 2;
constexpr size_t WS_V = WS_K + (size_t)MPAD * AW * 2;
constexpr size_t WS_U = WS_V + (size_t)MPAD * AW * 2;
constexpr size_t WS_R1END = WS_U + (size_t)MPAD * CCH * 4;
constexpr size_t WS_H = WS_R1;
constexpr size_t WS_AO = WS_R1END;
constexpr size_t WS_Z1 = WS_AO + (size_t)MPAD * DM * 2;
constexpr size_t WS_BAR = WS_Z1 + (size_t)MPAD * DM * 4;
constexpr size_t WS_END = WS_BAR + 16384;
static_assert((size_t)MPAD * FH * 2 <= WS_R1END - WS_R1, "H alias");

struct Params {
    const float *xp, *xs, *c0, *c1, *c2, *sconv, *w_in, *w_out, *conv_w, *conv_b, *cln_g, *cln_b, *ln1_g, *ln1_b, *w_gate, *w_up, *w_down, *ln2_g, *ln2_b;
    float* out; unsigned char* ws;
};

__device__ __forceinline__ unsigned cvt_pk_bf16(float lo, float hi) { unsigned r; asm volatile("v_cvt_pk_bf16_f32 %0, %1, %2" : "=v"(r) : "v"(lo), "v"(hi)); return r; }
__device__ __forceinline__ float bf2f(unsigned short b) { return __uint_as_float(((unsigned)b) << 16); }
__device__ __forceinline__ u32x2 pack4(f32x4 v) { u32x2 r; r.x = cvt_pk_bf16(v[0], v[1]); r.y = cvt_pk_bf16(v[2], v[3]); return r; }
__device__ __forceinline__ u32x4 pack8(f32x4 a, f32x4 b) { u32x4 r; r.x = cvt_pk_bf16(a[0], a[1]); r.y = cvt_pk_bf16(a[2], a[3]); r.z = cvt_pk_bf16(b[0], b[1]); r.w = cvt_pk_bf16(b[2], b[3]); return r; }
__device__ __forceinline__ float wave_sum(float v) {
#pragma unroll
    for (int o = 1; o < 64; o <<= 1) v += __shfl_xor(v, o);
    return v;
}
__device__ __forceinline__ float wave_max(float v) {
#pragma unroll
    for (int o = 1; o < 64; o <<= 1) v = fmaxf(v, __shfl_xor(v, o));
    return v;
}
__device__ __forceinline__ int perm8(int s) { return 8 * ((s >> 2) & 3) + 4 * ((s >> 4) & 1) + (s & 3); }
__device__ __forceinline__ float fast_sigmoid(float g) { return 1.0f / (1.0f + __expf(-g)); }

#define XB_TMO      128
#define XB_XCNT(j)  (256  + 64 * (j))
#define XB_XSUB(j)  (1280 + 64 * (j))
#define XB_XGEN(j)  (2304 + 64 * (j))
#define XB_TOP      3328
#define XB_TOPGEN   3392
#define XCD_BAR_WORDS 3456
#define XB_SPIN_CAP (1u << 18)
__device__ __forceinline__ unsigned xb_ld(unsigned* p)              { return __hip_atomic_load(p, __ATOMIC_RELAXED, __HIP_MEMORY_SCOPE_AGENT); }
__device__ __forceinline__ unsigned xb_add(unsigned* p, unsigned v) { return __hip_atomic_fetch_add(p, v, __ATOMIC_RELAXED, __HIP_MEMORY_SCOPE_AGENT); }
__device__ __forceinline__ unsigned xb_xcc_id() { return (unsigned)__builtin_amdgcn_s_getreg((3 << 11) | 20) & 0xFu; }
#define XB_SPIN(cond, bar) do { unsigned _sp = 0; while (cond) { __builtin_amdgcn_s_sleep(1); \
    if ((++_sp & 255u) == 0u) { if (xb_ld(&(bar)[XB_TMO])) break; if (_sp > XB_SPIN_CAP) { atomicAdd(&(bar)[XB_TMO], 1u); break; } } } } while (0)
struct XcdBarrier { unsigned* bar; unsigned x; volatile LAS unsigned* st; };
__device__ __forceinline__ XcdBarrier xcd_barrier_post(unsigned* bar, volatile LAS unsigned* st) {
    XcdBarrier b; b.bar = bar; b.x = xb_xcc_id(); b.st = st;
    if (threadIdx.x == 0) (void)xb_add(&bar[XB_XCNT(b.x)], 1u);
    return b;
}
__device__ __forceinline__ void xcd_barrier_complete(unsigned* bar, unsigned x, unsigned& nloc, unsigned& nx) {
    const unsigned G = gridDim.x * gridDim.y * gridDim.z;
    unsigned sum, cnt, mine, sp = 0u;
    for (;;) {
        sum = 0u; cnt = 0u; mine = 0u;
#pragma unroll
        for (unsigned j = 0; j < 16; ++j) { const unsigned c = xb_ld(&bar[XB_XCNT(j)]); sum += c; cnt += (c > 0u) ? 1u : 0u; mine = (j == x) ? c : mine; }
        if (sum == G) break;
        __builtin_amdgcn_s_sleep(1);
        if ((++sp & 255u) == 0u) { if (xb_ld(&bar[XB_TMO])) break; if (sp > XB_SPIN_CAP) { atomicAdd(&bar[XB_TMO], 1u); break; } }
    }
    nloc = mine > 0u ? mine : 1u; nx = cnt > 0u ? cnt : 1u;
}
__device__ __forceinline__ void xcd_barrier(const XcdBarrier& b) {
    asm volatile("s_waitcnt vmcnt(0)" ::: "memory");
    __syncthreads();
    if (threadIdx.x == 0) {
        unsigned* bar = b.bar;
        __builtin_amdgcn_s_waitcnt(0);
        unsigned nloc = b.st[0], nx = b.st[1];
        if (nloc == 0u) { xcd_barrier_complete(bar, b.x, nloc, nx); b.st[0] = nloc; b.st[1] = nx; }
        const unsigned old = xb_add(&bar[XB_XSUB(b.x)], 1u);
        const unsigned gen = old / nloc;
        if (old + 1u == (gen + 1u) * nloc) {
            __builtin_amdgcn_fence(__ATOMIC_RELEASE, "agent");
            asm volatile("s_waitcnt vmcnt(0)" ::: "memory");
            const unsigned og = xb_add(&bar[XB_TOP], 1u);
            const unsigned tg = og / nx;
            if (og + 1u == (tg + 1u) * nx) xb_add(&bar[XB_TOPGEN], 1u);
            else XB_SPIN(xb_ld(&bar[XB_TOPGEN]) == tg, bar);
            __builtin_amdgcn_fence(__ATOMIC_ACQUIRE, "agent");
            xb_add(&bar[XB_XGEN(b.x)], 1u);
            asm volatile("s_waitcnt vmcnt(0)" ::: "memory");
        } else {
            XB_SPIN(xb_ld(&bar[XB_XGEN(b.x)]) == gen, bar);
            __builtin_amdgcn_fence(__ATOMIC_ACQUIRE, "agent");
            asm volatile("s_waitcnt vmcnt(0)" ::: "memory");
        }
    }
    __syncthreads();
}

constexpr int BM = 256, BK = 64, HALF = 128, HTB = HALF * BK * 2, STAGE_BYTES = 8 * HTB, NXCD = 8, WGM = 8;
__device__ __forceinline__ int lds_byte(int r, int c) { const int st = (r >> 4) * 2 + (c >> 5), rr = r & 15, cc = c & 31, ob = rr * 64 + cc * 2; return st * 1024 + (ob ^ (((ob >> 9) & 1) << 5)); }
__device__ __forceinline__ void stage_rc(int b, int& R, int& C) { const int st = b / 1024, sb = b % 1024, swz = sb ^ (((sb >> 9) & 1) << 5); R = (st >> 1) * 16 + swz / 64; C = (st & 1) * 32 + (swz % 64) / 2; }
struct Unit { int pm, pn; };
struct Gemm { const bf16_t* A; const bf16_t* Bt; int M, N, K; };
struct StaticOrder {
    int nM, nN, nwg, G, c;
    __device__ void init(int M, int N, int G_, int c_) { nM = M / BM; nN = N / BM; nwg = nM * nN; G = G_; c = c_; }
    __device__ bool next(int i, Unit& u) const {
        const long L = (long)i * G + c; if (L >= nwg) return false;
        int wgid = (int)L; { const int q = nwg / NXCD, r = nwg % NXCD, xcd = wgid % NXCD, off = wgid / NXCD; wgid = (xcd < r ? xcd * (q + 1) : r * (q + 1) + (xcd - r) * q) + off; }
        const int nig = WGM * nN, gid = wgid / nig, fm = gid * WGM, gsz = (nM - fm) < WGM ? (nM - fm) : WGM;
        u.pm = fm + ((wgid % nig) % gsz); u.pn = (wgid % nig) / gsz; return true;
    }
};

template <class Epi>
__device__ __forceinline__ void gemm_phase(LAS unsigned char* lds, const Gemm g, const StaticOrder& S, const Epi& E) {
    const int tid = threadIdx.x, wid = __builtin_amdgcn_readfirstlane(tid >> 6), lane = tid & 63, wr = wid >> 2, wc = wid & 3, fr = lane & 15, fq = lane >> 4;
    const int K = g.K, nt = K / BK;
    unsigned voffA[2];
#pragma unroll
    for (int i = 0; i < 2; ++i) { int R, C; stage_rc(tid * 16 + i * 8192, R, C); voffA[i] = (unsigned)(R * K + C) * 2u; }
    const size_t kstep = (size_t)(BK * 2);
    const size_t hstep = (size_t)HALF * K * 2;
    const size_t tstep = 2 * hstep;
    const unsigned ldsw = (unsigned)wid * 1024u;
    const int aoff = lds_byte(wr * 64 + fr, fq * 8), boff = lds_byte(wc * 32 + fr, fq * 8);
#define PG8_SA(b, h) (((b) * 2 + (h)) * HTB)
#define PG8_SB(b, h) ((4 + (b) * 2 + (h)) * HTB)
#define PG8_STAGE(bufoff, gbase, voff) do { _Pragma("unroll") for (int _i = 0; _i < 2; ++_i) \
        __builtin_amdgcn_global_load_lds((const unsigned*)((const char*)(gbase) + (voff)[_i]), (LAS unsigned*)(lds + (bufoff) + ldsw + _i * 8192), 16, 0, 0); } while (0)
#define PG8_LDA(dst, b, h) do { _Pragma("unroll") for (int m = 0; m < 4; ++m) _Pragma("unroll") for (int k = 0; k < 2; ++k) dst[m][k] = *(const LAS bf16x8*)(lds + PG8_SA(b, h) + aoff + m * 2048 + k * 1024); } while (0)
#define PG8_LDB(dst, b, h) do { _Pragma("unroll") for (int n = 0; n < 2; ++n) _Pragma("unroll") for (int k = 0; k < 2; ++k) dst[n][k] = *(const LAS bf16x8*)(lds + PG8_SB(b, h) + boff + n * 2048 + k * 1024); } while (0)
#define PG8_MMA(ai, bj, At, Bt) do { __builtin_amdgcn_s_setprio(1); _Pragma("unroll") for (int m = 0; m < 4; ++m) _Pragma("unroll") for (int n = 0; n < 2; ++n) _Pragma("unroll") for (int k = 0; k < 2; ++k) \
        acc[ai][bj][m][n] = __builtin_amdgcn_mfma_f32_16x16x32_bf16(Bt[n][k], At[m][k], acc[ai][bj][m][n], 0, 0, 0); __builtin_amdgcn_s_setprio(0); } while (0)
#define PG8_WAIT_V(n) asm volatile("s_waitcnt vmcnt(" #n ")" ::: "memory")
#define PG8_WAIT_L(n) asm volatile("s_waitcnt lgkmcnt(" #n ")" ::: "memory")
#define PG8_BAR __builtin_amdgcn_s_barrier()
#define PG8_SCHED __builtin_amdgcn_sched_barrier(0)
    Unit cur, nxt; int ui = 0;
    if (!S.next(0, cur)) return;
    f32x4 acc[2][2][4][2];
#pragma unroll
    for (int a = 0; a < 2; ++a)
#pragma unroll
        for (int b = 0; b < 2; ++b)
#pragma unroll
            for (int m = 0; m < 4; ++m)
#pragma unroll
                for (int n = 0; n < 2; ++n) acc[a][b][m][n] = (f32x4){0.f, 0.f, 0.f, 0.f};
    bf16x8 At[4][2], B0[2][2], B1[2][2];
    const char* cA = (const char*)g.A + (size_t)cur.pm * tstep; const char* cB = (const char*)g.Bt + (size_t)cur.pn * tstep;
    PG8_STAGE(PG8_SB(0, 0), cB, voffA); PG8_STAGE(PG8_SA(0, 0), cA, voffA); PG8_STAGE(PG8_SB(0, 1), cB + hstep, voffA); PG8_STAGE(PG8_SA(0, 1), cA + hstep, voffA);
    if (wr == 1) PG8_BAR;
    PG8_WAIT_V(4); PG8_BAR;
    PG8_STAGE(PG8_SB(1, 0), cB + kstep, voffA); PG8_STAGE(PG8_SA(1, 0), cA + kstep, voffA); PG8_STAGE(PG8_SB(1, 1), cB + hstep + kstep, voffA);
    PG8_WAIT_V(6); PG8_BAR;
    for (;;) {
        const bool has_next = S.next(ui + 1, nxt);
        const char* nA = has_next ? (const char*)g.A + (size_t)nxt.pm * tstep : cA; const char* nB = has_next ? (const char*)g.Bt + (size_t)nxt.pn * tstep : cB;
        for (int t = 0; t < nt; t += 2) {
            const bool last = (t == nt - 2);
            const char* a1 = cA + (size_t)(t + 1) * kstep;
            const char* a2 = last ? nA : cA + (size_t)(t + 2) * kstep; const char* b2 = last ? nB : cB + (size_t)(t + 2) * kstep;
            const char* a3 = a2 + kstep; const char* b3 = b2 + kstep;
            PG8_LDB(B0, 0, 0); PG8_SCHED; PG8_LDA(At, 0, 0); PG8_STAGE(PG8_SA(1, 1), a1 + hstep, voffA);
            PG8_WAIT_L(8); PG8_BAR; PG8_WAIT_L(0); PG8_MMA(0, 0, At, B0); PG8_BAR; PG8_SCHED;
            PG8_LDB(B1, 0, 1); PG8_STAGE(PG8_SB(0, 0), b2, voffA);
            PG8_BAR; PG8_WAIT_L(0); PG8_MMA(0, 1, At, B1); PG8_BAR;
            PG8_LDA(At, 0, 1); PG8_STAGE(PG8_SA(0, 0), a2, voffA);
            PG8_BAR; PG8_WAIT_L(0); PG8_MMA(1, 0, At, B0); PG8_BAR; PG8_SCHED;
            PG8_STAGE(PG8_SB(0, 1), b2 + hstep, voffA);
            PG8_WAIT_V(6); PG8_BAR; PG8_MMA(1, 1, At, B1); PG8_BAR;
            PG8_LDB(B0, 1, 0); PG8_SCHED; PG8_LDA(At, 1, 0); PG8_STAGE(PG8_SA(0, 1), a2 + hstep, voffA);
            PG8_WAIT_L(8); PG8_BAR; PG8_WAIT_L(0); PG8_MMA(0, 0, At, B0); PG8_BAR; PG8_SCHED;
            PG8_LDB(B1, 1, 1); PG8_STAGE(PG8_SB(1, 0), b3, voffA);
            PG8_BAR; PG8_WAIT_L(0); PG8_MMA(0, 1, At, B1); PG8_BAR;
            PG8_LDA(At, 1, 1); PG8_STAGE(PG8_SA(1, 0), a3, voffA);
            PG8_BAR; PG8_WAIT_L(0); PG8_MMA(1, 0, At, B0); PG8_BAR; PG8_SCHED;
            PG8_STAGE(PG8_SB(1, 1), b3 + hstep, voffA);
            PG8_WAIT_V(6); PG8_BAR; PG8_MMA(1, 1, At, B1); PG8_BAR;
        }
        E(acc, cur, wr, wc, fr, fq);
        if (!has_next) break;
#pragma unroll
        for (int a = 0; a < 2; ++a)
#pragma unroll
            for (int b = 0; b < 2; ++b)
#pragma unroll
                for (int m = 0; m < 4; ++m)
#pragma unroll
                    for (int n = 0; n < 2; ++n) acc[a][b][m][n] = (f32x4){0.f, 0.f, 0.f, 0.f};
        cur = nxt; cA = nA; cB = nB; ++ui;
    }
    PG8_WAIT_V(0);
    if (wr == 0) PG8_BAR;
    PG8_BAR;
#undef PG8_SA
#undef PG8_SB
#undef PG8_STAGE
#undef PG8_LDA
#undef PG8_LDB
#undef PG8_MMA
#undef PG8_WAIT_V
#undef PG8_WAIT_L
#undef PG8_BAR
#undef PG8_SCHED
}

__device__ __forceinline__ float* kv_out_ptr(float* out, int r, int gi, bool& ok) {
    const int keep = 128 << (2 * gi);
    ok = false;
    if (r < MP) {
        const int b = r >> 12, t = r & 4095;
        if (t < SEQ - keep) return out;
        ok = true;
        const size_t base = gi == 0 ? O_KVP0 : (gi == 1 ? O_KVP1 : O_KVP2);
        return out + base + ((size_t)(b * keep + t - (SEQ - keep))) * 1024;
    }
    if (r < MT) {
        const int b = (r - MP) >> 2, t = (r - MP) & 3;
        ok = true;
        const size_t base = gi == 0 ? O_KVS0 : (gi == 1 ? O_KVS1 : O_KVS2);
        return out + base + ((size_t)(b * keep + keep - 4 + t)) * 1024;
    }
    return out;
}

struct EpiIn {
    bf16_t *Qb, *Kb, *Vb; float* U; const float* rope; float* out;
    __device__ __forceinline__ void operator()(const f32x4 (&acc)[2][2][4][2], const Unit& u, int wr, int wc, int fr, int fq) const {
        const int pn = u.pn;
#pragma unroll
        for (int ai = 0; ai < 2; ++ai)
#pragma unroll
            for (int m = 0; m < 4; ++m) {
                const int r = u.pm * 256 + ai * 128 + wr * 64 + m * 16 + fr;
                if (pn < 12) {
                    const int pidx = r < MP ? (r & 4095) : (r < MT ? 4096 + ((r - MP) & 3) : 0);
                    const f32x4* rp = (const f32x4*)(rope + ((size_t)pidx * 64 + 16 * wc + 4 * fq) * 2);
                    const f32x4 cs0 = rp[0], cs1 = rp[1];
                    const f32x4 c = {cs0[0], cs0[2], cs1[0], cs1[2]}, s = {cs0[1], cs0[3], cs1[1], cs1[3]};
                    const int col = 16 * wc + 4 * fq;
#pragma unroll
                    for (int bj = 0; bj < 2; ++bj) {
                        const f32x4 x1 = acc[ai][bj][m][0], x2 = acc[ai][bj][m][1];
                        f32x4 o1 = x1 * c - x2 * s, o2 = x2 * c + x1 * s;
                        const int hq = 2 * pn + bj;
                        if (pn < 6) {
                            o1 = o1 * QSCALE; o2 = o2 * QSCALE;
                            bf16_t* dst = Qb + (size_t)r * AW + hq * 128 + col;
                            *(u32x2*)dst = pack4(o1); *(u32x2*)(dst + 64) = pack4(o2);
                        } else {
                            const int hk = hq - 12;
                            bf16_t* dst = Kb + (size_t)r * AW + hk * 128 + col;
                            *(u32x2*)dst = pack4(o1); *(u32x2*)(dst + 64) = pack4(o2);
                            bool ok; float* o = kv_out_ptr(out, r, hk >> 2, ok);
                            if (ok) { o += (hk & 3) * 128 + col; *(f32x4*)o = o1; *(f32x4*)(o + 64) = o2; }
                        }
                    }
                } else if (pn < 18) {
                    const int col = 32 * wc + 8 * fq;
#pragma unroll
                    for (int bj = 0; bj < 2; ++bj) {
                        const int hv = 2 * (pn - 12) + bj;
                        const f32x4 v0 = acc[ai][bj][m][0], v1 = acc[ai][bj][m][1];
                        *(u32x4*)(Vb + (size_t)r * AW + hv * 128 + col) = pack8(v0, v1);
                        bool ok; float* o = kv_out_ptr(out, r, hv >> 2, ok);
                        if (ok) { o += 512 + (hv & 3) * 128 + col; *(f32x4*)o = v0; *(f32x4*)(o + 4) = v1; }
                    }
                } else {
                    const int ch = 128 * (pn - 18) + 32 * wc + 8 * fq;
                    f32x4 u0, u1;
#pragma unroll
                    for (int e = 0; e < 4; ++e) { u0[e] = acc[ai][0][m][0][e] * fast_sigmoid(acc[ai][1][m][0][e]); u1[e] = acc[ai][0][m][1][e] * fast_sigmoid(acc[ai][1][m][1][e]); }
                    float* up = U + (size_t)r * CCH + ch;
                    *(f32x4*)up = u0; *(f32x4*)(up + 4) = u1;
                    float* o = nullptr;
                    if (r < MP) { const int b = r >> 12, t = r & 4095; if (t >= SEQ - 30) o = out + O_CONVP + ((size_t)(b * 30 + t - (SEQ - 30))) * CCH + ch; }
                    else if (r < MT) { const int b = (r - MP) >> 2, t = (r - MP) & 3; o = out + O_CONVS + ((size_t)(b * 30 + 26 + t)) * CCH + ch; }
                    if (o) { *(f32x4*)o = u0; *(f32x4*)(o + 4) = u1; }
                }
            }
    }
};
struct EpiOut {
    const bf16_t* Xb; bf16_t* Z;
    __device__ __forceinline__ void operator()(const f32x4 (&acc)[2][2][4][2], const Unit& u, int wr, int wc, int fr, int fq) const {
#pragma unroll
        for (int ai = 0; ai < 2; ++ai)
#pragma unroll
            for (int m = 0; m < 4; ++m) {
                const int r = u.pm * 256 + ai * 128 + wr * 64 + m * 16 + fr;
#pragma unroll
                for (int bj = 0; bj < 2; ++bj) {
                    const size_t o = (size_t)r * DM + u.pn * 256 + bj * 128 + wc * 32 + 8 * fq;
                    const u32x4 xv = *(const u32x4*)(Xb + o);
                    f32x4 z0, z1;
#pragma unroll
                    for (int k = 0; k < 2; ++k) { z0[2 * k] = __uint_as_float(xv[k] << 16); z0[2 * k + 1] = __uint_as_float(xv[k] & 0xffff0000u); z1[2 * k] = __uint_as_float(xv[2 + k] << 16); z1[2 * k + 1] = __uint_as_float(xv[2 + k] & 0xffff0000u); }
                    *(u32x4*)(Z + o) = pack8(z0 * ALPHA + acc[ai][bj][m][0], z1 * ALPHA + acc[ai][bj][m][1]);
                }
            }
    }
};
struct EpiGU {
    bf16_t* H;
    __device__ __forceinline__ void operator()(const f32x4 (&acc)[2][2][4][2], const Unit& u, int wr, int wc, int fr, int fq) const {
#pragma unroll
        for (int ai = 0; ai < 2; ++ai)
#pragma unroll
            for (int m = 0; m < 4; ++m) {
                const int r = u.pm * 256 + ai * 128 + wr * 64 + m * 16 + fr;
                const int col = 128 * u.pn + 32 * wc + 8 * fq;
                f32x4 h0, h1;
#pragma unroll
                for (int e = 0; e < 4; ++e) {
                    const float g0 = acc[ai][0][m][0][e], g1 = acc[ai][0][m][1][e];
                    h0[e] = g0 * fast_sigmoid(g0) * acc[ai][1][m][0][e]; h1[e] = g1 * fast_sigmoid(g1) * acc[ai][1][m][1][e];
                }
                *(u32x4*)(H + (size_t)r * FH + col) = pack8(h0, h1);
            }
    }
};
struct EpiNull {
    float* Z;
    __device__ __forceinline__ void operator()(const f32x4 (&acc)[2][2][4][2], const Unit& u, int wr, int wc, int fr, int fq) const {
        float s = 0.f;
#pragma unroll
        for (int ai = 0; ai < 2; ++ai)
#pragma unroll
            for (int bj = 0; bj < 2; ++bj)
#pragma unroll
                for (int m = 0; m < 4; ++m)
#pragma unroll
                    for (int n = 0; n < 2; ++n) s += acc[ai][bj][m][n][0] + acc[ai][bj][m][n][1] + acc[ai][bj][m][n][2] + acc[ai][bj][m][n][3];
        if (s != s) Z[threadIdx.x] = s;
    }
};
struct EpiDown {
    const bf16_t* X1; bf16_t* Z;
    __device__ __forceinline__ void operator()(const f32x4 (&acc)[2][2][4][2], const Unit& u, int wr, int wc, int fr, int fq) const {
#pragma unroll
        for (int ai = 0; ai < 2; ++ai)
#pragma unroll
            for (int m = 0; m < 4; ++m) {
                const int r = u.pm * 256 + ai * 128 + wr * 64 + m * 16 + fr;
#pragma unroll
                for (int bj = 0; bj < 2; ++bj) {
                    const size_t o = (size_t)r * DM + u.pn * 256 + bj * 128 + wc * 32 + 8 * fq;
                    const u32x4 xv = *(const u32x4*)(X1 + o);
                    f32x4 z0, z1;
#pragma unroll
                    for (int k = 0; k < 2; ++k) { z0[2 * k] = __uint_as_float(xv[k] << 16); z0[2 * k + 1] = __uint_as_float(xv[k] & 0xffff0000u); z1[2 * k] = __uint_as_float(xv[2 + k] << 16); z1[2 * k + 1] = __uint_as_float(xv[2 + k] & 0xffff0000u); }
                    *(u32x4*)(Z + o) = pack8(z0 * ALPHA + acc[ai][bj][m][0], z1 * ALPHA + acc[ai][bj][m][1]);
                }
            }
    }
};

template <int KSTEPS, bool DST_BF16>
__device__ __forceinline__ void skinny_gemm(LAS unsigned char* lds, const bf16_t* A, const bf16_t* Bt, const bf16_t* resid, void* dst) {
    constexpr int K = 8 * 32 * KSTEPS;
    const int tid = threadIdx.x, w = tid >> 6, lane = tid & 63, fr = lane & 15, fq = lane >> 4;
    for (int item = blockIdx.x; item < 256; item += gridDim.x) {
        const int rh = item & 1, cb = item >> 1;
        const bf16_t* ap = A + (size_t)(rh * 16 + fr) * K + w * (32 * KSTEPS) + 8 * fq;
        const bf16_t* bp = Bt + (size_t)(cb * 16 + fr) * K + w * (32 * KSTEPS) + 8 * fq;
        f32x4 acc = {0.f, 0.f, 0.f, 0.f};
#pragma unroll (KSTEPS > 11 ? 11 : KSTEPS)
        for (int s = 0; s < KSTEPS; ++s) { const bf16x8 a = *(const bf16x8*)(ap + 32 * s), bb = *(const bf16x8*)(bp + 32 * s); acc = __builtin_amdgcn_mfma_f32_16x16x32_bf16(bb, a, acc, 0, 0, 0); }
        *(LAS f32x4*)(lds + (w * 64 + lane) * 16) = acc;
        __syncthreads();
        if (w == 0) {
            f32x4 sum = *(const LAS f32x4*)(lds + lane * 16);
#pragma unroll
            for (int ww = 1; ww < 8; ++ww) sum = sum + *(const LAS f32x4*)(lds + (ww * 64 + lane) * 16);
            const int slot = cb * 16 + 4 * fq, col = (slot & ~31) + perm8(slot & 31);
            const size_t o = (size_t)(rh * 16 + fr) * DM + col;
            const u32x2 xv = *(const u32x2*)(resid + o);
            f32x4 z; z[0] = __uint_as_float(xv[0] << 16); z[1] = __uint_as_float(xv[0] & 0xffff0000u); z[2] = __uint_as_float(xv[1] << 16); z[3] = __uint_as_float(xv[1] & 0xffff0000u);
            z = z * ALPHA + sum;
            if (DST_BF16) *(u32x2*)((bf16_t*)dst + o) = pack4(z); else *(f32x4*)((float*)dst + o) = z;
        }
        __syncthreads();
    }
}

__device__ __forceinline__ int src_col_in(int np) {
    const int pn = np >> 8, bj = (np >> 7) & 1, s = np & 127;
    if (pn < 12) { const int wc = s >> 5, n = (s >> 4) & 1, q4 = s & 15; return (2 * pn + bj) * 128 + 64 * n + 16 * wc + q4; }
    if (pn < 18) return (2 * pn + bj) * 128 + (s & ~31) + perm8(s & 31);
    return (bj ? 5120 : 4608) + 128 * (pn - 18) + (s & ~31) + perm8(s & 31);
}
__device__ __forceinline__ void cvt_unit(const float* W, int ldw, int K, int srccol, bf16_t* Bt, int nrow, int k0, int oct) {
    const float* src = W + (size_t)(k0 + 8 * oct) * ldw + srccol;
    f32x4 v[8];
#pragma unroll
    for (int j = 0; j < 8; ++j) v[j] = __builtin_nontemporal_load((const f32x4*)(src + (size_t)j * ldw));
#pragma unroll
    for (int e = 0; e < 4; ++e) {
        u32x4 o; o.x = cvt_pk_bf16(v[0][e], v[1][e]); o.y = cvt_pk_bf16(v[2][e], v[3][e]); o.z = cvt_pk_bf16(v[4][e], v[5][e]); o.w = cvt_pk_bf16(v[6][e], v[7][e]);
        *(u32x4*)(Bt + (size_t)(nrow + e) * K + k0 + 8 * oct) = o;
    }
}
constexpr int NB_IN = NIN / 32, NB_OUT = DM / 32, NB_GU = 2 * FH / 32, NB_D = DM / 32;
constexpr int U_IN = NB_IN * (DM / 64), U_OUT = NB_OUT * (DM / 64), U_GU = NB_GU * (DM / 64), U_D = NB_D * (FH / 64);
__device__ __forceinline__ void cvt_range(const Params& p, int u0, int u1, int gw, int NW) {
    unsigned char* ws = p.ws;
    const int lane = threadIdx.x & 63, grp = lane >> 3, oct = lane & 7;
    for (int it = u0 + gw; it < u1; it += NW) {
        int r = it;
        if (r < U_IN) { const int nb = r % NB_IN, kb = r / NB_IN, np = nb * 32 + 4 * grp; cvt_unit(p.w_in, NIN, DM, src_col_in(np), (bf16_t*)(ws + WS_WIN), np, kb * 64, oct); continue; }
        r -= U_IN;
        if (r < U_OUT) { const int nb = r % NB_OUT, kb = r / NB_OUT, np = nb * 32 + 4 * grp; cvt_unit(p.w_out, DM, DM, (np & ~31) + perm8(np & 31), (bf16_t*)(ws + WS_WOUT), np, kb * 64, oct); continue; }
        r -= U_OUT;
        if (r < U_GU) { const int nb = r % NB_GU, kb = r / NB_GU, np = nb * 32 + 4 * grp, pn = np >> 8, bj = (np >> 7) & 1, sl = np & 127;
            cvt_unit(bj ? p.w_up : p.w_gate, FH, DM, 128 * pn + (sl & ~31) + perm8(sl & 31), (bf16_t*)(ws + WS_WGU), np, kb * 64, oct); continue; }
        r -= U_GU;
        { const int nb = r % NB_D, kb = r / NB_D, np = nb * 32 + 4 * grp; cvt_unit(p.w_down, DM, FH, (np & ~31) + perm8(np & 31), (bf16_t*)(ws + WS_WD), np, kb * 64, oct); }
    }
}
__device__ __forceinline__ void copy_rows(const f32x4* src, f32x4* dst, size_t per_b, size_t bstride, size_t soff, size_t gt, size_t gs) {
    const size_t n = 8 * per_b;
    for (size_t i0 = gt; i0 < n; i0 += 8 * gs) {
        f32x4 v[8];
#pragma unroll
        for (int u = 0; u < 8; ++u) { const size_t i = i0 + (size_t)u * gs; if (i < n) { const size_t b = i / per_b, o = i - b * per_b; v[u] = __builtin_nontemporal_load(src + b * bstride + soff + o); } }
#pragma unroll
        for (int u = 0; u < 8; ++u) { const size_t i = i0 + (size_t)u * gs; if (i < n) { const size_t b = i / per_b, o = i - b * per_b; __builtin_nontemporal_store(v[u], dst + b * bstride + o); } }
    }
}
__device__ __forceinline__ void copy_caches(const Params& p, size_t gt, size_t gs) {
    copy_rows((const f32x4*)p.c2, (f32x4*)(p.out + O_KVS2), (size_t)(2048 - 4) * 256, (size_t)2048 * 256, 4 * 256, gt, gs);
    copy_rows((const f32x4*)p.c1, (f32x4*)(p.out + O_KVS1), (size_t)(512 - 4) * 256, (size_t)512 * 256, 4 * 256, gt, gs);
    copy_rows((const f32x4*)p.c0, (f32x4*)(p.out + O_KVS0), (size_t)(128 - 4) * 256, (size_t)128 * 256, 4 * 256, gt, gs);
    copy_rows((const f32x4*)p.sconv, (f32x4*)(p.out + O_CONVS), (size_t)26 * 128, (size_t)30 * 128, 4 * 128, gt, gs);
}
__device__ __forceinline__ void phase_convert(const Params& p, LAS unsigned char* lds) {
    const int tid = threadIdx.x, G = gridDim.x, bid = blockIdx.x;
    unsigned char* ws = p.ws;
    { bf16_t* Xb = (bf16_t*)(ws + WS_XB);
      for (size_t i = (size_t)bid * 512 + tid; i < (size_t)MT * DM / 8; i += (size_t)G * 512) {
          const size_t e = i * 8; const float* src = e < (size_t)MP * DM ? p.xp + e : p.xs + (e - (size_t)MP * DM);
          const f32x4 a = __builtin_nontemporal_load((const f32x4*)src), b = __builtin_nontemporal_load((const f32x4*)(src + 4));
          *(u32x4*)(Xb + e) = pack8(a, b); } }
    { float* rope = (float*)(ws + WS_ROPE);
      for (int i = bid * 512 + tid; i < 4100 * 64; i += G * 512) {
          const int pr = i >> 6, k = i & 63; const double pos = pr < 4096 ? (double)pr : (double)(16384 + pr - 4096);
          const double inv = exp2(-(double)k * (13.287712379549449 / 64.0));
          double sn, cs; sincos(pos * inv, &sn, &cs);
          rope[2 * i] = (float)cs; rope[2 * i + 1] = (float)sn; } }
    { const int gw = bid * 8 + (tid >> 6), NW = G * 8;
      cvt_range(p, 0, U_IN, gw, NW);
      cvt_range(p, U_IN + U_OUT, U_IN + U_OUT + U_GU, gw, NW); }
}

constexpr int MIXPROBE = 0;
__device__ __forceinline__ unsigned off_b(unsigned row, unsigned ch) { return 256u * row + 16u * (ch ^ (((row & 3) << 2) | ((row >> 2) & 3))); }

struct APItem { int b, d, rcls, n, head; };
__device__ __forceinline__ APItem ap_decode(int item) {
    APItem I; const int blk = item & 31, hs = (item >> 5) & 3, g = (item >> 7) % 3; I.b = item / 384;
    const int dsh = 2 * g; I.d = 1 << dsh; I.rcls = blk & (I.d - 1); I.n = blk >> dsh; I.head = g * 4 + hs; return I;
}
__device__ __forceinline__ void ap_load(const Params& p, const APItem& I, u32x4 (&kv)[8], u32x4 (&vv)[8]) {
    const int tid = threadIdx.x, ch = tid & 15, r0 = tid >> 4;
    const bf16_t* Kb = (const bf16_t*)(p.ws + WS_K); const bf16_t* Vb = (const bf16_t*)(p.ws + WS_V);
#pragma unroll
    for (int i = 0; i < 8; ++i) {
        const int row = r0 + 32 * i, j = 128 * (I.n - 1) + row;
        kv[i] = (u32x4){0u, 0u, 0u, 0u}; vv[i] = kv[i];
        if (j >= 0) { const size_t gi = ((size_t)(I.b * SEQ + j * I.d + I.rcls)) * AW + I.head * 128 + ch * 8; kv[i] = *(const u32x4*)(Kb + gi); vv[i] = *(const u32x4*)(Vb + gi); }
    }
}
__device__ __forceinline__ void attn_prompt_loop(const Params& p, LAS unsigned char* lds, int n_items) {
    const int tid = threadIdx.x, w = tid >> 6, lane = tid & 63, fr = lane & 15, fq = lane >> 4, G = gridDim.x;
    bf16_t* AO = (bf16_t*)(p.ws + WS_AO); float* LSE = (float*)(p.ws + WS_LSE);
    const bool xl = (G == 256);
    int rho = 0;
    int it = xl ? ((int)(blockIdx.x & 7)) * 32 + (int)(blockIdx.x >> 3) : (int)blockIdx.x;
    if (it >= n_items) return;
    u32x4 kv[8], vv[8];
    APItem I = ap_decode(it);
    ap_load(p, I, kv, vv);
    const bf16_t* Qb = (const bf16_t*)(p.ws + WS_Q);
    for (;;) {
        {
            const int ch = tid & 15, r0 = tid >> 4;
#pragma unroll
            for (int i = 0; i < 8; ++i) { const int row = r0 + 32 * i; *(LAS u32x4*)(lds + off_b(row, ch)) = kv[i]; *(LAS u32x4*)(lds + 65536 + off_b(row, ch)) = vv[i]; }
        }
        const APItem C = I;
        const int qi = 16 * w + fr;
        const size_t qrow = (size_t)(C.b * SEQ + (128 * C.n + qi) * C.d + C.rcls);
        bf16x8 qf[4];
#pragma unroll
        for (int ks = 0; ks < 4; ++ks) qf[ks] = *(const bf16x8*)(Qb + qrow * AW + C.head * 128 + 32 * ks + 8 * fq);
        __syncthreads();
        ++rho;
        const int nit = xl ? (rho * 8 + (int)(blockIdx.x & 7)) * 32 + (int)(blockIdx.x >> 3) : it + G; const bool more = nit < n_items;
        if (more) { I = ap_decode(nit); ap_load(p, I, kv, vv); }
        f32x4 s[9];
#pragma unroll
        for (int tt = 0; tt < 9; ++tt) {
            const int T = w + tt; s[tt] = (f32x4){0.f, 0.f, 0.f, 0.f};
#pragma unroll
            for (int ks = 0; ks < 4; ++ks) { const bf16x8 kf = *(const LAS bf16x8*)(lds + off_b(16 * T + fr, 4 * ks + fq)); s[tt] = __builtin_amdgcn_mfma_f32_16x16x32_bf16(kf, qf[ks], s[tt], 0, 0, 0); }
        }
        const int kmin = C.n == 0 ? 128 : 0;
        float mx = -3.0e38f;
#pragma unroll
        for (int tt = 0; tt < 9; ++tt)
#pragma unroll
            for (int e = 0; e < 4; ++e) { const int kk = 16 * (w + tt) + 4 * fq + e; const bool ok = kk >= qi && kk <= qi + 128 && kk >= kmin; s[tt][e] = ok ? s[tt][e] : -3.0e38f; mx = fmaxf(mx, s[tt][e]); }
        mx = fmaxf(mx, __shfl_xor(mx, 16)); mx = fmaxf(mx, __shfl_xor(mx, 32));
        float den = 0.f;
#pragma unroll
        for (int tt = 0; tt < 9; ++tt)
#pragma unroll
            for (int e = 0; e < 4; ++e) { const float pv = __builtin_amdgcn_exp2f(s[tt][e] - mx); s[tt][e] = pv; den += pv; }
        den += __shfl_xor(den, 16); den += __shfl_xor(den, 32);
        f32x4 o[8];
#pragma unroll
        for (int dt = 0; dt < 8; ++dt) o[dt] = (f32x4){0.f, 0.f, 0.f, 0.f};
        const int q4 = (lane & 15) >> 2, p4 = lane & 3;
#pragma unroll
        for (int ku = 0; ku < 5; ++ku) {
            const int T0 = w + 2 * ku, T1 = ku < 4 ? T0 + 1 : T0;
            union { bf16x8 v; unsigned u[4]; } pf;
            pf.u[0] = cvt_pk_bf16(s[2 * ku][0], s[2 * ku][1]); pf.u[1] = cvt_pk_bf16(s[2 * ku][2], s[2 * ku][3]);
            if (ku < 4) { pf.u[2] = cvt_pk_bf16(s[2 * ku + 1][0], s[2 * ku + 1][1]); pf.u[3] = cvt_pk_bf16(s[2 * ku + 1][2], s[2 * ku + 1][3]); } else { pf.u[2] = 0u; pf.u[3] = 0u; }
#pragma unroll
            for (int dt = 0; dt < 8; ++dt) {
                union { bf16x8 v; bf16x4 h[2]; } vf;
                vf.h[0] = __builtin_amdgcn_ds_read_tr16_b64_v4i16((LAS bf16x4*)(lds + 65536 + off_b(16 * T0 + 4 * fq + q4, 2 * dt + (p4 >> 1)) + 8 * (p4 & 1)));
                vf.h[1] = __builtin_amdgcn_ds_read_tr16_b64_v4i16((LAS bf16x4*)(lds + 65536 + off_b(16 * T1 + 4 * fq + q4, 2 * dt + (p4 >> 1)) + 8 * (p4 & 1)));
                o[dt] = __builtin_amdgcn_mfma_f32_16x16x32_bf16(vf.v, pf.v, o[dt], 0, 0, 0);
            }
        }
        const float rden = 1.0f / den;
        bf16_t* orow = AO + qrow * DM + C.head * 128 + 4 * fq;
#pragma unroll
        for (int dt = 0; dt < 8; ++dt) *(u32x2*)(orow + 16 * dt) = pack4(o[dt] * rden);
        if (fq == 0) LSE[qrow * 12 + C.head] = mx + __builtin_amdgcn_logf(den);
        __syncthreads();
        if (!more) break;
        it = nit;
    }
}

__device__ __forceinline__ void attn_sample_item(const Params& p, LAS unsigned char* lds, int item) {
    const int tid = threadIdx.x;
    const int hs = item & 3, g = (item >> 2) % 3, b = item / 12, d = 1 << (2 * g), buf = 128 * d, head = g * 4 + hs;
    const float* cache = g == 0 ? p.c0 : (g == 1 ? p.c1 : p.c2);
    const float* okv = p.out + (g == 0 ? O_KVS0 : (g == 1 ? O_KVS1 : O_KVS2));
    LAS float* qs = (LAS float*)lds;
    LAS float* sc = qs + 512;
    LAS float* st = sc + 4 * 132;
    LAS float* part = st + 8;
    const bf16_t* Qb = (const bf16_t*)(p.ws + WS_Q);
    { const int t = tid >> 7, j = tid & 127; qs[tid] = bf2f(Qb[((size_t)MP + b * 4 + t) * AW + head * 128 + j]); }
    __syncthreads();
    {
        const int sub = tid & 3;
#pragma unroll
        for (int ps = 0; ps < 5; ++ps) {
            const int pi = ps * 128 + (tid >> 2);
            const bool act = pi < 516;
            const int t = act ? pi / 129 : 0, jj = act ? pi % 129 : 0;
            const int idx = buf + t - d * jj;
            const float* kr = (idx < buf ? cache + ((size_t)(b * buf + idx)) * 1024 : okv + ((size_t)(b * buf + idx - 4)) * 1024) + hs * 128 + 32 * sub;
            f32x4 kv[8];
#pragma unroll
            for (int c = 0; c < 8; ++c) kv[c] = *(const f32x4*)(kr + 4 * c);
            float dot = 0.f;
#pragma unroll
            for (int c = 0; c < 8; ++c) { const LAS float* qq = qs + t * 128 + 32 * sub + 4 * c; dot += kv[c][0] * qq[0] + kv[c][1] * qq[1] + kv[c][2] * qq[2] + kv[c][3] * qq[3]; }
            dot += __shfl_xor(dot, 1); dot += __shfl_xor(dot, 2);
            if (act && sub == 0) sc[t * 132 + jj] = dot;
        }
    }
    __syncthreads();
    if (tid < 256) {
        const int tw = tid >> 6, lane = tid & 63;
        const float a0 = sc[tw * 132 + lane], a1 = sc[tw * 132 + 64 + lane], a2 = lane == 0 ? sc[tw * 132 + 128] : -3.0e38f;
        const float mx = wave_max(fmaxf(fmaxf(a0, a1), a2));
        const float e0 = __builtin_amdgcn_exp2f(a0 - mx), e1 = __builtin_amdgcn_exp2f(a1 - mx), e2 = lane == 0 ? __builtin_amdgcn_exp2f(a2 - mx) : 0.f;
        const float den = wave_sum(e0 + e1 + e2);
        sc[tw * 132 + lane] = e0; sc[tw * 132 + 64 + lane] = e1; if (lane == 0) { sc[tw * 132 + 128] = e2; st[tw * 2] = den; st[tw * 2 + 1] = mx + __builtin_amdgcn_logf(den); }
    }
    __syncthreads();
    {
        const int t = tid >> 7, kq = (tid >> 5) & 3, dd4 = tid & 31;
        f32x4 acc = {0.f, 0.f, 0.f, 0.f};
#pragma unroll 11
        for (int i = 0; i < 33; ++i) {
            const int jj = kq + 4 * i;
            if (jj <= 128) {
                const int idx = buf + t - d * jj;
                const float* vr = (idx < buf ? cache + ((size_t)(b * buf + idx)) * 1024 : okv + ((size_t)(b * buf + idx - 4)) * 1024) + 512 + hs * 128 + 4 * dd4;
                acc = acc + *(const f32x4*)vr * sc[t * 132 + jj];
            }
        }
        *(LAS f32x4*)(part + (t * 4 + kq) * 128 + 4 * dd4) = acc;
    }
    __syncthreads();
    {
        const int t = tid >> 7, j = tid & 127;
        const size_t row = (size_t)MP + b * 4 + t;
        const float acc = (part[(t * 4 + 0) * 128 + j] + part[(t * 4 + 1) * 128 + j]) + (part[(t * 4 + 2) * 128 + j] + part[(t * 4 + 3) * 128 + j]);
        bf16_t* AO = (bf16_t*)(p.ws + WS_AO);
        AO[row * DM + head * 128 + j] = (bf16_t)(cvt_pk_bf16(acc / st[t * 2], 0.f) & 0xffffu);
        if (j == 0) ((float*)(p.ws + WS_LSE))[row * 12 + head] = st[t * 2 + 1];
    }
    __syncthreads();
}

__device__ __forceinline__ void conv_item(const Params& p, LAS unsigned char* lds, int item) {
    const int tid = threadIdx.x, ch = tid;
    const float* U = (const float*)(p.ws + WS_U);
    const bool samp = item >= 256;
    const int b = samp ? item - 256 : item >> 7, t0 = samp ? 0 : (item & 127) * 32;
    float wgt[31];
#pragma unroll
    for (int j = 0; j < 31; ++j) wgt[j] = p.conv_w[j * CCH + ch];
    float acc[32];
    const float bias = p.conv_b[ch];
#pragma unroll
    for (int t = 0; t < 32; ++t) acc[t] = bias;
#pragma unroll
    for (int rr = 0; rr < 62; ++rr) {
        float uv = 0.f;
        if (!samp) { const int tok = t0 - 30 + rr; if (tok >= 0) uv = U[((size_t)(b * SEQ + tok)) * CCH + ch]; }
        else { if (rr < 30) uv = p.sconv[((size_t)(b * 30 + rr)) * CCH + ch]; else if (rr < 34) uv = U[((size_t)(MP + b * 4 + rr - 30)) * CCH + ch]; }
#pragma unroll
        for (int t = 0; t < 32; ++t) { const int j = rr - t; if (j >= 0 && j <= 30) acc[t] += wgt[j] * uv; }
    }
    LAS float* ct = (LAS float*)lds;
#pragma unroll
    for (int t = 0; t < 32; ++t) ct[t * CCH + ch] = acc[t];
    __syncthreads();
    {
        const int w = tid >> 6, lane = tid & 63;
        bf16_t* AO = (bf16_t*)(p.ws + WS_AO);
        const int ntok = samp ? 4 : 32;
        for (int tt = 0; tt < 4; ++tt) {
            const int t = 4 * w + tt;
            if (t < ntok) {
                float x[8]; float sm = 0.f;
#pragma unroll
                for (int i = 0; i < 8; ++i) { x[i] = ct[t * CCH + lane + 64 * i]; sm += x[i]; }
                const float mean = wave_sum(sm) * (1.0f / CCH); float s2 = 0.f;
#pragma unroll
                for (int i = 0; i < 8; ++i) { x[i] -= mean; s2 += x[i] * x[i]; }
                const float rstd = rsqrtf(wave_sum(s2) * (1.0f / CCH) + LN_EPS);
                const size_t row = samp ? (size_t)MP + b * 4 + t : (size_t)b * SEQ + t0 + t;
#pragma unroll
                for (int i = 0; i < 8; ++i) { const int c = lane + 64 * i; float y = x[i] * rstd * p.cln_g[c] + p.cln_b[c]; y = y * fast_sigmoid(y);
                    AO[row * DM + AW + c] = (bf16_t)(cvt_pk_bf16(y, 0.f) & 0xffffu); }
            }
        }
    }
    __syncthreads();
}

__device__ __forceinline__ void phase_mixers(const Params& p, LAS unsigned char* lds) {
    constexpr int N_AP = 2 * 3 * 4 * 32, N_AS = 8 * 12, N_CV = 256 + 8;
    const int G = gridDim.x;
    attn_prompt_loop(p, lds, N_AP);
    for (int it = (blockIdx.x + N_AS) % G; it < N_AS; it += G) attn_sample_item(p, lds, it);
    if constexpr (MIXPROBE == 2) { for (int it = (blockIdx.x + N_AS) % G; it < N_AS; it += G) attn_sample_item(p, lds, it); }

}

__device__ __forceinline__ void phase_alpha(const Params& p) {
    bf16_t* AO = (bf16_t*)(p.ws + WS_AO); const float* LSE = (const float*)(p.ws + WS_LSE);
    for (size_t i = (size_t)blockIdx.x * 512 + threadIdx.x; i < (size_t)MT * 12 * 16; i += (size_t)gridDim.x * 512) {
        const int c = (int)(i & 15), s = (int)((i >> 4) % 12); const size_t row = i / 192;
        const int g = s >> 2, hs = s & 3;
        const float l0 = LSE[row * 12 + hs], l1 = LSE[row * 12 + 4 + hs], l2 = LSE[row * 12 + 8 + hs];
        const float mx = fmaxf(l0, fmaxf(l1, l2));
        const float e0 = __builtin_amdgcn_exp2f(l0 - mx), e1 = __builtin_amdgcn_exp2f(l1 - mx), e2 = __builtin_amdgcn_exp2f(l2 - mx);
        const float al = (g == 0 ? e0 : (g == 1 ? e1 : e2)) / (e0 + e1 + e2);
        u32x4* ptr = (u32x4*)(AO + row * DM + s * 128 + c * 8);
        u32x4 v = *ptr;
#pragma unroll
        for (int k = 0; k < 4; ++k) { const float lo = __uint_as_float(v[k] << 16) * al, hi = __uint_as_float(v[k] & 0xffff0000u) * al; v[k] = cvt_pk_bf16(lo, hi); }
        *ptr = v;
    }
}

__device__ __forceinline__ void phase_ln(const float* src, float* dstf, bf16_t* dstb, const float* gam, const float* bet) {
    const int lane = threadIdx.x & 63, gw = blockIdx.x * 8 + (threadIdx.x >> 6), NW = gridDim.x * 8;
    f32x4 gv[8], bv[8];
#pragma unroll
    for (int j = 0; j < 8; ++j) { gv[j] = *(const f32x4*)(gam + 4 * lane + 256 * j); bv[j] = *(const f32x4*)(bet + 4 * lane + 256 * j); }
    for (int r = gw; r < MT; r += NW) {
        const float* xr = src + (size_t)r * DM + 4 * lane;
        f32x4 v[8]; float sm = 0.f;
#pragma unroll
        for (int j = 0; j < 8; ++j) { v[j] = *(const f32x4*)(xr + 256 * j); sm += (v[j][0] + v[j][1]) + (v[j][2] + v[j][3]); }
        const float mean = wave_sum(sm) * (1.0f / DM); float s2 = 0.f;
#pragma unroll
        for (int j = 0; j < 8; ++j) { v[j] = v[j] - mean; s2 += (v[j][0] * v[j][0] + v[j][1] * v[j][1]) + (v[j][2] * v[j][2] + v[j][3] * v[j][3]); }
        const float rstd = rsqrtf(wave_sum(s2) * (1.0f / DM) + LN_EPS);
#pragma unroll
        for (int j = 0; j < 8; ++j) {
            const f32x4 y = v[j] * rstd * gv[j] + bv[j];
            if (dstf) *(f32x4*)(dstf + (size_t)r * DM + 4 * lane + 256 * j) = y;
            if (dstb) *(u32x2*)(dstb + (size_t)r * DM + 4 * lane + 256 * j) = pack4(y);
        }
    }
}

__device__ __forceinline__ void phase_ln_bf16(bf16_t* X, float* yout, const float* gam, const float* bet) {
    const int lane = threadIdx.x & 63, gw = blockIdx.x * 8 + (threadIdx.x >> 6), NW = gridDim.x * 8;
    for (int r = gw; r < MT; r += NW) {
        bf16_t* xr = X + (size_t)r * DM + 8 * lane;
        float v[32]; float sm = 0.f;
#pragma unroll
        for (int j = 0; j < 4; ++j) { const u32x4 q = *(const u32x4*)(xr + 512 * j);
#pragma unroll
            for (int k = 0; k < 4; ++k) { v[8 * j + 2 * k] = __uint_as_float(q[k] << 16); v[8 * j + 2 * k + 1] = __uint_as_float(q[k] & 0xffff0000u); sm += v[8 * j + 2 * k] + v[8 * j + 2 * k + 1]; } }
        const float mean = wave_sum(sm) * (1.0f / DM); float s2 = 0.f;
#pragma unroll
        for (int i = 0; i < 32; ++i) { v[i] -= mean; s2 += v[i] * v[i]; }
        const float rstd = rsqrtf(wave_sum(s2) * (1.0f / DM) + LN_EPS);
#pragma unroll
        for (int j = 0; j < 4; ++j) {
            const f32x4 g0 = *(const f32x4*)(gam + 8 * lane + 512 * j), g1 = *(const f32x4*)(gam + 8 * lane + 512 * j + 4), b0 = *(const f32x4*)(bet + 8 * lane + 512 * j), b1 = *(const f32x4*)(bet + 8 * lane + 512 * j + 4);
            f32x4 y0, y1;
#pragma unroll
            for (int k = 0; k < 4; ++k) { y0[k] = v[8 * j + k] * rstd * g0[k] + b0[k]; y1[k] = v[8 * j + 4 + k] * rstd * g1[k] + b1[k]; }
            if (yout) { float* yr = yout + (size_t)r * DM + 8 * lane + 512 * j; __builtin_nontemporal_store(y0, (f32x4*)yr); __builtin_nontemporal_store(y1, (f32x4*)(yr + 4)); }
            else *(u32x4*)(xr + 512 * j) = pack8(y0, y1);
        }
    }
}

constexpr int REP0 = 1, REP2 = 1, REPG = 1, PROBE_NULLGU = 0, REPMASK = 0, NSYNC_PROBE = 0;
template <int MASK>
__global__ void __launch_bounds__(512, 2) fwd_kernel(Params p) {
    extern __shared__ __attribute__((aligned(16))) unsigned char shm[];
    LAS unsigned char* lds = (LAS unsigned char*)shm;
    unsigned char* ws = p.ws;
    __shared__ uint4 xb_words;
    if (threadIdx.x == 0) xb_words = make_uint4(0u, 0u, 0u, 0u);
    __syncthreads();
    const XcdBarrier xb = xcd_barrier_post((unsigned*)(ws + WS_BAR), (volatile LAS unsigned*)&xb_words);
    if (p.out == nullptr) cg::this_grid().sync();
#define GSYNC() xcd_barrier(xb)
#define PH(k) if constexpr ((MASK >> (k)) & 1)
#define SYNC(k) if constexpr (((MASK >> (k)) & 1) && (MASK & ((1 << (k)) - 1))) GSYNC();
    PH(0) for (int rep = 0; rep < REP0; ++rep) { phase_convert(p, lds); if (rep + 1 < REP0) GSYNC(); }
    SYNC(1)
    PH(1) { Gemm g{(const bf16_t*)(ws + WS_XB), (const bf16_t*)(ws + WS_WIN), MPAD, NIN, DM}; StaticOrder S; S.init(MPAD, NIN, gridDim.x, blockIdx.x);
            EpiIn E{(bf16_t*)(ws + WS_Q), (bf16_t*)(ws + WS_K), (bf16_t*)(ws + WS_V), (float*)(ws + WS_U), (const float*)(ws + WS_ROPE), p.out};
            gemm_phase(lds, g, S, E); if constexpr ((REPMASK >> 1) & 1) { GSYNC(); gemm_phase(lds, g, S, E); }
            { const int ntile = (MPAD / 256) * (NIN / 256), G = gridDim.x, full = ntile % G;
              if (full != 0 && (int)blockIdx.x >= full) { const int gw = ((int)blockIdx.x - full) * 8 + (threadIdx.x >> 6), NW = (G - full) * 8;
                  cvt_range(p, U_IN, U_IN + U_OUT, gw, NW); cvt_range(p, U_IN + U_OUT + U_GU, U_IN + U_OUT + U_GU + U_D, gw, NW); }
              else if (full == 0) { const int gw = blockIdx.x * 8 + (threadIdx.x >> 6), NW = G * 8; cvt_range(p, U_IN, U_IN + U_OUT, gw, NW); cvt_range(p, U_IN + U_OUT + U_GU, U_IN + U_OUT + U_GU + U_D, gw, NW); } } }
    SYNC(2)
    PH(2) { phase_mixers(p, lds); if constexpr (REP2 == 2) { GSYNC(); phase_mixers(p, lds); } }
    SYNC(3)
    PH(3) { for (int it = blockIdx.x; it < 256 + 8; it += gridDim.x) conv_item(p, lds, it); phase_alpha(p); }
    SYNC(4)
    PH(4) { skinny_gemm<8, true>(lds, (const bf16_t*)(ws + WS_AO) + (size_t)MP * DM, (const bf16_t*)(ws + WS_WOUT), (const bf16_t*)(ws + WS_XB) + (size_t)MP * DM, (bf16_t*)(ws + WS_Z1) + (size_t)MP * DM);
            Gemm g{(const bf16_t*)(ws + WS_AO), (const bf16_t*)(ws + WS_WOUT), MP, DM, DM}; StaticOrder S; S.init(MP, DM, gridDim.x, blockIdx.x);
            EpiOut E{(const bf16_t*)(ws + WS_XB), (bf16_t*)(ws + WS_Z1)}; gemm_phase(lds, g, S, E); if constexpr ((REPMASK >> 4) & 1) { GSYNC(); gemm_phase(lds, g, S, E); } }
    SYNC(5)
    PH(5) phase_ln_bf16((bf16_t*)(ws + WS_Z1), nullptr, p.ln1_g, p.ln1_b);
    SYNC(6)
    PH(6) { Gemm g{(const bf16_t*)(ws + WS_Z1), (const bf16_t*)(ws + WS_WGU), MPAD, 2 * FH, DM}; StaticOrder S; S.init(MPAD, 2 * FH, gridDim.x, blockIdx.x);
            if constexpr (PROBE_NULLGU) { EpiNull EN{(float*)(ws + WS_LSE)}; gemm_phase(lds, g, S, EN); GSYNC(); }
            EpiGU E{(bf16_t*)(ws + WS_H)}; gemm_phase(lds, g, S, E); if constexpr ((REPMASK >> 6) & 1) { GSYNC(); gemm_phase(lds, g, S, E); }
            { const int ntile = (MPAD / 256) * (2 * FH / 256), G = gridDim.x, full = ntile % G;
              if (full != 0 && (int)blockIdx.x >= full) copy_caches(p, (size_t)((int)blockIdx.x - full) * 512 + threadIdx.x, (size_t)(G - full) * 512);
              else if (full == 0) copy_caches(p, (size_t)blockIdx.x * 512 + threadIdx.x, (size_t)G * 512); } }
    SYNC(7)
    PH(7) { skinny_gemm<22, true>(lds, (const bf16_t*)(ws + WS_H) + (size_t)MP * FH, (const bf16_t*)(ws + WS_WD), (const bf16_t*)(ws + WS_Z1) + (size_t)MP * DM, (bf16_t*)(ws + WS_AO) + (size_t)MP * DM);
            Gemm g{(const bf16_t*)(ws + WS_H), (const bf16_t*)(ws + WS_WD), MP, DM, FH}; StaticOrder S; S.init(MP, DM, gridDim.x, blockIdx.x);
            EpiDown E{(const bf16_t*)(ws + WS_Z1), (bf16_t*)(ws + WS_AO)}; gemm_phase(lds, g, S, E); if constexpr ((REPMASK >> 7) & 1) { GSYNC(); gemm_phase(lds, g, S, E); } }
    SYNC(8)
    PH(8) phase_ln_bf16((bf16_t*)(ws + WS_AO), p.out, p.ln2_g, p.ln2_b);
    if constexpr (NSYNC_PROBE > 0) { for (int i = 0; i < NSYNC_PROBE; ++i) GSYNC(); }
#undef PH
#undef SYNC
}

#ifndef N_LAUNCH_MODE
#define N_LAUNCH_MODE 1
#endif
template <int MASK> static void launch_plain(const Params& p, int grid, hipStream_t stream) {
    static bool attr = false;
    if (!attr) { (void)hipFuncSetAttribute((const void*)fwd_kernel<MASK>, hipFuncAttributeMaxDynamicSharedMemorySize, STAGE_BYTES); attr = true; }
    hipLaunchKernelGGL(fwd_kernel<MASK>, dim3(grid), dim3(512), STAGE_BYTES, stream, p);
}
extern "C" void kernel_launch(void* const* d_in, const int* in_sizes, int n_in, void* d_out, int out_size, void* d_ws, size_t ws_size, hipStream_t stream) {
    static int grid = 0;
    if (grid == 0) {
        if (n_in != 19 || (size_t)out_size != O_END || ws_size < WS_END) { fprintf(stderr, "kernel_launch: unexpected shapes: n_in %d out %d ws %zu (need %zu)\n", n_in, out_size, ws_size, (size_t)WS_END); grid = -1; return; }
        int dev = 0, cus = 0, per_cu = 0;
        (void)hipGetDevice(&dev); (void)hipDeviceGetAttribute(&cus, hipDeviceAttributeMultiprocessorCount, dev);
#if N_LAUNCH_MODE == 1
        if (hipFuncSetAttribute((const void*)fwd_kernel<0x1FF>, hipFuncAttributeMaxDynamicSharedMemorySize, STAGE_BYTES) != hipSuccess) { fprintf(stderr, "kernel_launch: hipFuncSetAttribute failed\n"); grid = -1; return; }
        if (hipOccupancyMaxActiveBlocksPerMultiprocessor(&per_cu, (const void*)fwd_kernel<0x1FF>, 512, STAGE_BYTES) != hipSuccess || per_cu < 1) { fprintf(stderr, "kernel_launch: occupancy query failed (%d)\n", per_cu); (void)hipGetLastError(); }
#endif
        grid = cus;
        fprintf(stderr, "kernel_launch: grid %d (per_cu %d)\n", grid, per_cu);
    }
    if (grid < 0) return;
    Params p{};
    p.xp = (const float*)d_in[0]; p.xs = (const float*)d_in[1]; p.c0 = (const float*)d_in[2]; p.c1 = (const float*)d_in[3]; p.c2 = (const float*)d_in[4]; p.sconv = (const float*)d_in[5];
    p.w_in = (const float*)d_in[6]; p.w_out = (const float*)d_in[7]; p.conv_w = (const float*)d_in[8]; p.conv_b = (const float*)d_in[9]; p.cln_g = (const float*)d_in[10]; p.cln_b = (const float*)d_in[11];
    p.ln1_g = (const float*)d_in[12]; p.ln1_b = (const float*)d_in[13]; p.w_gate = (const float*)d_in[14]; p.w_up = (const float*)d_in[15]; p.w_down = (const float*)d_in[16]; p.ln2_g = (const float*)d_in[17]; p.ln2_b = (const float*)d_in[18];
    p.out = (float*)d_out; p.ws = (unsigned char*)d_ws;
#if N_LAUNCH_MODE == 1
    if (hipMemsetAsync((unsigned char*)d_ws + WS_BAR, 0, 16384, stream) != hipSuccess) { fprintf(stderr, "kernel_launch: memset of the barrier words failed\n"); return; }
    void* args[] = {&p};
    hipError_t e = hipLaunchCooperativeKernel((const void*)fwd_kernel<0x1FF>, dim3(grid), dim3(512), args, STAGE_BYTES, stream);
    if (e != hipSuccess) fprintf(stderr, "cooperative launch failed: %s (grid %d)\n", hipGetErrorString(e), grid);
#else
    launch_plain<1>(p, grid, stream); launch_plain<2>(p, grid, stream); launch_plain<4>(p, grid, stream); launch_plain<8>(p, grid, stream); launch_plain<16>(p, grid, stream);
    launch_plain<32>(p, grid, stream); launch_plain<64>(p, grid, stream); launch_plain<128>(p, grid, stream); launch_plain<256>(p, grid, stream);
#endif
}
```

```cpp
#include <hip/hip_runtime.h>
#include <hip/hip_cooperative_groups.h>
#include <cstdio>
namespace cg = cooperative_groups;

#define LAS __attribute__((address_space(3)))
typedef unsigned short bf16_t;
typedef short bf16x8 __attribute__((ext_vector_type(8)));
typedef short bf16x4 __attribute__((ext_vector_type(4)));
typedef float f32x4 __attribute__((ext_vector_type(4)));
typedef unsigned u32x4 __attribute__((ext_vector_type(4)));
typedef unsigned u32x2 __attribute__((ext_vector_type(2)));

constexpr int DM = 2048, SEQ = 4096, MP = 8192, MS = 32, MT = MP + MS, MPAD = 8448;
constexpr int AW = 1536, CCH = 512, NIN = 5632, FH = 5632;
constexpr float ALPHA = 1.189207115002721f;
constexpr float LN_EPS = 1e-5f;
constexpr float QSCALE = 0.08838834764831845f * 1.4426950408889634f;

constexpr size_t O_KVP0 = (size_t)MT * DM;
constexpr size_t O_KVP1 = O_KVP0 + 2 * 128 * 1024;
constexpr size_t O_KVP2 = O_KVP1 + 2 * 512 * 1024;
constexpr size_t O_CONVP = O_KVP2 + 2 * 2048 * 1024;
constexpr size_t O_KVS0 = O_CONVP + 2 * 30 * 512;
constexpr size_t O_KVS1 = O_KVS0 + 8 * 128 * 1024;
constexpr size_t O_KVS2 = O_KVS1 + 8 * 512 * 1024;
constexpr size_t O_CONVS = O_KVS2 + (size_t)8 * 2048 * 1024;
constexpr size_t O_END = O_CONVS + 8 * 30 * 512;

constexpr size_t WS_WIN = 0;
constexpr size_t WS_WOUT = WS_WIN + (size_t)NIN * DM * 2;
constexpr size_t WS_WGU = WS_WOUT + (size_t)DM * DM * 2;
constexpr size_t WS_WD = WS_WGU + (size_t)2 * FH * DM * 2;
constexpr size_t WS_ROPE = WS_WD + (size_t)DM * FH * 2;
constexpr size_t WS_LSE = WS_ROPE + (size_t)4100 * 64 * 8;
constexpr size_t WS_R1 = WS_LSE + (size_t)MPAD * 12 * 4;
constexpr size_t WS_XB = WS_R1;
constexpr size_t WS_Q = WS_XB + (size_t)MPAD * DM * 2;
constexpr size_t WS_K = WS_Q + (size_t)MPAD * AW * 2;
constexpr size_t WS_V = WS_K + (size_t)MPAD * AW * 2;
constexpr size_t WS_U = WS_V + (size_t)MPAD * AW * 2;
constexpr size_t WS_R1END = WS_U + (size_t)MPAD * CCH * 4;
constexpr size_t WS_H = WS_R1;
constexpr size_t WS_AO = WS_R1END;
constexpr size_t WS_Z1 = WS_AO + (size_t)MPAD * DM * 2;
constexpr size_t WS_BAR = WS_Z1 + (size_t)MPAD * DM * 4;
constexpr size_t WS_END = WS_BAR + 16384;
static_assert((size_t)MPAD * FH * 2 <= WS_R1END - WS_R1, "H alias");

struct Params {
    const float *xp, *xs, *c0, *c1, *c2, *sconv, *w_in, *w_out, *conv_w, *conv_b, *cln_g, *cln_b, *ln1_g, *ln1_b, *w_gate, *w_up, *w_down, *ln2_g, *ln2_b;
    float* out; unsigned char* ws;
};

__device__ __forceinline__ unsigned cvt_pk_bf16(float lo, float hi) { unsigned r; asm volatile("v_cvt_pk_bf16_f32 %0, %1, %2" : "=v"(r) : "v"(lo), "v"(hi)); return r; }
__device__ __forceinline__ float bf2f(unsigned short b) { return __uint_as_float(((unsigned)b) << 16); }
__device__ __forceinline__ u32x2 pack4(f32x4 v) { u32x2 r; r.x = cvt_pk_bf16(v[0], v[1]); r.y = cvt_pk_bf16(v[2], v[3]); return r; }
__device__ __forceinline__ u32x4 pack8(f32x4 a, f32x4 b) { u32x4 r; r.x = cvt_pk_bf16(a[0], a[1]); r.y = cvt_pk_bf16(a[2], a[3]); r.z = cvt_pk_bf16(b[0], b[1]); r.w = cvt_pk_bf16(b[2], b[3]); return r; }
__device__ __forceinline__ float wave_sum(float v) {
#pragma unroll
    for (int o = 1; o < 64; o <<= 1) v += __shfl_xor(v, o);
    return v;
}
__device__ __forceinline__ float wave_max(float v) {
#pragma unroll
    for (int o = 1; o < 64; o <<= 1) v = fmaxf(v, __shfl_xor(v, o));
    return v;
}
__device__ __forceinline__ int perm8(int s) { return 8 * ((s >> 2) & 3) + 4 * ((s >> 4) & 1) + (s & 3); }
__device__ __forceinline__ float fast_sigmoid(float g) { return 1.0f / (1.0f + __expf(-g)); }

#define XB_TMO      128
#define XB_XCNT(j)  (256  + 64 * (j))
#define XB_XSUB(j)  (1280 + 64 * (j))
#define XB_XGEN(j)  (2304 + 64 * (j))
#define XB_TOP      3328
#define XB_TOPGEN   3392
#define XCD_BAR_WORDS 3456
#define XB_SPIN_CAP (1u << 18)
__device__ __forceinline__ unsigned xb_ld(unsigned* p)              { return __hip_atomic_load(p, __ATOMIC_RELAXED, __HIP_MEMORY_SCOPE_AGENT); }
__device__ __forceinline__ unsigned xb_add(unsigned* p, unsigned v) { return __hip_atomic_fetch_add(p, v, __ATOMIC_RELAXED, __HIP_MEMORY_SCOPE_AGENT); }
__device__ __forceinline__ unsigned xb_xcc_id() { return (unsigned)__builtin_amdgcn_s_getreg((3 << 11) | 20) & 0xFu; }
#define XB_SPIN(cond, bar) do { unsigned _sp = 0; while (cond) { __builtin_amdgcn_s_sleep(1); \
    if ((++_sp & 255u) == 0u) { if (xb_ld(&(bar)[XB_TMO])) break; if (_sp > XB_SPIN_CAP) { atomicAdd(&(bar)[XB_TMO], 1u); break; } } } } while (0)
struct XcdBarrier { unsigned* bar; unsigned x; volatile LAS unsigned* st; };
__device__ __forceinline__ XcdBarrier xcd_barrier_post(unsigned* bar, volatile LAS unsigned* st) {
    XcdBarrier b; b.bar = bar; b.x = xb_xcc_id(); b.st = st;
    if (threadIdx.x == 0) (void)xb_add(&bar[XB_XCNT(b.x)], 1u);
    return b;
}
__device__ __forceinline__ void xcd_barrier_complete(unsigned* bar, unsigned x, unsigned& nloc, unsigned& nx) {
    const unsigned G = gridDim.x * gridDim.y * gridDim.z;
    unsigned sum, cnt, mine, sp = 0u;
    for (;;) {
        sum = 0u; cnt = 0u; mine = 0u;
#pragma unroll
        for (unsigned j = 0; j < 16; ++j) { const unsigned c = xb_ld(&bar[XB_XCNT(j)]); sum += c; cnt += (c > 0u) ? 1u : 0u; mine = (j == x) ? c : mine; }
        if (sum == G) break;
        __builtin_amdgcn_s_sleep(1);
        if ((++sp & 255u) == 0u) { if (xb_ld(&bar[XB_TMO])) break; if (sp > XB_SPIN_CAP) { atomicAdd(&bar[XB_TMO], 1u); break; } }
    }
    nloc = mine > 0u ? mine : 1u; nx = cnt > 0u ? cnt : 1u;
}
__device__ __forceinline__ void xcd_barrier(const XcdBarrier& b) {
    asm volatile("s_waitcnt vmcnt(0)" ::: "memory");
    __syncthreads();
    if (threadIdx.x == 0) {
        unsigned* bar = b.bar;
        __builtin_amdgcn_s_waitcnt(0);
        unsigned nloc = b.st[0], nx = b.st[1];
        if (nloc == 0u) { xcd_barrier_complete(bar, b.x, nloc, nx); b.st[0] = nloc; b.st[1] = nx; }
        const unsigned old = xb_add(&bar[XB_XSUB(b.x)], 1u);
        const unsigned gen = old / nloc;
        if (old + 1u == (gen + 1u) * nloc) {
            __builtin_amdgcn_fence(__ATOMIC_RELEASE, "agent");
            asm volatile("s_waitcnt vmcnt(0)" ::: "memory");
            const unsigned og = xb_add(&bar[XB_TOP], 1u);
            const unsigned tg = og / nx;
            if (og + 1u == (tg + 1u) * nx) xb_add(&bar[XB_TOPGEN], 1u);
            else XB_SPIN(xb_ld(&bar[XB_TOPGEN]) == tg, bar);
            __builtin_amdgcn_fence(__ATOMIC_ACQUIRE, "agent");
            xb_add(&bar[XB_XGEN(b.x)], 1u);
            asm volatile("s_waitcnt vmcnt(0)" ::: "memory");
        } else {
            XB_SPIN(xb_ld(&bar[XB_XGEN(b.x)]) == gen, bar);
            __builtin_amdgcn_fence(__ATOMIC_ACQUIRE, "agent");
            asm volatile("s_waitcnt vmcnt(0)" ::: "memory");
        }
    }
    __syncthreads();
}

constexpr int BM = 256, BK = 64, HALF = 128, HTB = HALF * BK * 2, STAGE_BYTES = 8 * HTB, NXCD = 8, WGM = 8;
__device__ __forceinline__ int lds_byte(int r, int c) { const int st = (r >> 4) * 2 + (c >> 5), rr = r & 15, cc = c & 31, ob = rr * 64 + cc * 2; return st * 1024 + (ob ^ (((ob >> 9) & 1) << 5)); }
__device__ __forceinline__ void stage_rc(int b, int& R, int& C) { const int st = b / 1024, sb = b % 1024, swz = sb ^ (((sb >> 9) & 1) << 5); R = (st >> 1) * 16 + swz / 64; C = (st & 1) * 32 + (swz % 64) / 2; }
struct Unit { int pm, pn; };
struct Gemm { const bf16_t* A; const bf16_t* Bt; int M, N, K; };
struct StaticOrder {
    int nM, nN, nwg, G, c;
    __device__ void init(int M, int N, int G_, int c_) { nM = M / BM; nN = N / BM; nwg = nM * nN; G = G_; c = c_; }
    __device__ bool next(int i, Unit& u) const {
        const long L = (long)i * G + c; if (L >= nwg) return false;
        int wgid = (int)L; { const int q = nwg / NXCD, r = nwg % NXCD, xcd = wgid % NXCD, off = wgid / NXCD; wgid = (xcd < r ? xcd * (q + 1) : r * (q + 1) + (xcd - r) * q) + off; }
        const int nig = WGM * nN, gid = wgid / nig, fm = gid * WGM, gsz = (nM - fm) < WGM ? (nM - fm) : WGM;
        u.pm = fm + ((wgid % nig) % gsz); u.pn = (wgid % nig) / gsz; return true;
    }
};

template <class Epi>
__device__ __forceinline__ void gemm_phase(LAS unsigned char* lds, const Gemm g, const StaticOrder& S, const Epi& E) {
    int tid = threadIdx.x; asm volatile("" : "+v"(tid));
    const int wid = __builtin_amdgcn_readfirstlane(tid >> 6), lane = tid & 63, wr = wid >> 2, wc = wid & 3, fr = lane & 15, fq = lane >> 4;
    const int K = g.K, nt = K / BK;
    unsigned voffA[2];
#pragma unroll
    for (int i = 0; i < 2; ++i) { int R, C; stage_rc(tid * 16 + i * 8192, R, C); voffA[i] = (unsigned)(R * K + C) * 2u; }
    const size_t kstep = (size_t)(BK * 2);
    const size_t hstep = (size_t)HALF * K * 2;
    const size_t tstep = 2 * hstep;
    const unsigned ldsw = (unsigned)wid * 1024u;
    const int aoff = lds_byte(wr * 64 + fr, fq * 8), boff = lds_byte(wc * 32 + fr, fq * 8);
#define PG8_SA(b, h) (((b) * 2 + (h)) * HTB)
#define PG8_SB(b, h) ((4 + (b) * 2 + (h)) * HTB)
#define PG8_STAGE(bufoff, gbase, voff) do { _Pragma("unroll") for (int _i = 0; _i < 2; ++_i) \
        __builtin_amdgcn_global_load_lds((const unsigned*)((const char*)(gbase) + (voff)[_i]), (LAS unsigned*)(lds + (bufoff) + ldsw + _i * 8192), 16, 0, 0); } while (0)
#define PG8_LDA(dst, b, h) do { _Pragma("unroll") for (int m = 0; m < 4; ++m) _Pragma("unroll") for (int k = 0; k < 2; ++k) dst[m][k] = *(const LAS bf16x8*)(lds + PG8_SA(b, h) + aoff + m * 2048 + k * 1024); } while (0)
#define PG8_LDB(dst, b, h) do { _Pragma("unroll") for (int n = 0; n < 2; ++n) _Pragma("unroll") for (int k = 0; k < 2; ++k) dst[n][k] = *(const LAS bf16x8*)(lds + PG8_SB(b, h) + boff + n * 2048 + k * 1024); } while (0)
#define PG8_MMA(ai, bj, At, Bt) do { __builtin_amdgcn_s_setprio(1); _Pragma("unroll") for (int m = 0; m < 4; ++m) _Pragma("unroll") for (int n = 0; n < 2; ++n) _Pragma("unroll") for (int k = 0; k < 2; ++k) \
        acc[ai][bj][m][n] = __builtin_amdgcn_mfma_f32_16x16x32_bf16(Bt[n][k], At[m][k], acc[ai][bj][m][n], 0, 0, 0); __builtin_amdgcn_s_setprio(0); } while (0)
#define PG8_WAIT_V(n) asm volatile("s_waitcnt vmcnt(" #n ")" ::: "memory")
#define PG8_WAIT_L(n) asm volatile("s_waitcnt lgkmcnt(" #n ")" ::: "memory")
#define PG8_BAR __builtin_amdgcn_s_barrier()
#define PG8_SCHED __builtin_amdgcn_sched_barrier(0)
    Unit cur, nxt; int ui = 0;
    if (!S.next(0, cur)) return;
    f32x4 acc[2][2][4][2];
#pragma unroll
    for (int a = 0; a < 2; ++a)
#pragma unroll
        for (int b = 0; b < 2; ++b)
#pragma unroll
            for (int m = 0; m < 4; ++m)
#pragma unroll
                for (int n = 0; n < 2; ++n) acc[a][b][m][n] = (f32x4){0.f, 0.f, 0.f, 0.f};
    bf16x8 At[4][2], B0[2][2], B1[2][2];
    const char* cA = (const char*)g.A + (size_t)cur.pm * tstep; const char* cB = (const char*)g.Bt + (size_t)cur.pn * tstep;
    PG8_STAGE(PG8_SB(0, 0), cB, voffA); PG8_STAGE(PG8_SA(0, 0), cA, voffA); PG8_STAGE(PG8_SB(0, 1), cB + hstep, voffA); PG8_STAGE(PG8_SA(0, 1), cA + hstep, voffA);
    if (wr == 1) PG8_BAR;
    PG8_WAIT_V(4); PG8_BAR;
    PG8_STAGE(PG8_SB(1, 0), cB + kstep, voffA); PG8_STAGE(PG8_SA(1, 0), cA + kstep, voffA); PG8_STAGE(PG8_SB(1, 1), cB + hstep + kstep, voffA);
    PG8_WAIT_V(6); PG8_BAR;
    for (;;) {
        const bool has_next = S.next(ui + 1, nxt);
        const char* nA = has_next ? (const char*)g.A + (size_t)nxt.pm * tstep : cA; const char* nB = has_next ? (const char*)g.Bt + (size_t)nxt.pn * tstep : cB;
        for (int t = 0; t < nt; t += 2) {
            const bool last = (t == nt - 2);
            const char* a1 = cA + (size_t)(t + 1) * kstep;
            const char* a2 = last ? nA : cA + (size_t)(t + 2) * kstep; const char* b2 = last ? nB : cB + (size_t)(t + 2) * kstep;
            const char* a3 = a2 + kstep; const char* b3 = b2 + kstep;
            PG8_LDB(B0, 0, 0); PG8_SCHED; PG8_LDA(At, 0, 0); PG8_STAGE(PG8_SA(1, 1), a1 + hstep, voffA);
            PG8_WAIT_L(8); PG8_BAR; PG8_WAIT_L(0); PG8_MMA(0, 0, At, B0); PG8_BAR; PG8_SCHED;
            PG8_LDB(B1, 0, 1); PG8_STAGE(PG8_SB(0, 0), b2, voffA);
            PG8_BAR; PG8_WAIT_L(0); PG8_MMA(0, 1, At, B1); PG8_BAR;
            PG8_LDA(At, 0, 1); PG8_STAGE(PG8_SA(0, 0), a2, voffA);
            PG8_BAR; PG8_WAIT_L(0); PG8_MMA(1, 0, At, B0); PG8_BAR; PG8_SCHED;
            PG8_STAGE(PG8_SB(0, 1), b2 + hstep, voffA);
            PG8_WAIT_V(6); PG8_BAR; PG8_MMA(1, 1, At, B1); PG8_BAR;
            PG8_LDB(B0, 1, 0); PG8_SCHED; PG8_LDA(At, 1, 0); PG8_STAGE(PG8_SA(0, 1), a2 + hstep, voffA);
            PG8_WAIT_L(8); PG8_BAR; PG8_WAIT_L(0); PG8_MMA(0, 0, At, B0); PG8_BAR; PG8_SCHED;
            PG8_LDB(B1, 1, 1); PG8_STAGE(PG8_SB(1, 0), b3, voffA);
            PG8_BAR; PG8_WAIT_L(0); PG8_MMA(0, 1, At, B1); PG8_BAR;
            PG8_LDA(At, 1, 1); PG8_STAGE(PG8_SA(1, 0), a3, voffA);
            PG8_BAR; PG8_WAIT_L(0); PG8_MMA(1, 0, At, B0); PG8_BAR; PG8_SCHED;
            PG8_STAGE(PG8_SB(1, 1), b3 + hstep, voffA);
            PG8_WAIT_V(6); PG8_BAR; PG8_MMA(1, 1, At, B1); PG8_BAR;
        }
        E(acc, cur, wr, wc, fr, fq);
        if (!has_next) break;
#pragma unroll
        for (int a = 0; a < 2; ++a)
#pragma unroll
            for (int b = 0; b < 2; ++b)
#pragma unroll
                for (int m = 0; m < 4; ++m)
#pragma unroll
                    for (int n = 0; n < 2; ++n) acc[a][b][m][n] = (f32x4){0.f, 0.f, 0.f, 0.f};
        cur = nxt; cA = nA; cB = nB; ++ui;
    }
    PG8_WAIT_V(0);
    if (wr == 0) PG8_BAR;
    PG8_BAR;
#undef PG8_SA
#undef PG8_SB
#undef PG8_STAGE
#undef PG8_LDA
#undef PG8_LDB
#undef PG8_MMA
#undef PG8_WAIT_V
#undef PG8_WAIT_L
#undef PG8_BAR
#undef PG8_SCHED
}

__device__ __forceinline__ float* kv_out_ptr(float* out, int r, int gi, bool& ok) {
    const int keep = 128 << (2 * gi);
    ok = false;
    if (r < MP) {
        const int b = r >> 12, t = r & 4095;
        if (t < SEQ - keep) return out;
        ok = true;
        const size_t base = gi == 0 ? O_KVP0 : (gi == 1 ? O_KVP1 : O_KVP2);
        return out + base + ((size_t)(b * keep + t - (SEQ - keep))) * 1024;
    }
    if (r < MT) {
        const int b = (r - MP) >> 2, t = (r - MP) & 3;
        ok = true;
        const size_t base = gi == 0 ? O_KVS0 : (gi == 1 ? O_KVS1 : O_KVS2);
        return out + base + ((size_t)(b * keep + keep - 4 + t)) * 1024;
    }
    return out;
}

struct EpiIn {
    bf16_t *Qb, *Kb, *Vb; float* U; const float* rope; float* out;
    __device__ __forceinline__ void operator()(const f32x4 (&acc)[2][2][4][2], const Unit& u, int wr, int wc, int fr, int fq) const {
        const int pn = u.pn;
        const int rbase = u.pm * 256 + wr * 64 + fr;
        if (pn < 12) {
            const int col = 16 * wc + 4 * fq;
#pragma unroll
            for (int ai = 0; ai < 2; ++ai) {
                f32x4 cs[4][2];
#pragma unroll
                for (int m = 0; m < 4; ++m) {
                    const int r = rbase + ai * 128 + m * 16;
                    const int pidx = r < MP ? (r & 4095) : (r < MT ? 4096 + ((r - MP) & 3) : 0);
                    const f32x4* rp = (const f32x4*)(rope + ((size_t)pidx * 64 + 16 * wc + 4 * fq) * 2);
                    cs[m][0] = rp[0]; cs[m][1] = rp[1];
                }
#pragma unroll
                for (int m = 0; m < 4; ++m) {
                    const int r = rbase + ai * 128 + m * 16;
                    const f32x4 cs0 = cs[m][0], cs1 = cs[m][1];
                    const f32x4 c = {cs0[0], cs0[2], cs1[0], cs1[2]}, sn = {cs0[1], cs0[3], cs1[1], cs1[3]};
#pragma unroll
                    for (int bj = 0; bj < 2; ++bj) {
                        const f32x4 x1 = acc[ai][bj][m][0], x2 = acc[ai][bj][m][1];
                        f32x4 o1 = x1 * c - x2 * sn, o2 = x2 * c + x1 * sn;
                        const int hq = 2 * pn + bj;
                        if (pn < 6) {
                            o1 = o1 * QSCALE; o2 = o2 * QSCALE;
                            bf16_t* dst = Qb + (size_t)r * AW + hq * 128 + col;
                            *(u32x2*)dst = pack4(o1); *(u32x2*)(dst + 64) = pack4(o2);
                        } else {
                            const int hk = hq - 12;
                            bf16_t* dst = Kb + (size_t)r * AW + hk * 128 + col;
                            *(u32x2*)dst = pack4(o1); *(u32x2*)(dst + 64) = pack4(o2);
                            bool ok; float* o = kv_out_ptr(out, r, hk >> 2, ok);
                            if (ok) { o += (hk & 3) * 128 + col; *(f32x4*)o = o1; *(f32x4*)(o + 64) = o2; }
                        }
                    }
                }
            }
        } else if (pn < 18) {
            const int col = 32 * wc + 8 * fq;
#pragma unroll
            for (int ai = 0; ai < 2; ++ai)
#pragma unroll
                for (int m = 0; m < 4; ++m) {
                    const int r = rbase + ai * 128 + m * 16;
#pragma unroll
                    for (int bj = 0; bj < 2; ++bj) {
                        const int hv = 2 * (pn - 12) + bj;
                        const f32x4 v0 = acc[ai][bj][m][0], v1 = acc[ai][bj][m][1];
                        *(u32x4*)(Vb + (size_t)r * AW + hv * 128 + col) = pack8(v0, v1);
                        bool ok; float* o = kv_out_ptr(out, r, hv >> 2, ok);
                        if (ok) { o += 512 + (hv & 3) * 128 + col; *(f32x4*)o = v0; *(f32x4*)(o + 4) = v1; }
                    }
                }
        } else {
            const int ch = 128 * (pn - 18) + 32 * wc + 8 * fq;
#pragma unroll
            for (int ai = 0; ai < 2; ++ai)
#pragma unroll
                for (int m = 0; m < 4; ++m) {
                    const int r = rbase + ai * 128 + m * 16;
                    f32x4 u0, u1;
#pragma unroll
                    for (int e = 0; e < 4; ++e) { u0[e] = acc[ai][0][m][0][e] * fast_sigmoid(acc[ai][1][m][0][e]); u1[e] = acc[ai][0][m][1][e] * fast_sigmoid(acc[ai][1][m][1][e]); }
                    float* up = U + (size_t)r * CCH + ch;
                    *(f32x4*)up = u0; *(f32x4*)(up + 4) = u1;
                    float* o = nullptr;
                    if (r < MP) { const int b = r >> 12, t = r & 4095; if (t >= SEQ - 30) o = out + O_CONVP + ((size_t)(b * 30 + t - (SEQ - 30))) * CCH + ch; }
                    else if (r < MT) { const int b = (r - MP) >> 2, t = (r - MP) & 3; o = out + O_CONVS + ((size_t)(b * 30 + 26 + t)) * CCH + ch; }
                    if (o) { *(f32x4*)o = u0; *(f32x4*)(o + 4) = u1; }
                }
        }
    }
};
struct EpiOut {
    const bf16_t* Xb; bf16_t* Z;
    __device__ __forceinline__ void operator()(const f32x4 (&acc)[2][2][4][2], const Unit& u, int wr, int wc, int fr, int fq) const {
#pragma unroll
        for (int ai = 0; ai < 2; ++ai)
#pragma unroll
            for (int m = 0; m < 4; ++m) {
                const int r = u.pm * 256 + ai * 128 + wr * 64 + m * 16 + fr;
#pragma unroll
                for (int bj = 0; bj < 2; ++bj) {
                    const size_t o = (size_t)r * DM + u.pn * 256 + bj * 128 + wc * 32 + 8 * fq;
                    const u32x4 xv = *(const u32x4*)(Xb + o);
                    f32x4 z0, z1;
#pragma unroll
                    for (int k = 0; k < 2; ++k) { z0[2 * k] = __uint_as_float(xv[k] << 16); z0[2 * k + 1] = __uint_as_float(xv[k] & 0xffff0000u); z1[2 * k] = __uint_as_float(xv[2 + k] << 16); z1[2 * k + 1] = __uint_as_float(xv[2 + k] & 0xffff0000u); }
                    *(u32x4*)(Z + o) = pack8(z0 * ALPHA + acc[ai][bj][m][0], z1 * ALPHA + acc[ai][bj][m][1]);
                }
            }
    }
};
struct EpiGU {
    bf16_t* H;
    __device__ __forceinline__ void operator()(const f32x4 (&acc)[2][2][4][2], const Unit& u, int wr, int wc, int fr, int fq) const {
#pragma unroll
        for (int ai = 0; ai < 2; ++ai)
#pragma unroll
            for (int m = 0; m < 4; ++m) {
                const int r = u.pm * 256 + ai * 128 + wr * 64 + m * 16 + fr;
                const int col = 128 * u.pn + 32 * wc + 8 * fq;
                f32x4 h0, h1;
#pragma unroll
                for (int e = 0; e < 4; ++e) {
                    const float g0 = acc[ai][0][m][0][e], g1 = acc[ai][0][m][1][e];
                    h0[e] = g0 * fast_sigmoid(g0) * acc[ai][1][m][0][e]; h1[e] = g1 * fast_sigmoid(g1) * acc[ai][1][m][1][e];
                }
                *(u32x4*)(H + (size_t)r * FH + col) = pack8(h0, h1);
            }
    }
};
struct EpiNull {
    float* Z;
    __device__ __forceinline__ void operator()(const f32x4 (&acc)[2][2][4][2], const Unit& u, int wr, int wc, int fr, int fq) const {
        float s = 0.f;
#pragma unroll
        for (int ai = 0; ai < 2; ++ai)
#pragma unroll
            for (int bj = 0; bj < 2; ++bj)
#pragma unroll
                for (int m = 0; m < 4; ++m)
#pragma unroll
                    for (int n = 0; n < 2; ++n) s += acc[ai][bj][m][n][0] + acc[ai][bj][m][n][1] + acc[ai][bj][m][n][2] + acc[ai][bj][m][n][3];
        if (s != s) Z[threadIdx.x] = s;
    }
};
struct EpiDown {
    const bf16_t* X1; bf16_t* Z;
    __device__ __forceinline__ void operator()(const f32x4 (&acc)[2][2][4][2], const Unit& u, int wr, int wc, int fr, int fq) const {
#pragma unroll
        for (int ai = 0; ai < 2; ++ai)
#pragma unroll
            for (int m = 0; m < 4; ++m) {
                const int r = u.pm * 256 + ai * 128 + wr * 64 + m * 16 + fr;
#pragma unroll
                for (int bj = 0; bj < 2; ++bj) {
                    const size_t o = (size_t)r * DM + u.pn * 256 + bj * 128 + wc * 32 + 8 * fq;
                    const u32x4 xv = *(const u32x4*)(X1 + o);
                    f32x4 z0, z1;
#pragma unroll
                    for (int k = 0; k < 2; ++k) { z0[2 * k] = __uint_as_float(xv[k] << 16); z0[2 * k + 1] = __uint_as_float(xv[k] & 0xffff0000u); z1[2 * k] = __uint_as_float(xv[2 + k] << 16); z1[2 * k + 1] = __uint_as_float(xv[2 + k] & 0xffff0000u); }
                    *(u32x4*)(Z + o) = pack8(z0 * ALPHA + acc[ai][bj][m][0], z1 * ALPHA + acc[ai][bj][m][1]);
                }
            }
    }
};

template <int KSTEPS, bool DST_BF16>
__device__ __forceinline__ void skinny_gemm(LAS unsigned char* lds, const bf16_t* A, const bf16_t* Bt, const bf16_t* resid, void* dst) {
    constexpr int K = 8 * 32 * KSTEPS;
    const int tid = threadIdx.x, w = tid >> 6, lane = tid & 63, fr = lane & 15, fq = lane >> 4;
    for (int item = blockIdx.x; item < 256; item += gridDim.x) {
        const int rh = item & 1, cb = item >> 1;
        const bf16_t* ap = A + (size_t)(rh * 16 + fr) * K + w * (32 * KSTEPS) + 8 * fq;
        const bf16_t* bp = Bt + (size_t)(cb * 16 + fr) * K + w * (32 * KSTEPS) + 8 * fq;
        f32x4 acc = {0.f, 0.f, 0.f, 0.f};
#pragma unroll (KSTEPS > 11 ? 11 : KSTEPS)
        for (int s = 0; s < KSTEPS; ++s) { const bf16x8 a = *(const bf16x8*)(ap + 32 * s), bb = *(const bf16x8*)(bp + 32 * s); acc = __builtin_amdgcn_mfma_f32_16x16x32_bf16(bb, a, acc, 0, 0, 0); }
        *(LAS f32x4*)(lds + (w * 64 + lane) * 16) = acc;
        __syncthreads();
        if (w == 0) {
            f32x4 sum = *(const LAS f32x4*)(lds + lane * 16);
#pragma unroll
            for (int ww = 1; ww < 8; ++ww) sum = sum + *(const LAS f32x4*)(lds + (ww * 64 + lane) * 16);
            const int slot = cb * 16 + 4 * fq, col = (slot & ~31) + perm8(slot & 31);
            const size_t o = (size_t)(rh * 16 + fr) * DM + col;
            const u32x2 xv = *(const u32x2*)(resid + o);
            f32x4 z; z[0] = __uint_as_float(xv[0] << 16); z[1] = __uint_as_float(xv[0] & 0xffff0000u); z[2] = __uint_as_float(xv[1] << 16); z[3] = __uint_as_float(xv[1] & 0xffff0000u);
            z = z * ALPHA + sum;
            if (DST_BF16) *(u32x2*)((bf16_t*)dst + o) = pack4(z); else *(f32x4*)((float*)dst + o) = z;
        }
        __syncthreads();
    }
}

__device__ __forceinline__ int src_col_in(int np) {
    const int pn = np >> 8, bj = (np >> 7) & 1, s = np & 127;
    if (pn < 12) { const int wc = s >> 5, n = (s >> 4) & 1, q4 = s & 15; return (2 * pn + bj) * 128 + 64 * n + 16 * wc + q4; }
    if (pn < 18) return (2 * pn + bj) * 128 + (s & ~31) + perm8(s & 31);
    return (bj ? 5120 : 4608) + 128 * (pn - 18) + (s & ~31) + perm8(s & 31);
}
struct CvtDesc { const float* src; size_t ldw; bf16_t* dst; size_t K; };
constexpr int NB_IN = NIN / 32, NB_OUT = DM / 32, NB_GU = 2 * FH / 32, NB_D = DM / 32;
constexpr int U_IN = NB_IN * (DM / 64), U_OUT = NB_OUT * (DM / 64), U_GU = NB_GU * (DM / 64), U_D = NB_D * (FH / 64);
__device__ __forceinline__ CvtDesc cvt_decode(const Params& p, int it) {
    unsigned char* ws = p.ws;
    const int lane = threadIdx.x & 63, grp = lane >> 3, oct = lane & 7;
    const float* W; int ldw, K, srccol, np, k0; bf16_t* Bt;
    int r = it;
    if (r < U_IN) { const int nb = r % NB_IN, kb = r / NB_IN; np = nb * 32 + 4 * grp; k0 = kb * 64; W = p.w_in; ldw = NIN; K = DM; srccol = src_col_in(np); Bt = (bf16_t*)(ws + WS_WIN); }
    else if ((r -= U_IN) < U_OUT) { const int nb = r % NB_OUT, kb = r / NB_OUT; np = nb * 32 + 4 * grp; k0 = kb * 64; W = p.w_out; ldw = DM; K = DM; srccol = (np & ~31) + perm8(np & 31); Bt = (bf16_t*)(ws + WS_WOUT); }
    else if ((r -= U_OUT) < U_GU) { const int nb = r % NB_GU, kb = r / NB_GU; np = nb * 32 + 4 * grp; k0 = kb * 64; const int pn = np >> 8, bj = (np >> 7) & 1, sl = np & 127;
        W = bj ? p.w_up : p.w_gate; ldw = FH; K = DM; srccol = 128 * pn + (sl & ~31) + perm8(sl & 31); Bt = (bf16_t*)(ws + WS_WGU); }
    else { r -= U_GU; const int nb = r % NB_D, kb = r / NB_D; np = nb * 32 + 4 * grp; k0 = kb * 64; W = p.w_down; ldw = DM; K = FH; srccol = (np & ~31) + perm8(np & 31); Bt = (bf16_t*)(ws + WS_WD); }
    CvtDesc d; d.src = W + (size_t)(k0 + 8 * oct) * ldw + srccol; d.ldw = (size_t)ldw; d.dst = Bt + (size_t)np * K + k0 + 8 * oct; d.K = (size_t)K; return d;
}
__device__ __forceinline__ void cvt_store(const CvtDesc& d, const f32x4 (&v)[8]) {
#pragma unroll
    for (int e = 0; e < 4; ++e) {
        u32x4 o; o.x = cvt_pk_bf16(v[0][e], v[1][e]); o.y = cvt_pk_bf16(v[2][e], v[3][e]); o.z = cvt_pk_bf16(v[4][e], v[5][e]); o.w = cvt_pk_bf16(v[6][e], v[7][e]);
        *(u32x4*)(d.dst + (size_t)e * d.K) = o;
    }
}
__device__ __forceinline__ void cvt_range(const Params& p, int u0, int u1, int gw, int NW) {
    for (int it = u0 + gw; it < u1; it += 2 * NW) {
        const bool two = it + NW < u1;
        const CvtDesc d0 = cvt_decode(p, it), d1 = cvt_decode(p, two ? it + NW : it);
        f32x4 v0[8], v1[8];
#pragma unroll
        for (int j = 0; j < 8; ++j) v0[j] = __builtin_nontemporal_load((const f32x4*)(d0.src + (size_t)j * d0.ldw));
        if (two) {
#pragma unroll
            for (int j = 0; j < 8; ++j) v1[j] = __builtin_nontemporal_load((const f32x4*)(d1.src + (size_t)j * d1.ldw));
        }
        cvt_store(d0, v0);
        if (two) cvt_store(d1, v1);
    }
}
__device__ __forceinline__ void copy_rows(const f32x4* src, f32x4* dst, size_t per_b, size_t bstride, size_t soff, size_t gt, size_t gs) {
    const size_t n = 8 * per_b;
    for (size_t i0 = gt; i0 < n; i0 += 8 * gs) {
        f32x4 v[8];
#pragma unroll
        for (int u = 0; u < 8; ++u) { const size_t i = i0 + (size_t)u * gs; if (i < n) { const size_t b = i / per_b, o = i - b * per_b; v[u] = __builtin_nontemporal_load(src + b * bstride + soff + o); } }
#pragma unroll
        for (int u = 0; u < 8; ++u) { const size_t i = i0 + (size_t)u * gs; if (i < n) { const size_t b = i / per_b, o = i - b * per_b; __builtin_nontemporal_store(v[u], dst + b * bstride + o); } }
    }
}
__device__ __forceinline__ void copy_caches(const Params& p, size_t gt, size_t gs) {
    copy_rows((const f32x4*)p.c2, (f32x4*)(p.out + O_KVS2), (size_t)(2048 - 4) * 256, (size_t)2048 * 256, 4 * 256, gt, gs);
    copy_rows((const f32x4*)p.c1, (f32x4*)(p.out + O_KVS1), (size_t)(512 - 4) * 256, (size_t)512 * 256, 4 * 256, gt, gs);
    copy_rows((const f32x4*)p.c0, (f32x4*)(p.out + O_KVS0), (size_t)(128 - 4) * 256, (size_t)128 * 256, 4 * 256, gt, gs);
    copy_rows((const f32x4*)p.sconv, (f32x4*)(p.out + O_CONVS), (size_t)26 * 128, (size_t)30 * 128, 4 * 128, gt, gs);
}
__device__ __forceinline__ void phase_convert(const Params& p, LAS unsigned char* lds) {
    const int tid = threadIdx.x, G = gridDim.x, bid = blockIdx.x;
    unsigned char* ws = p.ws;
    { bf16_t* Xb = (bf16_t*)(ws + WS_XB);
      const size_t N = (size_t)MT * DM / 8, S = (size_t)G * 512;
      for (size_t i0 = (size_t)bid * 512 + tid; i0 < N; i0 += 4 * S) {
          f32x4 a[4], b[4];
#pragma unroll
          for (int u = 0; u < 4; ++u) { const size_t i = i0 + u * S; if (i < N) { const size_t e = i * 8; const float* src = e < (size_t)MP * DM ? p.xp + e : p.xs + (e - (size_t)MP * DM);
              a[u] = __builtin_nontemporal_load((const f32x4*)src); b[u] = __builtin_nontemporal_load((const f32x4*)(src + 4)); } }
#pragma unroll
          for (int u = 0; u < 4; ++u) { const size_t i = i0 + u * S; if (i < N) *(u32x4*)(Xb + i * 8) = pack8(a[u], b[u]); }
      } }
    { float* rope = (float*)(ws + WS_ROPE);
      for (int i = bid * 512 + tid; i < 4100 * 64; i += G * 512) {
          const int pr = i >> 6, k = i & 63; const double pos = pr < 4096 ? (double)pr : (double)(16384 + pr - 4096);
          const double inv = exp2(-(double)k * (13.287712379549449 / 64.0));
          double sn, cs; sincos(pos * inv, &sn, &cs);
          rope[2 * i] = (float)cs; rope[2 * i + 1] = (float)sn; } }
    { const int gw = bid * 8 + (tid >> 6), NW = G * 8;
      cvt_range(p, 0, U_IN, gw, NW); }
}

constexpr int MIXPROBE = 0;
__device__ __forceinline__ unsigned off_b(unsigned row, unsigned ch) { return 256u * row + 16u * (ch ^ (((row & 3) << 2) | ((row >> 2) & 3))); }

struct APItem { int b, d, rcls, n, head; };
__device__ __forceinline__ APItem ap_decode(int item) {
    APItem I; const int blk = item & 31, hs = (item >> 5) & 3, g = (item >> 7) % 3; I.b = item / 384;
    const int dsh = 2 * g; I.d = 1 << dsh; I.rcls = blk & (I.d - 1); I.n = blk >> dsh; I.head = g * 4 + hs; return I;
}
__device__ __forceinline__ void ap_load(const Params& p, const APItem& I, u32x4 (&kv)[8], u32x4 (&vv)[8]) {
    const int tid = threadIdx.x, ch = tid & 15, r0 = tid >> 4;
    const bf16_t* Kb = (const bf16_t*)(p.ws + WS_K); const bf16_t* Vb = (const bf16_t*)(p.ws + WS_V);
#pragma unroll
    for (int i = 0; i < 8; ++i) {
        const int row = r0 + 32 * i, j = 128 * (I.n - 1) + row;
        kv[i] = (u32x4){0u, 0u, 0u, 0u}; vv[i] = kv[i];
        if (j >= 0) { const size_t gi = ((size_t)(I.b * SEQ + j * I.d + I.rcls)) * AW + I.head * 128 + ch * 8; kv[i] = *(const u32x4*)(Kb + gi); vv[i] = *(const u32x4*)(Vb + gi); }
    }
}
__device__ __forceinline__ void attn_prompt_loop(const Params& p, LAS unsigned char* lds, int n_items) {
    const int tid = threadIdx.x, w = tid >> 6, lane = tid & 63, fr = lane & 15, fq = lane >> 4, G = gridDim.x;
    bf16_t* AO = (bf16_t*)(p.ws + WS_AO); float* LSE = (float*)(p.ws + WS_LSE);
    const bool xl = (G == 256);
    int rho = 0;
    int it = xl ? ((int)(blockIdx.x & 7)) * 32 + (int)(blockIdx.x >> 3) : (int)blockIdx.x;
    if (it >= n_items) return;
    u32x4 kv[8], vv[8];
    APItem I = ap_decode(it);
    ap_load(p, I, kv, vv);
    const bf16_t* Qb = (const bf16_t*)(p.ws + WS_Q);
    for (;;) {
        {
            const int ch = tid & 15, r0 = tid >> 4;
#pragma unroll
            for (int i = 0; i < 8; ++i) { const int row = r0 + 32 * i; *(LAS u32x4*)(lds + off_b(row, ch)) = kv[i]; *(LAS u32x4*)(lds + 65536 + off_b(row, ch)) = vv[i]; }
        }
        const APItem C = I;
        const int qi = 16 * w + fr;
        const size_t qrow = (size_t)(C.b * SEQ + (128 * C.n + qi) * C.d + C.rcls);
        bf16x8 qf[4];
#pragma unroll
        for (int ks = 0; ks < 4; ++ks) qf[ks] = *(const bf16x8*)(Qb + qrow * AW + C.head * 128 + 32 * ks + 8 * fq);
        __syncthreads();
        ++rho;
        const int nit = xl ? (rho * 8 + (int)(blockIdx.x & 7)) * 32 + (int)(blockIdx.x >> 3) : it + G; const bool more = nit < n_items;
        if (more) { I = ap_decode(nit); ap_load(p, I, kv, vv); }
        f32x4 s[9];
#pragma unroll
        for (int tt = 0; tt < 9; ++tt) {
            const int T = w + tt; s[tt] = (f32x4){0.f, 0.f, 0.f, 0.f};
#pragma unroll
            for (int ks = 0; ks < 4; ++ks) { const bf16x8 kf = *(const LAS bf16x8*)(lds + off_b(16 * T + fr, 4 * ks + fq)); s[tt] = __builtin_amdgcn_mfma_f32_16x16x32_bf16(kf, qf[ks], s[tt], 0, 0, 0); }
        }
        const int kmin = C.n == 0 ? 128 : 0;
        float mx = -3.0e38f;
#pragma unroll
        for (int tt = 0; tt < 9; ++tt)
#pragma unroll
            for (int e = 0; e < 4; ++e) { const int kk = 16 * (w + tt) + 4 * fq + e; const bool ok = kk >= qi && kk <= qi + 128 && kk >= kmin; s[tt][e] = ok ? s[tt][e] : -3.0e38f; mx = fmaxf(mx, s[tt][e]); }
        mx = fmaxf(mx, __shfl_xor(mx, 16)); mx = fmaxf(mx, __shfl_xor(mx, 32));
        float den = 0.f;
#pragma unroll
        for (int tt = 0; tt < 9; ++tt)
#pragma unroll
            for (int e = 0; e < 4; ++e) { const float pv = __builtin_amdgcn_exp2f(s[tt][e] - mx); s[tt][e] = pv; den += pv; }
        den += __shfl_xor(den, 16); den += __shfl_xor(den, 32);
        f32x4 o[8];
#pragma unroll
        for (int dt = 0; dt < 8; ++dt) o[dt] = (f32x4){0.f, 0.f, 0.f, 0.f};
        const int q4 = (lane & 15) >> 2, p4 = lane & 3;
#pragma unroll
        for (int ku = 0; ku < 5; ++ku) {
            const int T0 = w + 2 * ku, T1 = ku < 4 ? T0 + 1 : T0;
            union { bf16x8 v; unsigned u[4]; } pf;
            pf.u[0] = cvt_pk_bf16(s[2 * ku][0], s[2 * ku][1]); pf.u[1] = cvt_pk_bf16(s[2 * ku][2], s[2 * ku][3]);
            if (ku < 4) { pf.u[2] = cvt_pk_bf16(s[2 * ku + 1][0], s[2 * ku + 1][1]); pf.u[3] = cvt_pk_bf16(s[2 * ku + 1][2], s[2 * ku + 1][3]); } else { pf.u[2] = 0u; pf.u[3] = 0u; }
#pragma unroll
            for (int dt = 0; dt < 8; ++dt) {
                union { bf16x8 v; bf16x4 h[2]; } vf;
                vf.h[0] = __builtin_amdgcn_ds_read_tr16_b64_v4i16((LAS bf16x4*)(lds + 65536 + off_b(16 * T0 + 4 * fq + q4, 2 * dt + (p4 >> 1)) + 8 * (p4 & 1)));
                vf.h[1] = __builtin_amdgcn_ds_read_tr16_b64_v4i16((LAS bf16x4*)(lds + 65536 + off_b(16 * T1 + 4 * fq + q4, 2 * dt + (p4 >> 1)) + 8 * (p4 & 1)));
                o[dt] = __builtin_amdgcn_mfma_f32_16x16x32_bf16(vf.v, pf.v, o[dt], 0, 0, 0);
            }
        }
        const float rden = 1.0f / den;
        bf16_t* orow = AO + qrow * DM + C.head * 128 + 4 * fq;
#pragma unroll
        for (int dt = 0; dt < 8; ++dt) *(u32x2*)(orow + 16 * dt) = pack4(o[dt] * rden);
        if (fq == 0) LSE[qrow * 12 + C.head] = mx + __builtin_amdgcn_logf(den);
        __syncthreads();
        if (!more) break;
        it = nit;
    }
}

__device__ __forceinline__ void attn_sample_item(const Params& p, LAS unsigned char* lds, int item) {
    const int tid = threadIdx.x;
    const int hs = item & 3, g = (item >> 2) % 3, b = item / 12, d = 1 << (2 * g), buf = 128 * d, head = g * 4 + hs;
    const float* cache = g == 0 ? p.c0 : (g == 1 ? p.c1 : p.c2);
    const float* okv = p.out + (g == 0 ? O_KVS0 : (g == 1 ? O_KVS1 : O_KVS2));
    LAS float* qs = (LAS float*)lds;
    LAS float* sc = qs + 512;
    LAS float* st = sc + 4 * 132;
    LAS float* part = st + 8;
    const bf16_t* Qb = (const bf16_t*)(p.ws + WS_Q);
    { const int t = tid >> 7, j = tid & 127; qs[tid] = bf2f(Qb[((size_t)MP + b * 4 + t) * AW + head * 128 + j]); }
    __syncthreads();
    {
        const int sub = tid & 3;
#pragma unroll
        for (int ps = 0; ps < 5; ++ps) {
            const int pi = ps * 128 + (tid >> 2);
            const bool act = pi < 516;
            const int t = act ? pi / 129 : 0, jj = act ? pi % 129 : 0;
            const int idx = buf + t - d * jj;
            const float* kr = (idx < buf ? cache + ((size_t)(b * buf + idx)) * 1024 : okv + ((size_t)(b * buf + idx - 4)) * 1024) + hs * 128 + 32 * sub;
            f32x4 kv[8];
#pragma unroll
            for (int c = 0; c < 8; ++c) kv[c] = *(const f32x4*)(kr + 4 * c);
            float dot = 0.f;
#pragma unroll
            for (int c = 0; c < 8; ++c) { const LAS float* qq = qs + t * 128 + 32 * sub + 4 * c; dot += kv[c][0] * qq[0] + kv[c][1] * qq[1] + kv[c][2] * qq[2] + kv[c][3] * qq[3]; }
            dot += __shfl_xor(dot, 1); dot += __shfl_xor(dot, 2);
            if (act && sub == 0) sc[t * 132 + jj] = dot;
        }
    }
    __syncthreads();
    if (tid < 256) {
        const int tw = tid >> 6, lane = tid & 63;
        const float a0 = sc[tw * 132 + lane], a1 = sc[tw * 132 + 64 + lane], a2 = lane == 0 ? sc[tw * 132 + 128] : -3.0e38f;
        const float mx = wave_max(fmaxf(fmaxf(a0, a1), a2));
        const float e0 = __builtin_amdgcn_exp2f(a0 - mx), e1 = __builtin_amdgcn_exp2f(a1 - mx), e2 = lane == 0 ? __builtin_amdgcn_exp2f(a2 - mx) : 0.f;
        const float den = wave_sum(e0 + e1 + e2);
        sc[tw * 132 + lane] = e0; sc[tw * 132 + 64 + lane] = e1; if (lane == 0) { sc[tw * 132 + 128] = e2; st[tw * 2] = den; st[tw * 2 + 1] = mx + __builtin_amdgcn_logf(den); }
    }
    __syncthreads();
    {
        const int t = tid >> 7, kq = (tid >> 5) & 3, dd4 = tid & 31;
        f32x4 acc = {0.f, 0.f, 0.f, 0.f};
#pragma unroll 11
        for (int i = 0; i < 33; ++i) {
            const int jj = kq + 4 * i;
            if (jj <= 128) {
                const int idx = buf + t - d * jj;
                const float* vr = (idx < buf ? cache + ((size_t)(b * buf + idx)) * 1024 : okv + ((size_t)(b * buf + idx - 4)) * 1024) + 512 + hs * 128 + 4 * dd4;
                acc = acc + *(const f32x4*)vr * sc[t * 132 + jj];
            }
        }
        *(LAS f32x4*)(part + (t * 4 + kq) * 128 + 4 * dd4) = acc;
    }
    __syncthreads();
    {
        const int t = tid >> 7, j = tid & 127;
        const size_t row = (size_t)MP + b * 4 + t;
        const float acc = (part[(t * 4 + 0) * 128 + j] + part[(t * 4 + 1) * 128 + j]) + (part[(t * 4 + 2) * 128 + j] + part[(t * 4 + 3) * 128 + j]);
        bf16_t* AO = (bf16_t*)(p.ws + WS_AO);
        AO[row * DM + head * 128 + j] = (bf16_t)(cvt_pk_bf16(acc / st[t * 2], 0.f) & 0xffffu);
        if (j == 0) ((float*)(p.ws + WS_LSE))[row * 12 + head] = st[t * 2 + 1];
    }
    __syncthreads();
}

__device__ __forceinline__ void conv_item(const Params& p, LAS unsigned char* lds, int item) {
    const int tid = threadIdx.x, ch = tid;
    const float* U = (const float*)(p.ws + WS_U);
    const bool samp = item >= 256;
    const int b = samp ? item - 256 : item >> 7, t0 = samp ? 0 : (item & 127) * 32;
    float wgt[31];
#pragma unroll
    for (int j = 0; j < 31; ++j) wgt[j] = p.conv_w[j * CCH + ch];
    float acc[32];
    const float bias = p.conv_b[ch];
#pragma unroll
    for (int t = 0; t < 32; ++t) acc[t] = bias;
#pragma unroll
    for (int rr = 0; rr < 62; ++rr) {
        float uv = 0.f;
        if (!samp) { const int tok = t0 - 30 + rr; if (tok >= 0) uv = U[((size_t)(b * SEQ + tok)) * CCH + ch]; }
        else { if (rr < 30) uv = p.sconv[((size_t)(b * 30 + rr)) * CCH + ch]; else if (rr < 34) uv = U[((size_t)(MP + b * 4 + rr - 30)) * CCH + ch]; }
#pragma unroll
        for (int t = 0; t < 32; ++t) { const int j = rr - t; if (j >= 0 && j <= 30) acc[t] += wgt[j] * uv; }
    }
    LAS float* ct = (LAS float*)lds;
#pragma unroll
    for (int t = 0; t < 32; ++t) ct[t * CCH + ch] = acc[t];
    __syncthreads();
    {
        const int w = tid >> 6, lane = tid & 63;
        bf16_t* AO = (bf16_t*)(p.ws + WS_AO);
        const int ntok = samp ? 4 : 32;
        for (int tt = 0; tt < 4; ++tt) {
            const int t = 4 * w + tt;
            if (t < ntok) {
                float x[8]; float sm = 0.f;
#pragma unroll
                for (int i = 0; i < 8; ++i) { x[i] = ct[t * CCH + lane + 64 * i]; sm += x[i]; }
                const float mean = wave_sum(sm) * (1.0f / CCH); float s2 = 0.f;
#pragma unroll
                for (int i = 0; i < 8; ++i) { x[i] -= mean; s2 += x[i] * x[i]; }
                const float rstd = rsqrtf(wave_sum(s2) * (1.0f / CCH) + LN_EPS);
                const size_t row = samp ? (size_t)MP + b * 4 + t : (size_t)b * SEQ + t0 + t;
#pragma unroll
                for (int i = 0; i < 8; ++i) { const int c = lane + 64 * i; float y = x[i] * rstd * p.cln_g[c] + p.cln_b[c]; y = y * fast_sigmoid(y);
                    AO[row * DM + AW + c] = (bf16_t)(cvt_pk_bf16(y, 0.f) & 0xffffu); }
            }
        }
    }
    __syncthreads();
}

__device__ __forceinline__ void phase_mixers(const Params& p, LAS unsigned char* lds) {
    constexpr int N_AP = 2 * 3 * 4 * 32, N_AS = 8 * 12, N_CV = 256 + 8;
    const int G = gridDim.x;
    attn_prompt_loop(p, lds, N_AP);
    for (int it = (blockIdx.x + N_AS) % G; it < N_AS; it += G) attn_sample_item(p, lds, it);
    if (G > N_AS) { if ((int)((blockIdx.x + N_AS) % G) >= N_AS) cvt_range(p, U_IN + U_OUT, U_IN + U_OUT + U_GU, (int)blockIdx.x * 8 + (threadIdx.x >> 6), (G - N_AS) * 8); }
    else cvt_range(p, U_IN + U_OUT, U_IN + U_OUT + U_GU, (int)blockIdx.x * 8 + (threadIdx.x >> 6), G * 8);
    if constexpr (MIXPROBE == 2) { for (int it = (blockIdx.x + N_AS) % G; it < N_AS; it += G) attn_sample_item(p, lds, it); }

}

__device__ __forceinline__ void phase_alpha(const Params& p) {
    bf16_t* AO = (bf16_t*)(p.ws + WS_AO); const float* LSE = (const float*)(p.ws + WS_LSE);
    const size_t N = (size_t)MT * 12 * 16, S = (size_t)gridDim.x * 512;
    for (size_t i0 = (size_t)blockIdx.x * 512 + threadIdx.x; i0 < N; i0 += 4 * S) {
        float l0[4], l1[4], l2[4]; u32x4 v[4]; u32x4* ptr[4]; int gq[4];
#pragma unroll
        for (int u = 0; u < 4; ++u) {
            const size_t i = i0 + u * S; const bool ok = i < N; const size_t ii = ok ? i : 0;
            const int c = (int)(ii & 15), sl = (int)((ii >> 4) % 12); const size_t row = ii / 192;
            const int hs = sl & 3; gq[u] = ok ? (sl >> 2) : -1;
            l0[u] = LSE[row * 12 + hs]; l1[u] = LSE[row * 12 + 4 + hs]; l2[u] = LSE[row * 12 + 8 + hs];
            ptr[u] = (u32x4*)(AO + row * DM + sl * 128 + c * 8); v[u] = *ptr[u];
        }
#pragma unroll
        for (int u = 0; u < 4; ++u) {
            const float mx = fmaxf(l0[u], fmaxf(l1[u], l2[u]));
            const float e0 = __builtin_amdgcn_exp2f(l0[u] - mx), e1 = __builtin_amdgcn_exp2f(l1[u] - mx), e2 = __builtin_amdgcn_exp2f(l2[u] - mx);
            const float al = (gq[u] == 0 ? e0 : (gq[u] == 1 ? e1 : e2)) / (e0 + e1 + e2);
            u32x4 w = v[u];
#pragma unroll
            for (int k = 0; k < 4; ++k) { const float lo = __uint_as_float(w[k] << 16) * al, hi = __uint_as_float(w[k] & 0xffff0000u) * al; w[k] = cvt_pk_bf16(lo, hi); }
            if (gq[u] >= 0) *ptr[u] = w;
        }
    }
}

__device__ __forceinline__ void phase_ln(const float* src, float* dstf, bf16_t* dstb, const float* gam, const float* bet) {
    const int lane = threadIdx.x & 63, gw = blockIdx.x * 8 + (threadIdx.x >> 6), NW = gridDim.x * 8;
    f32x4 gv[8], bv[8];
#pragma unroll
    for (int j = 0; j < 8; ++j) { gv[j] = *(const f32x4*)(gam + 4 * lane + 256 * j); bv[j] = *(const f32x4*)(bet + 4 * lane + 256 * j); }
    for (int r = gw; r < MT; r += NW) {
        const float* xr = src + (size_t)r * DM + 4 * lane;
        f32x4 v[8]; float sm = 0.f;
#pragma unroll
        for (int j = 0; j < 8; ++j) { v[j] = *(const f32x4*)(xr + 256 * j); sm += (v[j][0] + v[j][1]) + (v[j][2] + v[j][3]); }
        const float mean = wave_sum(sm) * (1.0f / DM); float s2 = 0.f;
#pragma unroll
        for (int j = 0; j < 8; ++j) { v[j] = v[j] - mean; s2 += (v[j][0] * v[j][0] + v[j][1] * v[j][1]) + (v[j][2] * v[j][2] + v[j][3] * v[j][3]); }
        const float rstd = rsqrtf(wave_sum(s2) * (1.0f / DM) + LN_EPS);
#pragma unroll
        for (int j = 0; j < 8; ++j) {
            const f32x4 y = v[j] * rstd * gv[j] + bv[j];
            if (dstf) *(f32x4*)(dstf + (size_t)r * DM + 4 * lane + 256 * j) = y;
            if (dstb) *(u32x2*)(dstb + (size_t)r * DM + 4 * lane + 256 * j) = pack4(y);
        }
    }
}

__device__ __forceinline__ void phase_ln_bf16(bf16_t* X, float* yout, const float* gam, const float* bet) {
    const int lane = threadIdx.x & 63, gw = blockIdx.x * 8 + (threadIdx.x >> 6), NW = gridDim.x * 8;
    for (int r0 = gw; r0 < MT; r0 += 2 * NW) {
        u32x4 q[2][4];
#pragma unroll
        for (int h = 0; h < 2; ++h) { const int r = r0 + h * NW; if (r < MT) {
#pragma unroll
            for (int j = 0; j < 4; ++j) q[h][j] = *(const u32x4*)(X + (size_t)r * DM + 8 * lane + 512 * j); } }
#pragma unroll
        for (int h = 0; h < 2; ++h) {
            const int r = r0 + h * NW;
            if (r < MT) {
                bf16_t* xr = X + (size_t)r * DM + 8 * lane;
                float v[32]; float sm = 0.f;
#pragma unroll
                for (int j = 0; j < 4; ++j)
#pragma unroll
                    for (int k = 0; k < 4; ++k) { v[8 * j + 2 * k] = __uint_as_float(q[h][j][k] << 16); v[8 * j + 2 * k + 1] = __uint_as_float(q[h][j][k] & 0xffff0000u); sm += v[8 * j + 2 * k] + v[8 * j + 2 * k + 1]; }
                const float mean = wave_sum(sm) * (1.0f / DM); float s2 = 0.f;
#pragma unroll
                for (int i = 0; i < 32; ++i) { v[i] -= mean; s2 += v[i] * v[i]; }
                const float rstd = rsqrtf(wave_sum(s2) * (1.0f / DM) + LN_EPS);
#pragma unroll
                for (int j = 0; j < 4; ++j) {
                    const f32x4 g0 = *(const f32x4*)(gam + 8 * lane + 512 * j), g1 = *(const f32x4*)(gam + 8 * lane + 512 * j + 4), b0 = *(const f32x4*)(bet + 8 * lane + 512 * j), b1 = *(const f32x4*)(bet + 8 * lane + 512 * j + 4);
                    f32x4 y0, y1;
#pragma unroll
                    for (int k = 0; k < 4; ++k) { y0[k] = v[8 * j + k] * rstd * g0[k] + b0[k]; y1[k] = v[8 * j + 4 + k] * rstd * g1[k] + b1[k]; }
                    if (yout) { float* yr = yout + (size_t)r * DM + 8 * lane + 512 * j; __builtin_nontemporal_store(y0, (f32x4*)yr); __builtin_nontemporal_store(y1, (f32x4*)(yr + 4)); }
                    else *(u32x4*)(xr + 512 * j) = pack8(y0, y1);
                }
            }
        }
    }
}

constexpr int REP0 = 1, REP2 = 1, REPG = 1, PROBE_NULLGU = 0, REPMASK = 0, NSYNC_PROBE = 0;
template <int MASK>
__global__ void __launch_bounds__(512, 2) fwd_kernel(Params p) {
    extern __shared__ __attribute__((aligned(16))) unsigned char shm[];
    LAS unsigned char* lds = (LAS unsigned char*)shm;
    unsigned char* ws = p.ws;
    __shared__ uint4 xb_words;
    if (threadIdx.x == 0) xb_words = make_uint4(0u, 0u, 0u, 0u);
    __syncthreads();
    const XcdBarrier xb = xcd_barrier_post((unsigned*)(ws + WS_BAR), (volatile LAS unsigned*)&xb_words);
    if (p.out == nullptr) cg::this_grid().sync();
#define GSYNC() xcd_barrier(xb)
#define PH(k) if constexpr ((MASK >> (k)) & 1)
#define SYNC(k) if constexpr (((MASK >> (k)) & 1) && (MASK & ((1 << (k)) - 1))) GSYNC();
    PH(0) for (int rep = 0; rep < REP0; ++rep) { phase_convert(p, lds); if (rep + 1 < REP0) GSYNC(); }
    SYNC(1)
    PH(1) { Gemm g{(const bf16_t*)(ws + WS_XB), (const bf16_t*)(ws + WS_WIN), MPAD, NIN, DM}; StaticOrder S; S.init(MPAD, NIN, gridDim.x, blockIdx.x);
            EpiIn E{(bf16_t*)(ws + WS_Q), (bf16_t*)(ws + WS_K), (bf16_t*)(ws + WS_V), (float*)(ws + WS_U), (const float*)(ws + WS_ROPE), p.out};
            gemm_phase(lds, g, S, E); if constexpr ((REPMASK >> 1) & 1) { GSYNC(); gemm_phase(lds, g, S, E); }
            { const int ntile = (MPAD / 256) * (NIN / 256), G = gridDim.x, full = ntile % G;
              if (full != 0 && (int)blockIdx.x >= full) { const int gw = ((int)blockIdx.x - full) * 8 + (threadIdx.x >> 6), NW = (G - full) * 8;
                  cvt_range(p, U_IN, U_IN + U_OUT, gw, NW); cvt_range(p, U_IN + U_OUT + U_GU, U_IN + U_OUT + U_GU + U_D, gw, NW); }
              else if (full == 0) { const int gw = blockIdx.x * 8 + (threadIdx.x >> 6), NW = G * 8; cvt_range(p, U_IN, U_IN + U_OUT, gw, NW); cvt_range(p, U_IN + U_OUT + U_GU, U_IN + U_OUT + U_GU + U_D, gw, NW); } } }
    SYNC(2)
    PH(2) { phase_mixers(p, lds); if constexpr (REP2 == 2) { GSYNC(); phase_mixers(p, lds); } }
    SYNC(3)
    PH(3) { for (int it = blockIdx.x; it < 256 + 8; it += gridDim.x) conv_item(p, lds, it); phase_alpha(p); }
    SYNC(4)
    PH(4) { skinny_gemm<8, true>(lds, (const bf16_t*)(ws + WS_AO) + (size_t)MP * DM, (const bf16_t*)(ws + WS_WOUT), (const bf16_t*)(ws + WS_XB) + (size_t)MP * DM, (bf16_t*)(ws + WS_Z1) + (size_t)MP * DM);
            Gemm g{(const bf16_t*)(ws + WS_AO), (const bf16_t*)(ws + WS_WOUT), MP, DM, DM}; StaticOrder S; S.init(MP, DM, gridDim.x, blockIdx.x);
            EpiOut E{(const bf16_t*)(ws + WS_XB), (bf16_t*)(ws + WS_Z1)}; gemm_phase(lds, g, S, E); if constexpr ((REPMASK >> 4) & 1) { GSYNC(); gemm_phase(lds, g, S, E); } }
    SYNC(5)
    PH(5) phase_ln_bf16((bf16_t*)(ws + WS_Z1), nullptr, p.ln1_g, p.ln1_b);
    SYNC(6)
    PH(6) { Gemm g{(const bf16_t*)(ws + WS_Z1), (const bf16_t*)(ws + WS_WGU), MPAD, 2 * FH, DM}; StaticOrder S; S.init(MPAD, 2 * FH, gridDim.x, blockIdx.x);
            if constexpr (PROBE_NULLGU) { EpiNull EN{(float*)(ws + WS_LSE)}; gemm_phase(lds, g, S, EN); GSYNC(); }
            EpiGU E{(bf16_t*)(ws + WS_H)}; gemm_phase(lds, g, S, E); if constexpr ((REPMASK >> 6) & 1) { GSYNC(); gemm_phase(lds, g, S, E); }
            { const int ntile = (MPAD / 256) * (2 * FH / 256), G = gridDim.x, full = ntile % G;
              if (full != 0 && (int)blockIdx.x >= full) copy_caches(p, (size_t)((int)blockIdx.x - full) * 512 + threadIdx.x, (size_t)(G - full) * 512);
              else if (full == 0) copy_caches(p, (size_t)blockIdx.x * 512 + threadIdx.x, (size_t)G * 512); } }
    SYNC(7)
    PH(7) { skinny_gemm<22, true>(lds, (const bf16_t*)(ws + WS_H) + (size_t)MP * FH, (const bf16_t*)(ws + WS_WD), (const bf16_t*)(ws + WS_Z1) + (size_t)MP * DM, (bf16_t*)(ws + WS_AO) + (size_t)MP * DM);
            Gemm g{(const bf16_t*)(ws + WS_H), (const bf16_t*)(ws + WS_WD), MP, DM, FH}; StaticOrder S; S.init(MP, DM, gridDim.x, blockIdx.x);
            EpiDown E{(const bf16_t*)(ws + WS_Z1), (bf16_t*)(ws + WS_AO)}; gemm_phase(lds, g, S, E); if constexpr ((REPMASK >> 7) & 1) { GSYNC(); gemm_phase(lds, g, S, E); } }
    SYNC(8)
    PH(8) phase_ln_bf16((bf16_t*)(ws + WS_AO), p.out, p.ln2_g, p.ln2_b);
    if constexpr (NSYNC_PROBE > 0) { for (int i = 0; i < NSYNC_PROBE; ++i) GSYNC(); }
#undef PH
#undef SYNC
}

#ifndef N_LAUNCH_MODE
#define N_LAUNCH_MODE 1
#endif
template <int MASK> static void launch_plain(const Params& p, int grid, hipStream_t stream) {
    static bool attr = false;
    if (!attr) { (void)hipFuncSetAttribute((const void*)fwd_kernel<MASK>, hipFuncAttributeMaxDynamicSharedMemorySize, STAGE_BYTES); attr = true; }
    hipLaunchKernelGGL(fwd_kernel<MASK>, dim3(grid), dim3(512), STAGE_BYTES, stream, p);
}
extern "C" void kernel_launch(void* const* d_in, const int* in_sizes, int n_in, void* d_out, int out_size, void* d_ws, size_t ws_size, hipStream_t stream) {
    static int grid = 0;
    if (grid == 0) {
        if (n_in != 19 || (size_t)out_size != O_END || ws_size < WS_END) { fprintf(stderr, "kernel_launch: unexpected shapes: n_in %d out %d ws %zu (need %zu)\n", n_in, out_size, ws_size, (size_t)WS_END); grid = -1; return; }
        int dev = 0, cus = 0, per_cu = 0;
        (void)hipGetDevice(&dev); (void)hipDeviceGetAttribute(&cus, hipDeviceAttributeMultiprocessorCount, dev);
#if N_LAUNCH_MODE == 1
        if (hipFuncSetAttribute((const void*)fwd_kernel<0x1FF>, hipFuncAttributeMaxDynamicSharedMemorySize, STAGE_BYTES) != hipSuccess) { fprintf(stderr, "kernel_launch: hipFuncSetAttribute failed\n"); grid = -1; return; }
        if (hipOccupancyMaxActiveBlocksPerMultiprocessor(&per_cu, (const void*)fwd_kernel<0x1FF>, 512, STAGE_BYTES) != hipSuccess || per_cu < 1) { fprintf(stderr, "kernel_launch: occupancy query failed (%d)\n", per_cu); (void)hipGetLastError(); }
#endif
        grid = cus;
        fprintf(stderr, "kernel_launch: grid %d (per_cu %d)\n", grid, per_cu);
    }
    if (grid < 0) return;
    Params p{};
    p.xp = (const float*)d_in[0]; p.xs = (const float*)d_in[1]; p.c0 = (const float*)d_in[2]; p.c1 = (const float*)d_in[3]; p.c2 = (const float*)d_in[4]; p.sconv = (const float*)d_in[5];
    p.w_in = (const float*)d_in[6]; p.w_out = (const float*)d_in[7]; p.conv_w = (const float*)d_in[8]; p.conv_b = (const float*)d_in[9]; p.cln_g = (const float*)d_in[10]; p.cln_b = (const float*)d_in[11];
    p.ln1_g = (const float*)d_in[12]; p.ln1_b = (const float*)d_in[13]; p.w_gate = (const float*)d_in[14]; p.w_up = (const float*)d_in[15]; p.w_down = (const float*)d_in[16]; p.ln2_g = (const float*)d_in[17]; p.ln2_b = (const float*)d_in[18];
    p.out = (float*)d_out; p.ws = (unsigned char*)d_ws;
#if N_LAUNCH_MODE == 1
    if (hipMemsetAsync((unsigned char*)d_ws + WS_BAR, 0, 16384, stream) != hipSuccess) { fprintf(stderr, "kernel_launch: memset of the barrier words failed\n"); return; }
    void* args[] = {&p};
    hipError_t e = hipLaunchCooperativeKernel((const void*)fwd_kernel<0x1FF>, dim3(grid), dim3(512), args, STAGE_BYTES, stream);
    if (e != hipSuccess) fprintf(stderr, "cooperative launch failed: %s (grid %d)\n", hipGetErrorString(e), grid);
#else
    launch_plain<1>(p, grid, stream); launch_plain<2>(p, grid, stream); launch_plain<4>(p, grid, stream); launch_plain<8>(p, grid, stream); launch_plain<16>(p, grid, stream);
    launch_plain<32>(p, grid, stream); launch_plain<64>(p, grid, stream); launch_plain<128>(p, grid, stream); launch_plain<256>(p, grid, stream);
#endif
}
```

```cpp
#include <hip/hip_runtime.h>
#include <hip/hip_cooperative_groups.h>
#include <cstdio>
namespace cg = cooperative_groups;

#define LAS __attribute__((address_space(3)))
typedef unsigned short bf16_t;
typedef short bf16x8 __attribute__((ext_vector_type(8)));
typedef short bf16x4 __attribute__((ext_vector_type(4)));
typedef float f32x4 __attribute__((ext_vector_type(4)));
typedef unsigned u32x4 __attribute__((ext_vector_type(4)));
typedef unsigned u32x2 __attribute__((ext_vector_type(2)));

constexpr int DM = 2048, SEQ = 4096, MP = 8192, MS = 32, MT = MP + MS, MPAD = 8448;
constexpr int AW = 1536, CCH = 512, NIN = 5632, FH = 5632;
constexpr float ALPHA = 1.189207115002721f;
constexpr float LN_EPS = 1e-5f;
constexpr float QSCALE = 0.08838834764831845f * 1.4426950408889634f;

constexpr size_t O_KVP0 = (size_t)MT * DM;
constexpr size_t O_KVP1 = O_KVP0 + 2 * 128 * 1024;
constexpr size_t O_KVP2 = O_KVP1 + 2 * 512 * 1024;
constexpr size_t O_CONVP = O_KVP2 + 2 * 2048 * 1024;
constexpr size_t O_KVS0 = O_CONVP + 2 * 30 * 512;
constexpr size_t O_KVS1 = O_KVS0 + 8 * 128 * 1024;
constexpr size_t O_KVS2 = O_KVS1 + 8 * 512 * 1024;
constexpr size_t O_CONVS = O_KVS2 + (size_t)8 * 2048 * 1024;
constexpr size_t O_END = O_CONVS + 8 * 30 * 512;

constexpr size_t WS_WIN = 0;
constexpr size_t WS_WOUT = WS_WIN + (size_t)NIN * DM * 2;
constexpr size_t WS_WGU = WS_WOUT + (size_t)DM * DM * 2;
constexpr size_t WS_WD = WS_WGU + (size_t)2 * FH * DM * 2;
constexpr size_t WS_ROPE = WS_WD + (size_t)DM * FH * 2;
constexpr size_t WS_LSE = WS_ROPE + (size_t)4100 * 64 * 8;
constexpr size_t WS_R1 = WS_LSE + (size_t)MPAD * 12 * 4;
constexpr size_t WS_XB = WS_R1;
constexpr size_t WS_Q = WS_XB + (size_t)MPAD * DM * 2;
constexpr size_t WS_K = WS_Q + (size_t)MPAD * AW * 2;
constexpr size_t WS_V = WS_K + (size_t)MPAD * AW * 2;
constexpr size_t WS_U = WS_V + (size_t)MPAD * AW * 2;
constexpr size_t WS_R1END = WS_U + (size_t)MPAD * CCH * 4;
constexpr size_t WS_H = WS_R1;
constexpr size_t WS_AO = WS_R1END;
constexpr size_t WS_Z1 = WS_AO + (size_t)MPAD * DM * 2;
constexpr size_t WS_BAR = WS_Z1 + (size_t)MPAD * DM * 4;
constexpr size_t WS_END = WS_BAR + 16384;
static_assert((size_t)MPAD * FH * 2 <= WS_R1END - WS_R1, "H alias");

struct Params {
    const float *xp, *xs, *c0, *c1, *c2, *sconv, *w_in, *w_out, *conv_w, *conv_b, *cln_g, *cln_b, *ln1_g, *ln1_b, *w_gate, *w_up, *w_down, *ln2_g, *ln2_b;
    float* out; unsigned char* ws;
};

__device__ __forceinline__ unsigned cvt_pk_bf16(float lo, float hi) { unsigned r; asm volatile("v_cvt_pk_bf16_f32 %0, %1, %2" : "=v"(r) : "v"(lo), "v"(hi)); return r; }
__device__ __forceinline__ float bf2f(unsigned short b) { return __uint_as_float(((unsigned)b) << 16); }
__device__ __forceinline__ u32x2 pack4(f32x4 v) { u32x2 r; r.x = cvt_pk_bf16(v[0], v[1]); r.y = cvt_pk_bf16(v[2], v[3]); return r; }
__device__ __forceinline__ u32x4 pack8(f32x4 a, f32x4 b) { u32x4 r; r.x = cvt_pk_bf16(a[0], a[1]); r.y = cvt_pk_bf16(a[2], a[3]); r.z = cvt_pk_bf16(b[0], b[1]); r.w = cvt_pk_bf16(b[2], b[3]); return r; }
__device__ __forceinline__ float wave_sum(float v) {
#pragma unroll
    for (int o = 1; o < 64; o <<= 1) v += __shfl_xor(v, o);
    return v;
}
__device__ __forceinline__ float wave_max(float v) {
#pragma unroll
    for (int o = 1; o < 64; o <<= 1) v = fmaxf(v, __shfl_xor(v, o));
    return v;
}
__device__ __forceinline__ int perm8(int s) { return 8 * ((s >> 2) & 3) + 4 * ((s >> 4) & 1) + (s & 3); }
__device__ __forceinline__ float fast_sigmoid(float g) { return 1.0f / (1.0f + __expf(-g)); }

#define XB_TMO      128
#define XB_XCNT(j)  (256  + 64 * (j))
#define XB_XSUB(j)  (1280 + 64 * (j))
#define XB_XGEN(j)  (2304 + 64 * (j))
#define XB_TOP      3328
#define XB_TOPGEN   3392
#define XCD_BAR_WORDS 3456
#define XB_SPIN_CAP (1u << 18)
__device__ __forceinline__ unsigned xb_ld(unsigned* p)              { return __hip_atomic_load(p, __ATOMIC_RELAXED, __HIP_MEMORY_SCOPE_AGENT); }
__device__ __forceinline__ unsigned xb_add(unsigned* p, unsigned v) { return __hip_atomic_fetch_add(p, v, __ATOMIC_RELAXED, __HIP_MEMORY_SCOPE_AGENT); }
__device__ __forceinline__ unsigned xb_xcc_id() { return (unsigned)__builtin_amdgcn_s_getreg((3 << 11) | 20) & 0xFu; }
#define XB_SPIN(cond, bar) do { unsigned _sp = 0; while (cond) { __builtin_amdgcn_s_sleep(1); \
    if ((++_sp & 255u) == 0u) { if (xb_ld(&(bar)[XB_TMO])) break; if (_sp > XB_SPIN_CAP) { atomicAdd(&(bar)[XB_TMO], 1u); break; } } } } while (0)
struct XcdBarrier { unsigned* bar; unsigned x; volatile LAS unsigned* st; };
__device__ __forceinline__ XcdBarrier xcd_barrier_post(unsigned* bar, volatile LAS unsigned* st) {
    XcdBarrier b; b.bar = bar; b.x = xb_xcc_id(); b.st = st;
    if (threadIdx.x == 0) (void)xb_add(&bar[XB_XCNT(b.x)], 1u);
    return b;
}
__device__ __forceinline__ void xcd_barrier_complete(unsigned* bar, unsigned x, unsigned& nloc, unsigned& nx) {
    const unsigned G = gridDim.x * gridDim.y * gridDim.z;
    unsigned sum, cnt, mine, sp = 0u;
    for (;;) {
        sum = 0u; cnt = 0u; mine = 0u;
#pragma unroll
        for (unsigned j = 0; j < 16; ++j) { const unsigned c = xb_ld(&bar[XB_XCNT(j)]); sum += c; cnt += (c > 0u) ? 1u : 0u; mine = (j == x) ? c : mine; }
        if (sum == G) break;
        __builtin_amdgcn_s_sleep(1);
        if ((++sp & 255u) == 0u) { if (xb_ld(&bar[XB_TMO])) break; if (sp > XB_SPIN_CAP) { atomicAdd(&bar[XB_TMO], 1u); break; } }
    }
    nloc = mine > 0u ? mine : 1u; nx = cnt > 0u ? cnt : 1u;
}
__device__ __forceinline__ void xcd_barrier(const XcdBarrier& b) {
    asm volatile("s_waitcnt vmcnt(0)" ::: "memory");
    __syncthreads();
    if (threadIdx.x == 0) {
        unsigned* bar = b.bar;
        __builtin_amdgcn_s_waitcnt(0);
        unsigned nloc = b.st[0], nx = b.st[1];
        if (nloc == 0u) { xcd_barrier_complete(bar, b.x, nloc, nx); b.st[0] = nloc; b.st[1] = nx; }
        const unsigned old = xb_add(&bar[XB_XSUB(b.x)], 1u);
        const unsigned gen = old / nloc;
        if (old + 1u == (gen + 1u) * nloc) {
            __builtin_amdgcn_fence(__ATOMIC_RELEASE, "agent");
            asm volatile("s_waitcnt vmcnt(0)" ::: "memory");
            const unsigned og = xb_add(&bar[XB_TOP], 1u);
            const unsigned tg = og / nx;
            if (og + 1u == (tg + 1u) * nx) xb_add(&bar[XB_TOPGEN], 1u);
            else XB_SPIN(xb_ld(&bar[XB_TOPGEN]) == tg, bar);
            __builtin_amdgcn_fence(__ATOMIC_ACQUIRE, "agent");
            xb_add(&bar[XB_XGEN(b.x)], 1u);
            asm volatile("s_waitcnt vmcnt(0)" ::: "memory");
        } else {
            XB_SPIN(xb_ld(&bar[XB_XGEN(b.x)]) == gen, bar);
            __builtin_amdgcn_fence(__ATOMIC_ACQUIRE, "agent");
            asm volatile("s_waitcnt vmcnt(0)" ::: "memory");
        }
    }
    __syncthreads();
}

constexpr int BM = 256, BK = 64, HALF = 128, HTB = HALF * BK * 2, STAGE_BYTES = 8 * HTB, NXCD = 8, WGM = 4;
__device__ __forceinline__ int lds_byte(int r, int c) { const int st = (r >> 4) * 2 + (c >> 5), rr = r & 15, cc = c & 31, ob = rr * 64 + cc * 2; return st * 1024 + (ob ^ (((ob >> 9) & 1) << 5)); }
__device__ __forceinline__ void stage_rc(int b, int& R, int& C) { const int st = b / 1024, sb = b % 1024, swz = sb ^ (((sb >> 9) & 1) << 5); R = (st >> 1) * 16 + swz / 64; C = (st & 1) * 32 + (swz % 64) / 2; }
struct Unit { int pm, pn; };
struct Gemm { const bf16_t* A; const bf16_t* Bt; int M, N, K; };
struct StaticOrder {
    int nM, nN, nwg, G, c;
    __device__ void init(int M, int N, int G_, int c_) { nM = M / BM; nN = N / BM; nwg = nM * nN; G = G_; c = c_; }
    __device__ bool next(int i, Unit& u) const {
        const long L = (long)i * G + c; if (L >= nwg) return false;
        int wgid = (int)L; { const int q = nwg / NXCD, r = nwg % NXCD, xcd = wgid % NXCD, off = wgid / NXCD; wgid = (xcd < r ? xcd * (q + 1) : r * (q + 1) + (xcd - r) * q) + off; }
        const int nig = WGM * nN, gid = wgid / nig, fm = gid * WGM, gsz = (nM - fm) < WGM ? (nM - fm) : WGM;
        u.pm = fm + ((wgid % nig) % gsz); u.pn = (wgid % nig) / gsz; return true;
    }
};

template <class Epi>
__device__ __forceinline__ void gemm_phase(LAS unsigned char* lds, const Gemm g, const StaticOrder& S, const Epi& E) {
    int tid = threadIdx.x; asm volatile("" : "+v"(tid));
    const int wid = __builtin_amdgcn_readfirstlane(tid >> 6), lane = tid & 63, wr = wid >> 2, wc = wid & 3, fr = lane & 15, fq = lane >> 4;
    const int K = g.K, nt = K / BK;
    unsigned voffA[2];
#pragma unroll
    for (int i = 0; i < 2; ++i) { int R, C; stage_rc(tid * 16 + i * 8192, R, C); voffA[i] = (unsigned)(R * K + C) * 2u; }
    const size_t kstep = (size_t)(BK * 2);
    const size_t hstep = (size_t)HALF * K * 2;
    const size_t tstep = 2 * hstep;
    const unsigned ldsw = (unsigned)wid * 1024u;
    const int aoff = lds_byte(wr * 64 + fr, fq * 8), boff = lds_byte(wc * 32 + fr, fq * 8);
#define PG8_SA(b, h) (((b) * 2 + (h)) * HTB)
#define PG8_SB(b, h) ((4 + (b) * 2 + (h)) * HTB)
#define PG8_STAGE(bufoff, gbase, voff) do { _Pragma("unroll") for (int _i = 0; _i < 2; ++_i) \
        __builtin_amdgcn_global_load_lds((const unsigned*)((const char*)(gbase) + (voff)[_i]), (LAS unsigned*)(lds + (bufoff) + ldsw + _i * 8192), 16, 0, 0); } while (0)
#define PG8_LDA(dst, b, h) do { _Pragma("unroll") for (int m = 0; m < 4; ++m) _Pragma("unroll") for (int k = 0; k < 2; ++k) dst[m][k] = *(const LAS bf16x8*)(lds + PG8_SA(b, h) + aoff + m * 2048 + k * 1024); } while (0)
#define PG8_LDB(dst, b, h) do { _Pragma("unroll") for (int n = 0; n < 2; ++n) _Pragma("unroll") for (int k = 0; k < 2; ++k) dst[n][k] = *(const LAS bf16x8*)(lds + PG8_SB(b, h) + boff + n * 2048 + k * 1024); } while (0)
#define PG8_MMA(ai, bj, At, Bt) do { __builtin_amdgcn_s_setprio(1); _Pragma("unroll") for (int m = 0; m < 4; ++m) _Pragma("unroll") for (int n = 0; n < 2; ++n) _Pragma("unroll") for (int k = 0; k < 2; ++k) \
        acc[ai][bj][m][n] = __builtin_amdgcn_mfma_f32_16x16x32_bf16(Bt[n][k], At[m][k], acc[ai][bj][m][n], 0, 0, 0); __builtin_amdgcn_s_setprio(0); } while (0)
#define PG8_WAIT_V(n) asm volatile("s_waitcnt vmcnt(" #n ")" ::: "memory")
#define PG8_WAIT_L(n) asm volatile("s_waitcnt lgkmcnt(" #n ")" ::: "memory")
#define PG8_BAR __builtin_amdgcn_s_barrier()
#define PG8_SCHED __builtin_amdgcn_sched_barrier(0)
    Unit cur, nxt; int ui = 0;
    if (!S.next(0, cur)) return;
    f32x4 acc[2][2][4][2];
#pragma unroll
    for (int a = 0; a < 2; ++a)
#pragma unroll
        for (int b = 0; b < 2; ++b)
#pragma unroll
            for (int m = 0; m < 4; ++m)
#pragma unroll
                for (int n = 0; n < 2; ++n) acc[a][b][m][n] = (f32x4){0.f, 0.f, 0.f, 0.f};
    bf16x8 At[4][2], B0[2][2], B1[2][2];
    const char* cA = (const char*)g.A + (size_t)cur.pm * tstep; const char* cB = (const char*)g.Bt + (size_t)cur.pn * tstep;
    PG8_STAGE(PG8_SB(0, 0), cB, voffA); PG8_STAGE(PG8_SA(0, 0), cA, voffA); PG8_STAGE(PG8_SB(0, 1), cB + hstep, voffA); PG8_STAGE(PG8_SA(0, 1), cA + hstep, voffA);
    if (wr == 1) PG8_BAR;
    PG8_WAIT_V(4); PG8_BAR;
    PG8_STAGE(PG8_SB(1, 0), cB + kstep, voffA); PG8_STAGE(PG8_SA(1, 0), cA + kstep, voffA); PG8_STAGE(PG8_SB(1, 1), cB + hstep + kstep, voffA);
    PG8_WAIT_V(6); PG8_BAR;
    for (;;) {
        const bool has_next = S.next(ui + 1, nxt);
        const char* nA = has_next ? (const char*)g.A + (size_t)nxt.pm * tstep : cA; const char* nB = has_next ? (const char*)g.Bt + (size_t)nxt.pn * tstep : cB;
        for (int t = 0; t < nt; t += 2) {
            const bool last = (t == nt - 2);
            const char* a1 = cA + (size_t)(t + 1) * kstep;
            const char* a2 = last ? nA : cA + (size_t)(t + 2) * kstep; const char* b2 = last ? nB : cB + (size_t)(t + 2) * kstep;
            const char* a3 = a2 + kstep; const char* b3 = b2 + kstep;
            PG8_LDB(B0, 0, 0); PG8_SCHED; PG8_LDA(At, 0, 0); PG8_STAGE(PG8_SA(1, 1), a1 + hstep, voffA);
            PG8_WAIT_L(8); PG8_BAR; PG8_WAIT_L(0); PG8_MMA(0, 0, At, B0); PG8_BAR; PG8_SCHED;
            PG8_LDB(B1, 0, 1); PG8_STAGE(PG8_SB(0, 0), b2, voffA);
            PG8_BAR; PG8_WAIT_L(0); PG8_MMA(0, 1, At, B1); PG8_BAR;
            PG8_LDA(At, 0, 1); PG8_STAGE(PG8_SA(0, 0), a2, voffA);
            PG8_BAR; PG8_WAIT_L(0); PG8_MMA(1, 0, At, B0); PG8_BAR; PG8_SCHED;
            PG8_STAGE(PG8_SB(0, 1), b2 + hstep, voffA);
            PG8_WAIT_V(6); PG8_BAR; PG8_MMA(1, 1, At, B1); PG8_BAR;
            PG8_LDB(B0, 1, 0); PG8_SCHED; PG8_LDA(At, 1, 0); PG8_STAGE(PG8_SA(0, 1), a2 + hstep, voffA);
            PG8_WAIT_L(8); PG8_BAR; PG8_WAIT_L(0); PG8_MMA(0, 0, At, B0); PG8_BAR; PG8_SCHED;
            PG8_LDB(B1, 1, 1); PG8_STAGE(PG8_SB(1, 0), b3, voffA);
            PG8_BAR; PG8_WAIT_L(0); PG8_MMA(0, 1, At, B1); PG8_BAR;
            PG8_LDA(At, 1, 1); PG8_STAGE(PG8_SA(1, 0), a3, voffA);
            PG8_BAR; PG8_WAIT_L(0); PG8_MMA(1, 0, At, B0); PG8_BAR; PG8_SCHED;
            PG8_STAGE(PG8_SB(1, 1), b3 + hstep, voffA);
            PG8_WAIT_V(6); PG8_BAR; PG8_MMA(1, 1, At, B1); PG8_BAR;
        }
        E(acc, cur, wr, wc, fr, fq);
        if (!has_next) break;
#pragma unroll
        for (int a = 0; a < 2; ++a)
#pragma unroll
            for (int b = 0; b < 2; ++b)
#pragma unroll
                for (int m = 0; m < 4; ++m)
#pragma unroll
                    for (int n = 0; n < 2; ++n) acc[a][b][m][n] = (f32x4){0.f, 0.f, 0.f, 0.f};
        cur = nxt; cA = nA; cB = nB; ++ui;
    }
    PG8_WAIT_V(0);
    if (wr == 0) PG8_BAR;
    PG8_BAR;
#undef PG8_SA
#undef PG8_SB
#undef PG8_STAGE
#undef PG8_LDA
#undef PG8_LDB
#undef PG8_MMA
#undef PG8_WAIT_V
#undef PG8_WAIT_L
#undef PG8_BAR
#undef PG8_SCHED
}

__device__ __forceinline__ float* kv_out_ptr(float* out, int r, int gi, bool& ok) {
    const int keep = 128 << (2 * gi);
    ok = false;
    if (r < MP) {
        const int b = r >> 12, t = r & 4095;
        if (t < SEQ - keep) return out;
        ok = true;
        const size_t base = gi == 0 ? O_KVP0 : (gi == 1 ? O_KVP1 : O_KVP2);
        return out + base + ((size_t)(b * keep + t - (SEQ - keep))) * 1024;
    }
    if (r < MT) {
        const int b = (r - MP) >> 2, t = (r - MP) & 3;
        ok = true;
        const size_t base = gi == 0 ? O_KVS0 : (gi == 1 ? O_KVS1 : O_KVS2);
        return out + base + ((size_t)(b * keep + keep - 4 + t)) * 1024;
    }
    return out;
}

struct EpiIn {
    bf16_t *Qb, *Kb, *Vb; float* U; const float* rope; float* out;
    __device__ __forceinline__ void operator()(const f32x4 (&acc)[2][2][4][2], const Unit& u, int wr, int wc, int fr, int fq) const {
        const int pn = u.pn;
        const int rbase = u.pm * 256 + wr * 64 + fr;
        if (pn < 12) {
            const int col = 16 * wc + 4 * fq;
#pragma unroll
            for (int ai = 0; ai < 2; ++ai) {
                f32x4 cs[4][2];
#pragma unroll
                for (int m = 0; m < 4; ++m) {
                    const int r = rbase + ai * 128 + m * 16;
                    const int pidx = r < MP ? (r & 4095) : (r < MT ? 4096 + ((r - MP) & 3) : 0);
                    const f32x4* rp = (const f32x4*)(rope + ((size_t)pidx * 64 + 16 * wc + 4 * fq) * 2);
                    cs[m][0] = rp[0]; cs[m][1] = rp[1];
                }
#pragma unroll
                for (int m = 0; m < 4; ++m) {
                    const int r = rbase + ai * 128 + m * 16;
                    const f32x4 cs0 = cs[m][0], cs1 = cs[m][1];
                    const f32x4 c = {cs0[0], cs0[2], cs1[0], cs1[2]}, sn = {cs0[1], cs0[3], cs1[1], cs1[3]};
#pragma unroll
                    for (int bj = 0; bj < 2; ++bj) {
                        const f32x4 x1 = acc[ai][bj][m][0], x2 = acc[ai][bj][m][1];
                        f32x4 o1 = x1 * c - x2 * sn, o2 = x2 * c + x1 * sn;
                        const int hq = 2 * pn + bj;
                        if (pn < 6) {
                            o1 = o1 * QSCALE; o2 = o2 * QSCALE;
                            bf16_t* dst = Qb + (size_t)r * AW + hq * 128 + col;
                            *(u32x2*)dst = pack4(o1); *(u32x2*)(dst + 64) = pack4(o2);
                        } else {
                            const int hk = hq - 12;
                            bf16_t* dst = Kb + (size_t)r * AW + hk * 128 + col;
                            *(u32x2*)dst = pack4(o1); *(u32x2*)(dst + 64) = pack4(o2);
                            bool ok; float* o = kv_out_ptr(out, r, hk >> 2, ok);
                            if (ok) { o += (hk & 3) * 128 + col; *(f32x4*)o = o1; *(f32x4*)(o + 64) = o2; }
                        }
                    }
                }
            }
        } else if (pn < 18) {
            const int col = 32 * wc + 8 * fq;
#pragma unroll
            for (int ai = 0; ai < 2; ++ai)
#pragma unroll
                for (int m = 0; m < 4; ++m) {
                    const int r = rbase + ai * 128 + m * 16;
#pragma unroll
                    for (int bj = 0; bj < 2; ++bj) {
                        const int hv = 2 * (pn - 12) + bj;
                        const f32x4 v0 = acc[ai][bj][m][0], v1 = acc[ai][bj][m][1];
                        *(u32x4*)(Vb + (size_t)r * AW + hv * 128 + col) = pack8(v0, v1);
                        bool ok; float* o = kv_out_ptr(out, r, hv >> 2, ok);
                        if (ok) { o += 512 + (hv & 3) * 128 + col; *(f32x4*)o = v0; *(f32x4*)(o + 4) = v1; }
                    }
                }
        } else {
            const int ch = 128 * (pn - 18) + 32 * wc + 8 * fq;
#pragma unroll
            for (int ai = 0; ai < 2; ++ai)
#pragma unroll
                for (int m = 0; m < 4; ++m) {
                    const int r = rbase + ai * 128 + m * 16;
                    f32x4 u0, u1;
#pragma unroll
                    for (int e = 0; e < 4; ++e) { u0[e] = acc[ai][0][m][0][e] * fast_sigmoid(acc[ai][1][m][0][e]); u1[e] = acc[ai][0][m][1][e] * fast_sigmoid(acc[ai][1][m][1][e]); }
                    float* up = U + (size_t)r * CCH + ch;
                    *(f32x4*)up = u0; *(f32x4*)(up + 4) = u1;
                    float* o = nullptr;
                    if (r < MP) { const int b = r >> 12, t = r & 4095; if (t >= SEQ - 30) o = out + O_CONVP + ((size_t)(b * 30 + t - (SEQ - 30))) * CCH + ch; }
                    else if (r < MT) { const int b = (r - MP) >> 2, t = (r - MP) & 3; o = out + O_CONVS + ((size_t)(b * 30 + 26 + t)) * CCH + ch; }
                    if (o) { *(f32x4*)o = u0; *(f32x4*)(o + 4) = u1; }
                }
        }
    }
};
struct EpiOut {
    const bf16_t* Xb; bf16_t* Z;
    __device__ __forceinline__ void operator()(const f32x4 (&acc)[2][2][4][2], const Unit& u, int wr, int wc, int fr, int fq) const {
#pragma unroll
        for (int ai = 0; ai < 2; ++ai)
#pragma unroll
            for (int m = 0; m < 4; ++m) {
                const int r = u.pm * 256 + ai * 128 + wr * 64 + m * 16 + fr;
#pragma unroll
                for (int bj = 0; bj < 2; ++bj) {
                    const size_t o = (size_t)r * DM + u.pn * 256 + bj * 128 + wc * 32 + 8 * fq;
                    const u32x4 xv = *(const u32x4*)(Xb + o);
                    f32x4 z0, z1;
#pragma unroll
                    for (int k = 0; k < 2; ++k) { z0[2 * k] = __uint_as_float(xv[k] << 16); z0[2 * k + 1] = __uint_as_float(xv[k] & 0xffff0000u); z1[2 * k] = __uint_as_float(xv[2 + k] << 16); z1[2 * k + 1] = __uint_as_float(xv[2 + k] & 0xffff0000u); }
                    *(u32x4*)(Z + o) = pack8(z0 * ALPHA + acc[ai][bj][m][0], z1 * ALPHA + acc[ai][bj][m][1]);
                }
            }
    }
};
struct EpiGU {
    bf16_t* H;
    __device__ __forceinline__ void operator()(const f32x4 (&acc)[2][2][4][2], const Unit& u, int wr, int wc, int fr, int fq) const {
#pragma unroll
        for (int ai = 0; ai < 2; ++ai)
#pragma unroll
            for (int m = 0; m < 4; ++m) {
                const int r = u.pm * 256 + ai * 128 + wr * 64 + m * 16 + fr;
                const int col = 128 * u.pn + 32 * wc + 8 * fq;
                f32x4 h0, h1;
#pragma unroll
                for (int e = 0; e < 4; ++e) {
                    const float g0 = acc[ai][0][m][0][e], g1 = acc[ai][0][m][1][e];
                    h0[e] = g0 * fast_sigmoid(g0) * acc[ai][1][m][0][e]; h1[e] = g1 * fast_sigmoid(g1) * acc[ai][1][m][1][e];
                }
                *(u32x4*)(H + (size_t)r * FH + col) = pack8(h0, h1);
            }
    }
};
struct EpiNull {
    float* Z;
    __device__ __forceinline__ void operator()(const f32x4 (&acc)[2][2][4][2], const Unit& u, int wr, int wc, int fr, int fq) const {
        float s = 0.f;
#pragma unroll
        for (int ai = 0; ai < 2; ++ai)
#pragma unroll
            for (int bj = 0; bj < 2; ++bj)
#pragma unroll
                for (int m = 0; m < 4; ++m)
#pragma unroll
                    for (int n = 0; n < 2; ++n) s += acc[ai][bj][m][n][0] + acc[ai][bj][m][n][1] + acc[ai][bj][m][n][2] + acc[ai][bj][m][n][3];
        if (s != s) Z[threadIdx.x] = s;
    }
};
struct EpiDown {
    const bf16_t* X1; bf16_t* Z;
    __device__ __forceinline__ void operator()(const f32x4 (&acc)[2][2][4][2], const Unit& u, int wr, int wc, int fr, int fq) const {
#pragma unroll
        for (int ai = 0; ai < 2; ++ai)
#pragma unroll
            for (int m = 0; m < 4; ++m) {
                const int r = u.pm * 256 + ai * 128 + wr * 64 + m * 16 + fr;
#pragma unroll
                for (int bj = 0; bj < 2; ++bj) {
                    const size_t o = (size_t)r * DM + u.pn * 256 + bj * 128 + wc * 32 + 8 * fq;
                    const u32x4 xv = *(const u32x4*)(X1 + o);
                    f32x4 z0, z1;
#pragma unroll
                    for (int k = 0; k < 2; ++k) { z0[2 * k] = __uint_as_float(xv[k] << 16); z0[2 * k + 1] = __uint_as_float(xv[k] & 0xffff0000u); z1[2 * k] = __uint_as_float(xv[2 + k] << 16); z1[2 * k + 1] = __uint_as_float(xv[2 + k] & 0xffff0000u); }
                    *(u32x4*)(Z + o) = pack8(z0 * ALPHA + acc[ai][bj][m][0], z1 * ALPHA + acc[ai][bj][m][1]);
                }
            }
    }
};

template <int KSTEPS, bool DST_BF16>
__device__ __forceinline__ void skinny_gemm(LAS unsigned char* lds, const bf16_t* A, const bf16_t* Bt, const bf16_t* resid, void* dst) {
    constexpr int K = 8 * 32 * KSTEPS;
    const int tid = threadIdx.x, w = tid >> 6, lane = tid & 63, fr = lane & 15, fq = lane >> 4;
    for (int item = blockIdx.x; item < 256; item += gridDim.x) {
        const int rh = item & 1, cb = item >> 1;
        const bf16_t* ap = A + (size_t)(rh * 16 + fr) * K + w * (32 * KSTEPS) + 8 * fq;
        const bf16_t* bp = Bt + (size_t)(cb * 16 + fr) * K + w * (32 * KSTEPS) + 8 * fq;
        f32x4 acc = {0.f, 0.f, 0.f, 0.f};
#pragma unroll (KSTEPS > 11 ? 11 : KSTEPS)
        for (int s = 0; s < KSTEPS; ++s) { const bf16x8 a = *(const bf16x8*)(ap + 32 * s), bb = *(const bf16x8*)(bp + 32 * s); acc = __builtin_amdgcn_mfma_f32_16x16x32_bf16(bb, a, acc, 0, 0, 0); }
        *(LAS f32x4*)(lds + (w * 64 + lane) * 16) = acc;
        __syncthreads();
        if (w == 0) {
            f32x4 sum = *(const LAS f32x4*)(lds + lane * 16);
#pragma unroll
            for (int ww = 1; ww < 8; ++ww) sum = sum + *(const LAS f32x4*)(lds + (ww * 64 + lane) * 16);
            const int slot = cb * 16 + 4 * fq, col = (slot & ~31) + perm8(slot & 31);
            const size_t o = (size_t)(rh * 16 + fr) * DM + col;
            const u32x2 xv = *(const u32x2*)(resid + o);
            f32x4 z; z[0] = __uint_as_float(xv[0] << 16); z[1] = __uint_as_float(xv[0] & 0xffff0000u); z[2] = __uint_as_float(xv[1] << 16); z[3] = __uint_as_float(xv[1] & 0xffff0000u);
            z = z * ALPHA + sum;
            if (DST_BF16) *(u32x2*)((bf16_t*)dst + o) = pack4(z); else *(f32x4*)((float*)dst + o) = z;
        }
        __syncthreads();
    }
}

__device__ __forceinline__ int src_col_in(int np) {
    const int pn = np >> 8, bj = (np >> 7) & 1, s = np & 127;
    if (pn < 12) { const int wc = s >> 5, n = (s >> 4) & 1, q4 = s & 15; return (2 * pn + bj) * 128 + 64 * n + 16 * wc + q4; }
    if (pn < 18) return (2 * pn + bj) * 128 + (s & ~31) + perm8(s & 31);
    return (bj ? 5120 : 4608) + 128 * (pn - 18) + (s & ~31) + perm8(s & 31);
}
struct CvtDesc { const float* src; size_t ldw; bf16_t* dst; size_t K; };
constexpr int NB_IN = NIN / 32, NB_OUT = DM / 32, NB_GU = 2 * FH / 32, NB_D = DM / 32;
constexpr int U_IN = NB_IN * (DM / 64), U_OUT = NB_OUT * (DM / 64), U_GU = NB_GU * (DM / 64), U_D = NB_D * (FH / 64);
__device__ __forceinline__ CvtDesc cvt_decode(const Params& p, int it) {
    unsigned char* ws = p.ws;
    const int lane = threadIdx.x & 63, grp = lane >> 3, oct = lane & 7;
    const float* W; int ldw, K, srccol, np, k0; bf16_t* Bt;
    int r = it;
    if (r < U_IN) { const int nb = r % NB_IN, kb = r / NB_IN; np = nb * 32 + 4 * grp; k0 = kb * 64; W = p.w_in; ldw = NIN; K = DM; srccol = src_col_in(np); Bt = (bf16_t*)(ws + WS_WIN); }
    else if ((r -= U_IN) < U_OUT) { const int nb = r % NB_OUT, kb = r / NB_OUT; np = nb * 32 + 4 * grp; k0 = kb * 64; W = p.w_out; ldw = DM; K = DM; srccol = (np & ~31) + perm8(np & 31); Bt = (bf16_t*)(ws + WS_WOUT); }
    else if ((r -= U_OUT) < U_GU) { const int nb = r % NB_GU, kb = r / NB_GU; np = nb * 32 + 4 * grp; k0 = kb * 64; const int pn = np >> 8, bj = (np >> 7) & 1, sl = np & 127;
        W = bj ? p.w_up : p.w_gate; ldw = FH; K = DM; srccol = 128 * pn + (sl & ~31) + perm8(sl & 31); Bt = (bf16_t*)(ws + WS_WGU); }
    else { r -= U_GU; const int nb = r % NB_D, kb = r / NB_D; np = nb * 32 + 4 * grp; k0 = kb * 64; W = p.w_down; ldw = DM; K = FH; srccol = (np & ~31) + perm8(np & 31); Bt = (bf16_t*)(ws + WS_WD); }
    CvtDesc d; d.src = W + (size_t)(k0 + 8 * oct) * ldw + srccol; d.ldw = (size_t)ldw; d.dst = Bt + (size_t)np * K + k0 + 8 * oct; d.K = (size_t)K; return d;
}
__device__ __forceinline__ void cvt_store(const CvtDesc& d, const f32x4 (&v)[8]) {
#pragma unroll
    for (int e = 0; e < 4; ++e) {
        u32x4 o; o.x = cvt_pk_bf16(v[0][e], v[1][e]); o.y = cvt_pk_bf16(v[2][e], v[3][e]); o.z = cvt_pk_bf16(v[4][e], v[5][e]); o.w = cvt_pk_bf16(v[6][e], v[7][e]);
        *(u32x4*)(d.dst + (size_t)e * d.K) = o;
    }
}
__device__ __forceinline__ void cvt_range(const Params& p, int u0, int u1, int gw, int NW) {
    for (int it = u0 + gw; it < u1; it += 2 * NW) {
        const bool two = it + NW < u1;
        const CvtDesc d0 = cvt_decode(p, it), d1 = cvt_decode(p, two ? it + NW : it);
        f32x4 v0[8], v1[8];
#pragma unroll
        for (int j = 0; j < 8; ++j) v0[j] = __builtin_nontemporal_load((const f32x4*)(d0.src + (size_t)j * d0.ldw));
        if (two) {
#pragma unroll
            for (int j = 0; j < 8; ++j) v1[j] = __builtin_nontemporal_load((const f32x4*)(d1.src + (size_t)j * d1.ldw));
        }
        cvt_store(d0, v0);
        if (two) cvt_store(d1, v1);
    }
}
__device__ __forceinline__ void copy_rows(const f32x4* src, f32x4* dst, size_t per_b, size_t bstride, size_t soff, size_t gt, size_t gs) {
    const size_t n = 8 * per_b;
    for (size_t i0 = gt; i0 < n; i0 += 8 * gs) {
        f32x4 v[8];
#pragma unroll
        for (int u = 0; u < 8; ++u) { const size_t i = i0 + (size_t)u * gs; if (i < n) { const size_t b = i / per_b, o = i - b * per_b; v[u] = __builtin_nontemporal_load(src + b * bstride + soff + o); } }
#pragma unroll
        for (int u = 0; u < 8; ++u) { const size_t i = i0 + (size_t)u * gs; if (i < n) { const size_t b = i / per_b, o = i - b * per_b; __builtin_nontemporal_store(v[u], dst + b * bstride + o); } }
    }
}
__device__ __forceinline__ void copy_caches(const Params& p, size_t gt, size_t gs) {
    copy_rows((const f32x4*)p.c2, (f32x4*)(p.out + O_KVS2), (size_t)(2048 - 4) * 256, (size_t)2048 * 256, 4 * 256, gt, gs);
    copy_rows((const f32x4*)p.c1, (f32x4*)(p.out + O_KVS1), (size_t)(512 - 4) * 256, (size_t)512 * 256, 4 * 256, gt, gs);
    copy_rows((const f32x4*)p.c0, (f32x4*)(p.out + O_KVS0), (size_t)(128 - 4) * 256, (size_t)128 * 256, 4 * 256, gt, gs);
    copy_rows((const f32x4*)p.sconv, (f32x4*)(p.out + O_CONVS), (size_t)26 * 128, (size_t)30 * 128, 4 * 128, gt, gs);
}
__device__ __forceinline__ void phase_convert(const Params& p, LAS unsigned char* lds) {
    const int tid = threadIdx.x, G = gridDim.x, bid = blockIdx.x;
    unsigned char* ws = p.ws;
    { bf16_t* Xb = (bf16_t*)(ws + WS_XB);
      const size_t N = (size_t)MT * DM / 8, S = (size_t)G * 512;
      for (size_t i0 = (size_t)bid * 512 + tid; i0 < N; i0 += 4 * S) {
          f32x4 a[4], b[4];
#pragma unroll
          for (int u = 0; u < 4; ++u) { const size_t i = i0 + u * S; if (i < N) { const size_t e = i * 8; const float* src = e < (size_t)MP * DM ? p.xp + e : p.xs + (e - (size_t)MP * DM);
              a[u] = __builtin_nontemporal_load((const f32x4*)src); b[u] = __builtin_nontemporal_load((const f32x4*)(src + 4)); } }
#pragma unroll
          for (int u = 0; u < 4; ++u) { const size_t i = i0 + u * S; if (i < N) *(u32x4*)(Xb + i * 8) = pack8(a[u], b[u]); }
      } }
    { float* rope = (float*)(ws + WS_ROPE);
      for (int i = bid * 512 + tid; i < 4100 * 64; i += G * 512) {
          const int pr = i >> 6, k = i & 63; const double pos = pr < 4096 ? (double)pr : (double)(16384 + pr - 4096);
          const double inv = exp2(-(double)k * (13.287712379549449 / 64.0));
          double sn, cs; sincos(pos * inv, &sn, &cs);
          rope[2 * i] = (float)cs; rope[2 * i + 1] = (float)sn; } }
    { const int gw = bid * 8 + (tid >> 6), NW = G * 8;
      cvt_range(p, 0, U_IN, gw, NW); }
}

constexpr int MIXPROBE = 0;
__device__ __forceinline__ unsigned off_b(unsigned row, unsigned ch) { return 256u * row + 16u * (ch ^ (((row & 3) << 2) | ((row >> 2) & 3))); }

struct APItem { int b, d, rcls, n, head; };
__device__ __forceinline__ APItem ap_decode(int item) {
    APItem I; const int blk = item & 31, hs = (item >> 5) & 3, g = (item >> 7) % 3; I.b = item / 384;
    const int dsh = 2 * g; I.d = 1 << dsh; I.rcls = blk & (I.d - 1); I.n = blk >> dsh; I.head = g * 4 + hs; return I;
}
__device__ __forceinline__ void ap_load(const Params& p, const APItem& I, u32x4 (&kv)[8], u32x4 (&vv)[8]) {
    const int tid = threadIdx.x, ch = tid & 15, r0 = tid >> 4;
    const bf16_t* Kb = (const bf16_t*)(p.ws + WS_K); const bf16_t* Vb = (const bf16_t*)(p.ws + WS_V);
#pragma unroll
    for (int i = 0; i < 8; ++i) {
        const int row = r0 + 32 * i, j = 128 * (I.n - 1) + row;
        kv[i] = (u32x4){0u, 0u, 0u, 0u}; vv[i] = kv[i];
        if (j >= 0) { const size_t gi = ((size_t)(I.b * SEQ + j * I.d + I.rcls)) * AW + I.head * 128 + ch * 8; kv[i] = *(const u32x4*)(Kb + gi); vv[i] = *(const u32x4*)(Vb + gi); }
    }
}
__device__ __forceinline__ void attn_prompt_loop(const Params& p, LAS unsigned char* lds, int n_items) {
    const int tid = threadIdx.x, w = tid >> 6, lane = tid & 63, fr = lane & 15, fq = lane >> 4, G = gridDim.x;
    bf16_t* AO = (bf16_t*)(p.ws + WS_AO); float* LSE = (float*)(p.ws + WS_LSE);
    const bool xl = (G == 256);
    int rho = 0;
    int it = xl ? ((int)(blockIdx.x & 7)) * 32 + (int)(blockIdx.x >> 3) : (int)blockIdx.x;
    if (it >= n_items) return;
    u32x4 kv[8], vv[8];
    APItem I = ap_decode(it);
    ap_load(p, I, kv, vv);
    const bf16_t* Qb = (const bf16_t*)(p.ws + WS_Q);
    for (;;) {
        {
            const int ch = tid & 15, r0 = tid >> 4;
#pragma unroll
            for (int i = 0; i < 8; ++i) { const int row = r0 + 32 * i; *(LAS u32x4*)(lds + off_b(row, ch)) = kv[i]; *(LAS u32x4*)(lds + 65536 + off_b(row, ch)) = vv[i]; }
        }
        const APItem C = I;
        const int qi = 16 * w + fr;
        const size_t qrow = (size_t)(C.b * SEQ + (128 * C.n + qi) * C.d + C.rcls);
        bf16x8 qf[4];
#pragma unroll
        for (int ks = 0; ks < 4; ++ks) qf[ks] = *(const bf16x8*)(Qb + qrow * AW + C.head * 128 + 32 * ks + 8 * fq);
        __syncthreads();
        ++rho;
        const int nit = xl ? (rho * 8 + (int)(blockIdx.x & 7)) * 32 + (int)(blockIdx.x >> 3) : it + G; const bool more = nit < n_items;
        if (more) { I = ap_decode(nit); ap_load(p, I, kv, vv); }
        f32x4 s[9];
#pragma unroll
        for (int tt = 0; tt < 9; ++tt) {
            const int T = w + tt; s[tt] = (f32x4){0.f, 0.f, 0.f, 0.f};
#pragma unroll
            for (int ks = 0; ks < 4; ++ks) { const bf16x8 kf = *(const LAS bf16x8*)(lds + off_b(16 * T + fr, 4 * ks + fq)); s[tt] = __builtin_amdgcn_mfma_f32_16x16x32_bf16(kf, qf[ks], s[tt], 0, 0, 0); }
        }
        const int kmin = C.n == 0 ? 128 : 0;
        float mx = -3.0e38f;
#pragma unroll
        for (int tt = 0; tt < 9; ++tt)
#pragma unroll
            for (int e = 0; e < 4; ++e) { const int kk = 16 * (w + tt) + 4 * fq + e; const bool ok = kk >= qi && kk <= qi + 128 && kk >= kmin; s[tt][e] = ok ? s[tt][e] : -3.0e38f; mx = fmaxf(mx, s[tt][e]); }
        mx = fmaxf(mx, __shfl_xor(mx, 16)); mx = fmaxf(mx, __shfl_xor(mx, 32));
        float den = 0.f;
#pragma unroll
        for (int tt = 0; tt < 9; ++tt)
#pragma unroll
            for (int e = 0; e < 4; ++e) { const float pv = __builtin_amdgcn_exp2f(s[tt][e] - mx); s[tt][e] = pv; den += pv; }
        den += __shfl_xor(den, 16); den += __shfl_xor(den, 32);
        f32x4 o[8];
#pragma unroll
        for (int dt = 0; dt < 8; ++dt) o[dt] = (f32x4){0.f, 0.f, 0.f, 0.f};
        const int q4 = (lane & 15) >> 2, p4 = lane & 3;
#pragma unroll
        for (int ku = 0; ku < 5; ++ku) {
            const int T0 = w + 2 * ku, T1 = ku < 4 ? T0 + 1 : T0;
            union { bf16x8 v; unsigned u[4]; } pf;
            pf.u[0] = cvt_pk_bf16(s[2 * ku][0], s[2 * ku][1]); pf.u[1] = cvt_pk_bf16(s[2 * ku][2], s[2 * ku][3]);
            if (ku < 4) { pf.u[2] = cvt_pk_bf16(s[2 * ku + 1][0], s[2 * ku + 1][1]); pf.u[3] = cvt_pk_bf16(s[2 * ku + 1][2], s[2 * ku + 1][3]); } else { pf.u[2] = 0u; pf.u[3] = 0u; }
#pragma unroll
            for (int dt = 0; dt < 8; ++dt) {
                union { bf16x8 v; bf16x4 h[2]; } vf;
                vf.h[0] = __builtin_amdgcn_ds_read_tr16_b64_v4i16((LAS bf16x4*)(lds + 65536 + off_b(16 * T0 + 4 * fq + q4, 2 * dt + (p4 >> 1)) + 8 * (p4 & 1)));
                vf.h[1] = __builtin_amdgcn_ds_read_tr16_b64_v4i16((LAS bf16x4*)(lds + 65536 + off_b(16 * T1 + 4 * fq + q4, 2 * dt + (p4 >> 1)) + 8 * (p4 & 1)));
                o[dt] = __builtin_amdgcn_mfma_f32_16x16x32_bf16(vf.v, pf.v, o[dt], 0, 0, 0);
            }
        }
        const float rden = 1.0f / den;
        bf16_t* orow = AO + qrow * DM + C.head * 128 + 4 * fq;
#pragma unroll
        for (int dt = 0; dt < 8; ++dt) *(u32x2*)(orow + 16 * dt) = pack4(o[dt] * rden);
        if (fq == 0) LSE[qrow * 12 + C.head] = mx + __builtin_amdgcn_logf(den);
        __syncthreads();
        if (!more) break;
        it = nit;
    }
}

__device__ __forceinline__ void attn_sample_item(const Params& p, LAS unsigned char* lds, int item) {
    const int tid = threadIdx.x;
    const int hs = item & 3, g = (item >> 2) % 3, b = item / 12, d = 1 << (2 * g), buf = 128 * d, head = g * 4 + hs;
    const float* cache = g == 0 ? p.c0 : (g == 1 ? p.c1 : p.c2);
    const float* okv = p.out + (g == 0 ? O_KVS0 : (g == 1 ? O_KVS1 : O_KVS2));
    LAS float* qs = (LAS float*)lds;
    LAS float* sc = qs + 512;
    LAS float* st = sc + 4 * 132;
    LAS float* part = st + 8;
    const bf16_t* Qb = (const bf16_t*)(p.ws + WS_Q);
    { const int t = tid >> 7, j = tid & 127; qs[tid] = bf2f(Qb[((size_t)MP + b * 4 + t) * AW + head * 128 + j]); }
    __syncthreads();
    {
        const int sub = tid & 3;
#pragma unroll
        for (int ps = 0; ps < 5; ++ps) {
            const int pi = ps * 128 + (tid >> 2);
            const bool act = pi < 516;
            const int t = act ? pi / 129 : 0, jj = act ? pi % 129 : 0;
            const int idx = buf + t - d * jj;
            const float* kr = (idx < buf ? cache + ((size_t)(b * buf + idx)) * 1024 : okv + ((size_t)(b * buf + idx - 4)) * 1024) + hs * 128 + 32 * sub;
            f32x4 kv[8];
#pragma unroll
            for (int c = 0; c < 8; ++c) kv[c] = *(const f32x4*)(kr + 4 * c);
            float dot = 0.f;
#pragma unroll
            for (int c = 0; c < 8; ++c) { const LAS float* qq = qs + t * 128 + 32 * sub + 4 * c; dot += kv[c][0] * qq[0] + kv[c][1] * qq[1] + kv[c][2] * qq[2] + kv[c][3] * qq[3]; }
            dot += __shfl_xor(dot, 1); dot += __shfl_xor(dot, 2);
            if (act && sub == 0) sc[t * 132 + jj] = dot;
        }
    }
    __syncthreads();
    if (tid < 256) {
        const int tw = tid >> 6, lane = tid & 63;
        const float a0 = sc[tw * 132 + lane], a1 = sc[tw * 132 + 64 + lane], a2 = lane == 0 ? sc[tw * 132 + 128] : -3.0e38f;
        const float mx = wave_max(fmaxf(fmaxf(a0, a1), a2));
        const float e0 = __builtin_amdgcn_exp2f(a0 - mx), e1 = __builtin_amdgcn_exp2f(a1 - mx), e2 = lane == 0 ? __builtin_amdgcn_exp2f(a2 - mx) : 0.f;
        const float den = wave_sum(e0 + e1 + e2);
        sc[tw * 132 + lane] = e0; sc[tw * 132 + 64 + lane] = e1; if (lane == 0) { sc[tw * 132 + 128] = e2; st[tw * 2] = den; st[tw * 2 + 1] = mx + __builtin_amdgcn_logf(den); }
    }
    __syncthreads();
    {
        const int t = tid >> 7, kq = (tid >> 5) & 3, dd4 = tid & 31;
        f32x4 acc = {0.f, 0.f, 0.f, 0.f};
#pragma unroll 11
        for (int i = 0; i < 33; ++i) {
            const int jj = kq + 4 * i;
            if (jj <= 128) {
                const int idx = buf + t - d * jj;
                const float* vr = (idx < buf ? cache + ((size_t)(b * buf + idx)) * 1024 : okv + ((size_t)(b * buf + idx - 4)) * 1024) + 512 + hs * 128 + 4 * dd4;
                acc = acc + *(const f32x4*)vr * sc[t * 132 + jj];
            }
        }
        *(LAS f32x4*)(part + (t * 4 + kq) * 128 + 4 * dd4) = acc;
    }
    __syncthreads();
    {
        const int t = tid >> 7, j = tid & 127;
        const size_t row = (size_t)MP + b * 4 + t;
        const float acc = (part[(t * 4 + 0) * 128 + j] + part[(t * 4 + 1) * 128 + j]) + (part[(t * 4 + 2) * 128 + j] + part[(t * 4 + 3) * 128 + j]);
        bf16_t* AO = (bf16_t*)(p.ws + WS_AO);
        AO[row * DM + head * 128 + j] = (bf16_t)(cvt_pk_bf16(acc / st[t * 2], 0.f) & 0xffffu);
        if (j == 0) ((float*)(p.ws + WS_LSE))[row * 12 + head] = st[t * 2 + 1];
    }
    __syncthreads();
}

__device__ __forceinline__ void conv_item(const Params& p, LAS unsigned char* lds, int item) {
    const int tid = threadIdx.x, ch = tid;
    const float* U = (const float*)(p.ws + WS_U);
    const bool samp = item >= 256;
    const int b = samp ? item - 256 : item >> 7, t0 = samp ? 0 : (item & 127) * 32;
    float wgt[31];
#pragma unroll
    for (int j = 0; j < 31; ++j) wgt[j] = p.conv_w[j * CCH + ch];
    float acc[32];
    const float bias = p.conv_b[ch];
#pragma unroll
    for (int t = 0; t < 32; ++t) acc[t] = bias;
#pragma unroll
    for (int rr = 0; rr < 62; ++rr) {
        float uv = 0.f;
        if (!samp) { const int tok = t0 - 30 + rr; if (tok >= 0) uv = U[((size_t)(b * SEQ + tok)) * CCH + ch]; }
        else { if (rr < 30) uv = p.sconv[((size_t)(b * 30 + rr)) * CCH + ch]; else if (rr < 34) uv = U[((size_t)(MP + b * 4 + rr - 30)) * CCH + ch]; }
#pragma unroll
        for (int t = 0; t < 32; ++t) { const int j = rr - t; if (j >= 0 && j <= 30) acc[t] += wgt[j] * uv; }
    }
    LAS float* ct = (LAS float*)lds;
#pragma unroll
    for (int t = 0; t < 32; ++t) ct[t * CCH + ch] = acc[t];
    __syncthreads();
    {
        const int w = tid >> 6, lane = tid & 63;
        bf16_t* AO = (bf16_t*)(p.ws + WS_AO);
        const int ntok = samp ? 4 : 32;
        for (int tt = 0; tt < 4; ++tt) {
            const int t = 4 * w + tt;
            if (t < ntok) {
                float x[8]; float sm = 0.f;
#pragma unroll
                for (int i = 0; i < 8; ++i) { x[i] = ct[t * CCH + lane + 64 * i]; sm += x[i]; }
                const float mean = wave_sum(sm) * (1.0f / CCH); float s2 = 0.f;
#pragma unroll
                for (int i = 0; i < 8; ++i) { x[i] -= mean; s2 += x[i] * x[i]; }
                const float rstd = rsqrtf(wave_sum(s2) * (1.0f / CCH) + LN_EPS);
                const size_t row = samp ? (size_t)MP + b * 4 + t : (size_t)b * SEQ + t0 + t;
#pragma unroll
                for (int i = 0; i < 8; ++i) { const int c = lane + 64 * i; float y = x[i] * rstd * p.cln_g[c] + p.cln_b[c]; y = y * fast_sigmoid(y);
                    AO[row * DM + AW + c] = (bf16_t)(cvt_pk_bf16(y, 0.f) & 0xffffu); }
            }
        }
    }
    __syncthreads();
}

__device__ __forceinline__ void phase_mixers(const Params& p, LAS unsigned char* lds) {
    constexpr int N_AP = 2 * 3 * 4 * 32, N_AS = 8 * 12, N_CV = 256 + 8;
    const int G = gridDim.x;
    attn_prompt_loop(p, lds, N_AP);
    for (int it = (blockIdx.x + N_AS) % G; it < N_AS; it += G) attn_sample_item(p, lds, it);
    if (G > N_AS) { if ((int)((blockIdx.x + N_AS) % G) >= N_AS) cvt_range(p, U_IN + U_OUT, U_IN + U_OUT + U_GU, (int)blockIdx.x * 8 + (threadIdx.x >> 6), (G - N_AS) * 8); }
    else cvt_range(p, U_IN + U_OUT, U_IN + U_OUT + U_GU, (int)blockIdx.x * 8 + (threadIdx.x >> 6), G * 8);
    if constexpr (MIXPROBE == 2) { for (int it = (blockIdx.x + N_AS) % G; it < N_AS; it += G) attn_sample_item(p, lds, it); }

}

__device__ __forceinline__ void phase_alpha(const Params& p) {
    bf16_t* AO = (bf16_t*)(p.ws + WS_AO); const float* LSE = (const float*)(p.ws + WS_LSE);
    const size_t N = (size_t)MT * 12 * 16, S = (size_t)gridDim.x * 512;
    for (size_t i0 = (size_t)blockIdx.x * 512 + threadIdx.x; i0 < N; i0 += 4 * S) {
        float l0[4], l1[4], l2[4]; u32x4 v[4]; u32x4* ptr[4]; int gq[4];
#pragma unroll
        for (int u = 0; u < 4; ++u) {
            const size_t i = i0 + u * S; const bool ok = i < N; const size_t ii = ok ? i : 0;
            const int c = (int)(ii & 15), sl = (int)((ii >> 4) % 12); const size_t row = ii / 192;
            const int hs = sl & 3; gq[u] = ok ? (sl >> 2) : -1;
            l0[u] = LSE[row * 12 + hs]; l1[u] = LSE[row * 12 + 4 + hs]; l2[u] = LSE[row * 12 + 8 + hs];
            ptr[u] = (u32x4*)(AO + row * DM + sl * 128 + c * 8); v[u] = *ptr[u];
        }
#pragma unroll
        for (int u = 0; u < 4; ++u) {
            const float mx = fmaxf(l0[u], fmaxf(l1[u], l2[u]));
            const float e0 = __builtin_amdgcn_exp2f(l0[u] - mx), e1 = __builtin_amdgcn_exp2f(l1[u] - mx), e2 = __builtin_amdgcn_exp2f(l2[u] - mx);
            const float al = (gq[u] == 0 ? e0 : (gq[u] == 1 ? e1 : e2)) / (e0 + e1 + e2);
            u32x4 w = v[u];
#pragma unroll
            for (int k = 0; k < 4; ++k) { const float lo = __uint_as_float(w[k] << 16) * al, hi = __uint_as_float(w[k] & 0xffff0000u) * al; w[k] = cvt_pk_bf16(lo, hi); }
            if (gq[u] >= 0) *ptr[u] = w;
        }
    }
}

__device__ __forceinline__ void phase_ln(const float* src, float* dstf, bf16_t* dstb, const float* gam, const float* bet) {
    const int lane = threadIdx.x & 63, gw = blockIdx.x * 8 + (threadIdx.x >> 6), NW = gridDim.x * 8;
    f32x4 gv[8], bv[8];
#pragma unroll
    for (int j = 0; j < 8; ++j) { gv[j] = *(const f32x4*)(gam + 4 * lane + 256 * j); bv[j] = *(const f32x4*)(bet + 4 * lane + 256 * j); }
    for (int r = gw; r < MT; r += NW) {
        const float* xr = src + (size_t)r * DM + 4 * lane;
        f32x4 v[8]; float sm = 0.f;
#pragma unroll
        for (int j = 0; j < 8; ++j) { v[j] = *(const f32x4*)(xr + 256 * j); sm += (v[j][0] + v[j][1]) + (v[j][2] + v[j][3]); }
        const float mean = wave_sum(sm) * (1.0f / DM); float s2 = 0.f;
#pragma unroll
        for (int j = 0; j < 8; ++j) { v[j] = v[j] - mean; s2 += (v[j][0] * v[j][0] + v[j][1] * v[j][1]) + (v[j][2] * v[j][2] + v[j][3] * v[j][3]); }
        const float rstd = rsqrtf(wave_sum(s2) * (1.0f / DM) + LN_EPS);
#pragma unroll
        for (int j = 0; j < 8; ++j) {
            const f32x4 y = v[j] * rstd * gv[j] + bv[j];
            if (dstf) *(f32x4*)(dstf + (size_t)r * DM + 4 * lane + 256 * j) = y;
            if (dstb) *(u32x2*)(dstb + (size_t)r * DM + 4 * lane + 256 * j) = pack4(y);
        }
    }
}

__device__ __forceinline__ void phase_ln_bf16(bf16_t* X, float* yout, const float* gam, const float* bet) {
    const int lane = threadIdx.x & 63, gw = blockIdx.x * 8 + (threadIdx.x >> 6), NW = gridDim.x * 8;
    for (int r0 = gw; r0 < MT; r0 += 2 * NW) {
        u32x4 q[2][4];
#pragma unroll
        for (int h = 0; h < 2; ++h) { const int r = r0 + h * NW; if (r < MT) {
#pragma unroll
            for (int j = 0; j < 4; ++j) q[h][j] = *(const u32x4*)(X + (size_t)r * DM + 8 * lane + 512 * j); } }
#pragma unroll
        for (int h = 0; h < 2; ++h) {
            const int r = r0 + h * NW;
            if (r < MT) {
                bf16_t* xr = X + (size_t)r * DM + 8 * lane;
                float v[32]; float sm = 0.f;
#pragma unroll
                for (int j = 0; j < 4; ++j)
#pragma unroll
                    for (int k = 0; k < 4; ++k) { v[8 * j + 2 * k] = __uint_as_float(q[h][j][k] << 16); v[8 * j + 2 * k + 1] = __uint_as_float(q[h][j][k] & 0xffff0000u); sm += v[8 * j + 2 * k] + v[8 * j + 2 * k + 1]; }
                const float mean = wave_sum(sm) * (1.0f / DM); float s2 = 0.f;
#pragma unroll
                for (int i = 0; i < 32; ++i) { v[i] -= mean; s2 += v[i] * v[i]; }
                const float rstd = rsqrtf(wave_sum(s2) * (1.0f / DM) + LN_EPS);
#pragma unroll
                for (int j = 0; j < 4; ++j) {
                    const f32x4 g0 = *(const f32x4*)(gam + 8 * lane + 512 * j), g1 = *(const f32x4*)(gam + 8 * lane + 512 * j + 4), b0 = *(const f32x4*)(bet + 8 * lane + 512 * j), b1 = *(const f32x4*)(bet + 8 * lane + 512 * j + 4);
                    f32x4 y0, y1;
#pragma unroll
                    for (int k = 0; k < 4; ++k) { y0[k] = v[8 * j + k] * rstd * g0[k] + b0[k]; y1[k] = v[8 * j + 4 + k] * rstd * g1[k] + b1[k]; }
                    if (yout) { float* yr = yout + (size_t)r * DM + 8 * lane + 512 * j; __builtin_nontemporal_store(y0, (f32x4*)yr); __builtin_nontemporal_store(y1, (f32x4*)(yr + 4)); }
                    else *(u32x4*)(xr + 512 * j) = pack8(y0, y1);
                }
            }
        }
    }
}

constexpr int REP0 = 1, REP2 = 1, REPG = 1, PROBE_NULLGU = 0, REPMASK = 0, NSYNC_PROBE = 0;
template <int MASK>
__global__ void __launch_bounds__(512, 2) fwd_kernel(Params p) {
    extern __shared__ __attribute__((aligned(16))) unsigned char shm[];
    LAS unsigned char* lds = (LAS unsigned char*)shm;
    unsigned char* ws = p.ws;
    __shared__ uint4 xb_words;
    if (threadIdx.x == 0) xb_words = make_uint4(0u, 0u, 0u, 0u);
    __syncthreads();
    const XcdBarrier xb = xcd_barrier_post((unsigned*)(ws + WS_BAR), (volatile LAS unsigned*)&xb_words);
    if (p.out == nullptr) cg::this_grid().sync();
#define GSYNC() xcd_barrier(xb)
#define PH(k) if constexpr ((MASK >> (k)) & 1)
#define SYNC(k) if constexpr (((MASK >> (k)) & 1) && (MASK & ((1 << (k)) - 1))) GSYNC();
    PH(0) for (int rep = 0; rep < REP0; ++rep) { phase_convert(p, lds); if (rep + 1 < REP0) GSYNC(); }
    SYNC(1)
    PH(1) { Gemm g{(const bf16_t*)(ws + WS_XB), (const bf16_t*)(ws + WS_WIN), MPAD, NIN, DM}; StaticOrder S; S.init(MPAD, NIN, gridDim.x, blockIdx.x);
            EpiIn E{(bf16_t*)(ws + WS_Q), (bf16_t*)(ws + WS_K), (bf16_t*)(ws + WS_V), (float*)(ws + WS_U), (const float*)(ws + WS_ROPE), p.out};
            gemm_phase(lds, g, S, E); if constexpr ((REPMASK >> 1) & 1) { GSYNC(); gemm_phase(lds, g, S, E); }
            { const int ntile = (MPAD / 256) * (NIN / 256), G = gridDim.x, full = ntile % G;
              if (full != 0 && (int)blockIdx.x >= full) { const int gw = ((int)blockIdx.x - full) * 8 + (threadIdx.x >> 6), NW = (G - full) * 8;
                  cvt_range(p, U_IN, U_IN + U_OUT, gw, NW); cvt_range(p, U_IN + U_OUT + U_GU, U_IN + U_OUT + U_GU + U_D, gw, NW); }
              else if (full == 0) { const int gw = blockIdx.x * 8 + (threadIdx.x >> 6), NW = G * 8; cvt_range(p, U_IN, U_IN + U_OUT, gw, NW); cvt_range(p, U_IN + U_OUT + U_GU, U_IN + U_OUT + U_GU + U_D, gw, NW); } } }
    SYNC(2)
    PH(2) { phase_mixers(p, lds); if constexpr (REP2 == 2) { GSYNC(); phase_mixers(p, lds); } }
    SYNC(3)
    PH(3) { for (int it = blockIdx.x; it < 256 + 8; it += gridDim.x) conv_item(p, lds, it); phase_alpha(p); }
    SYNC(4)
    PH(4) { skinny_gemm<8, true>(lds, (const bf16_t*)(ws + WS_AO) + (size_t)MP * DM, (const bf16_t*)(ws + WS_WOUT), (const bf16_t*)(ws + WS_XB) + (size_t)MP * DM, (bf16_t*)(ws + WS_Z1) + (size_t)MP * DM);
            Gemm g{(const bf16_t*)(ws + WS_AO), (const bf16_t*)(ws + WS_WOUT), MP, DM, DM}; StaticOrder S; S.init(MP, DM, gridDim.x, blockIdx.x);
            EpiOut E{(const bf16_t*)(ws + WS_XB), (bf16_t*)(ws + WS_Z1)}; gemm_phase(lds, g, S, E); if constexpr ((REPMASK >> 4) & 1) { GSYNC(); gemm_phase(lds, g, S, E); } }
    SYNC(5)
    PH(5) phase_ln_bf16((bf16_t*)(ws + WS_Z1), nullptr, p.ln1_g, p.ln1_b);
    SYNC(6)
    PH(6) { Gemm g{(const bf16_t*)(ws + WS_Z1), (const bf16_t*)(ws + WS_WGU), MPAD, 2 * FH, DM}; StaticOrder S; S.init(MPAD, 2 * FH, gridDim.x, blockIdx.x);
            if constexpr (PROBE_NULLGU) { EpiNull EN{(float*)(ws + WS_LSE)}; gemm_phase(lds, g, S, EN); GSYNC(); }
            EpiGU E{(bf16_t*)(ws + WS_H)}; gemm_phase(lds, g, S, E); if constexpr ((REPMASK >> 6) & 1) { GSYNC(); gemm_phase(lds, g, S, E); }
            { const int ntile = (MPAD / 256) * (2 * FH / 256), G = gridDim.x, full = ntile % G;
              if (full != 0 && (int)blockIdx.x >= full) copy_caches(p, (size_t)((int)blockIdx.x - full) * 512 + threadIdx.x, (size_t)(G - full) * 512);
              else if (full == 0) copy_caches(p, (size_t)blockIdx.x * 512 + threadIdx.x, (size_t)G * 512); } }
    SYNC(7)
    PH(7) { skinny_gemm<22, true>(lds, (const bf16_t*)(ws + WS_H) + (size_t)MP * FH, (const bf16_t*)(ws + WS_WD), (const bf16_t*)(ws + WS_Z1) + (size_t)MP * DM, (bf16_t*)(ws + WS_AO) + (size_t)MP * DM);
            Gemm g{(const bf16_t*)(ws + WS_H), (const bf16_t*)(ws + WS_WD), MP, DM, FH}; StaticOrder S; S.init(MP, DM, gridDim.x, blockIdx.x);
            EpiDown E{(const bf16_t*)(ws + WS_Z1), (bf16_t*)(ws + WS_AO)}; gemm_phase(lds, g, S, E); if constexpr ((REPMASK >> 7) & 1) { GSYNC(); gemm_phase(lds, g, S, E); } }
    SYNC(8)
    PH(8) phase_ln_bf16((bf16_t*)(ws + WS_AO), p.out, p.ln2_g, p.ln2_b);
    if constexpr (NSYNC_PROBE > 0) { for (int i = 0; i < NSYNC_PROBE; ++i) GSYNC(); }
#undef PH
#undef SYNC
}

#ifndef N_LAUNCH_MODE
#define N_LAUNCH_MODE 1
#endif
template <int MASK> static void launch_plain(const Params& p, int grid, hipStream_t stream) {
    static bool attr = false;
    if (!attr) { (void)hipFuncSetAttribute((const void*)fwd_kernel<MASK>, hipFuncAttributeMaxDynamicSharedMemorySize, STAGE_BYTES); attr = true; }
    hipLaunchKernelGGL(fwd_kernel<MASK>, dim3(grid), dim3(512), STAGE_BYTES, stream, p);
}
extern "C" void kernel_launch(void* const* d_in, const int* in_sizes, int n_in, void* d_out, int out_size, void* d_ws, size_t ws_size, hipStream_t stream) {
    static int grid = 0;
    if (grid == 0) {
        if (n_in != 19 || (size_t)out_size != O_END || ws_size < WS_END) { fprintf(stderr, "kernel_launch: unexpected shapes: n_in %d out %d ws %zu (need %zu)\n", n_in, out_size, ws_size, (size_t)WS_END); grid = -1; return; }
        int dev = 0, cus = 0, per_cu = 0;
        (void)hipGetDevice(&dev); (void)hipDeviceGetAttribute(&cus, hipDeviceAttributeMultiprocessorCount, dev);
#if N_LAUNCH_MODE == 1
        if (hipFuncSetAttribute((const void*)fwd_kernel<0x1FF>, hipFuncAttributeMaxDynamicSharedMemorySize, STAGE_BYTES) != hipSuccess) { fprintf(stderr, "kernel_launch: hipFuncSetAttribute failed\n"); grid = -1; return; }
        if (hipOccupancyMaxActiveBlocksPerMultiprocessor(&per_cu, (const void*)fwd_kernel<0x1FF>, 512, STAGE_BYTES) != hipSuccess || per_cu < 1) { fprintf(stderr, "kernel_launch: occupancy query failed (%d)\n", per_cu); (void)hipGetLastError(); }
#endif
        grid = cus;
        fprintf(stderr, "kernel_launch: grid %d (per_cu %d)\n", grid, per_cu);
    }
    if (grid < 0) return;
    Params p{};
    p.xp = (const float*)d_in[0]; p.xs = (const float*)d_in[1]; p.c0 = (const float*)d_in[2]; p.c1 = (const float*)d_in[3]; p.c2 = (const float*)d_in[4]; p.sconv = (const float*)d_in[5];
    p.w_in = (const float*)d_in[6]; p.w_out = (const float*)d_in[7]; p.conv_w = (const float*)d_in[8]; p.conv_b = (const float*)d_in[9]; p.cln_g = (const float*)d_in[10]; p.cln_b = (const float*)d_in[11];
    p.ln1_g = (const float*)d_in[12]; p.ln1_b = (const float*)d_in[13]; p.w_gate = (const float*)d_in[14]; p.w_up = (const float*)d_in[15]; p.w_down = (const float*)d_in[16]; p.ln2_g = (const float*)d_in[17]; p.ln2_b = (const float*)d_in[18];
    p.out = (float*)d_out; p.ws = (unsigned char*)d_ws;
#if N_LAUNCH_MODE == 1
    if (hipMemsetAsync((unsigned char*)d_ws + WS_BAR, 0, 16384, stream) != hipSuccess) { fprintf(stderr, "kernel_launch: memset of the barrier words failed\n"); return; }
    void* args[] = {&p};
    hipError_t e = hipLaunchCooperativeKernel((const void*)fwd_kernel<0x1FF>, dim3(grid), dim3(512), args, STAGE_BYTES, stream);
    if (e != hipSuccess) fprintf(stderr, "cooperative launch failed: %s (grid %d)\n", hipGetErrorString(e), grid);
#else
    launch_plain<1>(p, grid, stream); launch_plain<2>(p, grid, stream); launch_plain<4>(p, grid, stream); launch_plain<8>(p, grid, stream); launch_plain<16>(p, grid, stream);
    launch_plain<32>(p, grid, stream); launch_plain<64>(p, grid, stream); launch_plain<128>(p, grid, stream); launch_plain<256>(p, grid, stream);
#endif
}
```
